# Optimizing an MI355X kernel written in HIP

```python
import jax, jax.numpy as jnp
from jax import lax
import numpy as np


D_MODEL = 1024
BATCH = 8
SEQ = 4096
DEPTH = 2

EPS = 1e-6
HG_HEADS = 4
HG_HEAD_DIM = 128
HG_DIM = HG_HEADS * HG_HEAD_DIM
GLA_HEADS = 4
GLA_DK = 64
GLA_DV = 128
GLA_KDIM = GLA_HEADS * GLA_DK
GLA_VDIM = GLA_HEADS * GLA_DV
GLA_RANK = 16
GLA_TAU = 16.0
LA_CHUNK = 64
NSA_HEADS = 8
NSA_KV_GROUPS = 2
NSA_REP = NSA_HEADS // NSA_KV_GROUPS
NSA_DH = 64
NSA_DIM = NSA_HEADS * NSA_DH
NSA_KV_DIM = NSA_KV_GROUPS * NSA_DH
CMP_STRIDE = 16
CMP_BLK = 2 * CMP_STRIDE
CMP_HID = 128
SLC_BLK = 64
N_SEL = 16
WIN = 512
Q_BLOCK = 128
ROPE_THETA = 500000.0
ROT_DIM = NSA_DH // 4
N_BRANCH = 3
FF_DIM = ((8 * D_MODEL // 3 + 255) // 256) * 256

IN_SPLITS = (HG_DIM, HG_DIM, HG_DIM, HG_DIM,
             GLA_KDIM, GLA_KDIM, GLA_VDIM, GLA_RANK, GLA_VDIM,
             NSA_DIM, NSA_KV_DIM, NSA_KV_DIM, NSA_KV_DIM, NSA_KV_DIM, NSA_KV_DIM, NSA_KV_DIM,
             3 * NSA_HEADS,
             N_BRANCH * D_MODEL)
IN_COLS = sum(IN_SPLITS)

kernel_name = 'hybrid_hgrn2_gla_nsa_block'


def rmsnorm(x, g):
    x32 = x.astype(jnp.float32)
    y = x32 * lax.rsqrt(jnp.mean(x32 * x32, axis=-1, keepdims=True) + EPS)
    return y.astype(x.dtype) * g


def split_cols(z):
    outs = []
    start = 0
    for n in IN_SPLITS:
        outs.append(z[..., start:start + n])
        start += n
    return outs


def heads(z, n):
    B, T, _ = z.shape
    return z.reshape(B, T, n, -1).transpose(0, 2, 1, 3)


def head_rmsnorm(o, g, dtype):
    B, H, T, dv = o.shape
    o = o.astype(jnp.float32).transpose(0, 2, 1, 3)
    o = o * lax.rsqrt(jnp.mean(o * o, axis=-1, keepdims=True) + EPS)
    return o.reshape(B, T, H * dv).astype(dtype) * g


def chunked_gated_linear_attention(q, k, v, log_g):
    B, H, T, dk = q.shape
    dv = v.shape[-1]
    n = T // LA_CHUNK

    def to_chunks(a):
        return jnp.moveaxis(a.astype(jnp.float32).reshape(B, H, n, LA_CHUNK, a.shape[-1]), 2, 0)

    causal = jnp.tril(jnp.ones((LA_CHUNK, LA_CHUNK), dtype=bool))[:, :, None]

    def step(state, inp):
        qc, kc, vc, gc = inp
        b = jnp.cumsum(gc, axis=2)
        o_inter = jnp.einsum('bhtd,bhdv->bhtv', qc * jnp.exp(b), state)
        decay = jnp.exp(jnp.where(causal, b[:, :, :, None, :] - b[:, :, None, :, :], -jnp.inf))
        scores = jnp.einsum('bhtd,bhtsd,bhsd->bhts', qc, decay, kc)
        o = o_inter + jnp.einsum('bhts,bhsv->bhtv', scores, vc)
        b_last = b[:, :, -1:, :]
        state = (jnp.exp(b_last[:, :, 0, :, None]) * state
                 + jnp.einsum('bhsd,bhsv->bhdv', kc * jnp.exp(b_last - b), vc))
        return state, o

    s0 = jnp.zeros((B, H, dk, dv), jnp.float32)
    _, o = lax.scan(step, s0, (to_chunks(q), to_chunks(k), to_chunks(v), to_chunks(log_g)))
    return jnp.moveaxis(o, 0, 2).reshape(B, H, T, dv)


def partial_rope(x, cos, sin):
    half = ROT_DIM // 2
    c = cos[None, :, None, :].astype(x.dtype)
    s = sin[None, :, None, :].astype(x.dtype)
    x1 = x[..., :half]
    x2 = x[..., half:ROT_DIM]
    return jnp.concatenate([x1 * c - x2 * s, x2 * c + x1 * s, x[..., ROT_DIM:]], axis=-1)


def masked_softmax(s, mask):
    s = jnp.where(mask, s.astype(jnp.float32), -1e30)
    return jnp.where(mask, jax.nn.softmax(s, axis=-1), 0.0)


def compress(k, pos, w1, w2):
    B, G, T, dh = k.shape
    c = k.reshape(B, G, T // CMP_STRIDE, CMP_STRIDE, dh)
    blocks = jnp.concatenate([c[:, :, :-1], c[:, :, 1:]], axis=3) + pos
    flat = blocks.reshape(B, G, blocks.shape[2], CMP_BLK * dh)
    return jax.nn.gelu(flat @ w1) @ w2


def nsa_attention(q, kc, vc, ks, vs, kw, vw, gates):
    B, T, H, dh = q.shape
    G, R = NSA_KV_GROUPS, NSA_REP
    ncmp = kc.shape[2]
    nslc = T // SLC_BLK
    n_sel = min(N_SEL, nslc)
    nq = T // Q_BLOCK
    cmp_start = jnp.arange(ncmp) * CMP_STRIDE
    cmp_end = cmp_start + CMP_BLK - 1
    blk = jnp.arange(nslc)
    overlap = ((cmp_start[:, None] < (blk[None, :] + 1) * SLC_BLK)
               & (cmp_end[:, None] >= blk[None, :] * SLC_BLK)).astype(jnp.float32)
    ks_b = ks.reshape(B, G, nslc, SLC_BLK, dh)
    vs_b = vs.reshape(B, G, nslc, SLC_BLK, dh)
    kw_pad = jnp.pad(kw, ((0, 0), (0, 0), (WIN, 0), (0, 0)))
    vw_pad = jnp.pad(vw, ((0, 0), (0, 0), (WIN, 0), (0, 0)))
    b_idx = jnp.arange(B)[:, None, None, None]
    g_idx = jnp.arange(G)[None, :, None, None]
    q_blocks = jnp.moveaxis(q.reshape(B, nq, Q_BLOCK, G, R, dh), 1, 0).transpose(0, 1, 3, 4, 2, 5)

    def block_fn(args):
        c, qb = args
        t = c * Q_BLOCK + jnp.arange(Q_BLOCK)
        mask_c = cmp_end[None, :] <= t[:, None]
        p_c = masked_softmax(jnp.einsum('bgrqd,bgnd->bgrqn', qb, kc), mask_c)
        o_c = jnp.einsum('bgrqn,bgnd->bgrqd', p_c.astype(vc.dtype), vc)
        imp = jnp.einsum('bgrqn,nj->bgqj', p_c, overlap)
        cur = t // SLC_BLK
        valid = blk[None, :] <= cur[:, None]
        forced = (blk[None, :] == 0) | (blk[None, :] == cur[:, None]) | (blk[None, :] == cur[:, None] - 1)
        score = jnp.where(valid & forced, 1e9, jnp.where(valid, imp, -1e9))
        top_s, top_i = lax.top_k(score, n_sel)
        k_sel = ks_b[b_idx, g_idx, top_i].reshape(B, G, Q_BLOCK, n_sel * SLC_BLK, dh)
        v_sel = vs_b[b_idx, g_idx, top_i].reshape(B, G, Q_BLOCK, n_sel * SLC_BLK, dh)
        tok = (top_i[..., None] * SLC_BLK + jnp.arange(SLC_BLK)).reshape(B, G, Q_BLOCK, n_sel * SLC_BLK)
        mask_s = (tok <= t[None, None, :, None]) & jnp.repeat(top_s > -1e8, SLC_BLK, axis=-1)
        p_s = masked_softmax(jnp.einsum('bgrqd,bgqmd->bgrqm', qb, k_sel), mask_s[:, :, None])
        o_s = jnp.einsum('bgrqm,bgqmd->bgrqd', p_s.astype(v_sel.dtype), v_sel)
        k_win = lax.dynamic_slice_in_dim(kw_pad, c * Q_BLOCK, WIN + Q_BLOCK, axis=2)
        v_win = lax.dynamic_slice_in_dim(vw_pad, c * Q_BLOCK, WIN + Q_BLOCK, axis=2)
        kp = c * Q_BLOCK - WIN + jnp.arange(WIN + Q_BLOCK)
        mask_w = (kp[None, :] <= t[:, None]) & (kp[None, :] > t[:, None] - WIN) & (kp[None, :] >= 0)
        p_w = masked_softmax(jnp.einsum('bgrqd,bgkd->bgrqk', qb, k_win), mask_w)
        o_w = jnp.einsum('bgrqk,bgkd->bgrqd', p_w.astype(v_win.dtype), v_win)
        return jnp.stack([o_c, o_s, o_w], axis=-1)

    out = lax.map(block_fn, (jnp.arange(nq), q_blocks))
    out = out.transpose(1, 0, 4, 2, 3, 5, 6).reshape(B, T, H, dh, 3)
    return jnp.einsum('bthdk,bthk->bthd', out, gates).reshape(B, T, H * dh)


def hybrid_mixer(h, lb, w_in, hg_norm_g, gla_w2, gla_b, gla_norm_g, cmp_pos_k, cmp_pos_v,
                 cmp_w1_k, cmp_w2_k, cmp_w1_v, cmp_w2_v, w_br_hg, w_br_gla, w_br_nsa, w_out, cos, sin):
    B, T, _ = h.shape
    (hq, hf, hi, hog, gq, gk, gv, glr, gog,
     nq_, nkc, nvc, nks, nvs, nkw, nvw, ngate, mgate) = split_cols(h @ w_in)
    lbh = lb.reshape(1, HG_HEADS, 1, HG_HEAD_DIM)
    log_f = jnp.logaddexp(jnp.log(lbh), jnp.log1p(-lbh)
                          + jax.nn.log_sigmoid(heads(hf, HG_HEADS).astype(jnp.float32)))
    o_hg = chunked_gated_linear_attention(jax.nn.silu(heads(hq, HG_HEADS)), -jnp.expm1(log_f),
                                          heads(hi, HG_HEADS), log_f)
    y_hg = head_rmsnorm(o_hg, hg_norm_g, h.dtype) * jax.nn.silu(hog)
    log_a = jax.nn.log_sigmoid((glr @ gla_w2 + gla_b).astype(jnp.float32)) / GLA_TAU
    o_gla = chunked_gated_linear_attention(heads(gq, GLA_HEADS) * GLA_DK ** -0.5, heads(gk, GLA_HEADS),
                                           heads(gv, GLA_HEADS), heads(log_a, GLA_HEADS))
    y_gla = head_rmsnorm(o_gla, gla_norm_g, h.dtype) * jax.nn.silu(gog)
    q = partial_rope(nq_.reshape(B, T, NSA_HEADS, NSA_DH), cos, sin) * NSA_DH ** -0.5

    def kv(z):
        return z.reshape(B, T, NSA_KV_GROUPS, NSA_DH)

    def to_g(z):
        return z.transpose(0, 2, 1, 3)

    kc = compress(to_g(partial_rope(kv(nkc), cos, sin)), cmp_pos_k, cmp_w1_k, cmp_w2_k)
    vc = compress(to_g(kv(nvc)), cmp_pos_v, cmp_w1_v, cmp_w2_v)
    ks = to_g(partial_rope(kv(nks), cos, sin))
    vs = to_g(kv(nvs))
    kw = to_g(partial_rope(kv(nkw), cos, sin))
    vw = to_g(kv(nvw))
    gates = jax.nn.sigmoid(ngate).reshape(B, T, NSA_HEADS, 3)
    y_nsa = nsa_attention(q, kc, vc, ks, vs, kw, vw, gates)
    g = jax.nn.sigmoid(mgate).reshape(B, T, N_BRANCH, D_MODEL)
    m = (g[:, :, 0] * (y_hg @ w_br_hg) + g[:, :, 1] * (y_gla @ w_br_gla)
         + g[:, :, 2] * (y_nsa @ w_br_nsa))
    return m @ w_out


def swiglu(h, w_gate, w_up, w_down):
    return (jax.nn.silu(h @ w_gate) * (h @ w_up)) @ w_down


def setup_inputs(seed: int = 0) -> dict:
    key = jax.random.key(seed)
    k = jax.random.split(key, 24)
    L, D = DEPTH, D_MODEL

    def nrm(kk, shape, scale):
        return jax.random.normal(kk, shape, jnp.float32) * scale

    def gain(kk, shape):
        return 1.0 + 0.02 * jax.random.normal(kk, shape, jnp.float32)

    return {
        'x': nrm(k[0], (BATCH, SEQ, D), 1.0),
        'norm1_g': gain(k[1], (L, D)),
        'w_in': nrm(k[2], (L, D, IN_COLS), D ** -0.5),
        'hg_lb': nrm(k[3], (L, HG_DIM), 0.5),
        'hg_norm_g': gain(k[4], (L, HG_DIM)),
        'gla_w2': nrm(k[5], (L, GLA_RANK, GLA_KDIM), GLA_RANK ** -0.5),
        'gla_b': nrm(k[6], (L, GLA_KDIM), 0.1),
        'gla_norm_g': gain(k[7], (L, GLA_VDIM)),
        'cmp_pos_k': nrm(k[8], (L, CMP_BLK, NSA_DH), 0.1),
        'cmp_pos_v': nrm(k[9], (L, CMP_BLK, NSA_DH), 0.1),
        'cmp_w1_k': nrm(k[10], (L, CMP_BLK * NSA_DH, CMP_HID), (CMP_BLK * NSA_DH) ** -0.5),
        'cmp_w2_k': nrm(k[11], (L, CMP_HID, NSA_DH), CMP_HID ** -0.5),
        'cmp_w1_v': nrm(k[12], (L, CMP_BLK * NSA_DH, CMP_HID), (CMP_BLK * NSA_DH) ** -0.5),
        'cmp_w2_v': nrm(k[13], (L, CMP_HID, NSA_DH), CMP_HID ** -0.5),
        'w_br_hg': nrm(k[14], (L, HG_DIM, D), HG_DIM ** -0.5),
        'w_br_gla': nrm(k[15], (L, GLA_VDIM, D), GLA_VDIM ** -0.5),
        'w_br_nsa': nrm(k[16], (L, NSA_DIM, D), NSA_DIM ** -0.5),
        'w_out': nrm(k[17], (L, D, D), D ** -0.5),
        'norm2_g': gain(k[18], (L, D)),
        'w_ffn_gate': nrm(k[19], (L, D, FF_DIM), D ** -0.5),
        'w_ffn_up': nrm(k[20], (L, D, FF_DIM), D ** -0.5),
        'w_ffn_down': nrm(k[21], (L, FF_DIM, D), FF_DIM ** -0.5),
        'final_norm_g': gain(k[22], (D,)),
    }


def reference(x, norm1_g, w_in, hg_lb, hg_norm_g, gla_w2, gla_b, gla_norm_g, cmp_pos_k, cmp_pos_v,
              cmp_w1_k, cmp_w2_k, cmp_w1_v, cmp_w2_v, w_br_hg, w_br_gla, w_br_nsa, w_out,
              norm2_g, w_ffn_gate, w_ffn_up, w_ffn_down, final_norm_g):
    T = x.shape[1]
    pos = jnp.arange(T, dtype=jnp.float32)
    inv_freq = ROPE_THETA ** (-jnp.arange(0, ROT_DIM, 2, dtype=jnp.float32) / ROT_DIM)
    ang = pos[:, None] * inv_freq[None, :]
    cos, sin = jnp.cos(ang), jnp.sin(ang)
    lbs = jnp.cumsum(jax.nn.softmax(hg_lb.astype(jnp.float32), axis=0), axis=0)
    lbs = lbs - lbs[0]
    for l in range(DEPTH):
        h = rmsnorm(x, norm1_g[l])
        x = x + hybrid_mixer(h, lbs[l], w_in[l], hg_norm_g[l], gla_w2[l], gla_b[l], gla_norm_g[l],
                             cmp_pos_k[l], cmp_pos_v[l], cmp_w1_k[l], cmp_w2_k[l], cmp_w1_v[l], cmp_w2_v[l],
                             w_br_hg[l], w_br_gla[l], w_br_nsa[l], w_out[l], cos, sin)
        h = rmsnorm(x, norm2_g[l])
        x = x + swiglu(h, w_ffn_gate[l], w_ffn_up[l], w_ffn_down[l])
    return rmsnorm(x, final_norm_g)
```

```cpp
#include <hip/hip_runtime.h>
#include <hip/hip_cooperative_groups.h>
#include <cstdio>
#include <cstdint>
namespace cg = cooperative_groups;
namespace pg8 {
#define PG8_LAS __attribute__((address_space(3)))
typedef unsigned short bf16_t;
typedef short bf16x8 __attribute__((ext_vector_type(8)));
typedef float f32x4 __attribute__((ext_vector_type(4)));
typedef unsigned u32x4 __attribute__((ext_vector_type(4)));
constexpr int BM = 256, BK = 64, HALF = 128, HTB = HALF * BK * 2  , STAGE_BYTES = 8 * HTB, NXCD = 8, WGM = 8;

__host__ __device__ __forceinline__ int lds_byte(int r, int c) { const int st = (r >> 4) * 2 + (c >> 5), rr = r & 15, cc = c & 31, ob = rr * 64 + cc * 2; return st * 1024 + (ob ^ (((ob >> 9) & 1) << 5)); }
__host__ __device__ __forceinline__ void stage_rc(int b, int& R, int& C) { const int st = b / 1024, sb = b % 1024, swz = sb ^ (((sb >> 9) & 1) << 5); R = (st >> 1) * 16 + swz / 64; C = (st & 1) * 32 + (swz % 64) / 2; }
__host__ __device__ __forceinline__ int perm32(int rho) { const int n = rho >> 4, i = rho & 15; return 8 * (i >> 2) + 4 * n + (i & 3); }

struct Unit { int pm, pn; };
struct Gemm { const bf16_t* A; const bf16_t* Bt; int M, N, K; };

struct StaticOrder {
    int nM, nN, nwg, G, c;
    __host__ __device__ void init(int M, int N, int G_, int c_) { nM = M / BM; nN = N / BM; nwg = nM * nN; G = G_; c = c_; }
    __host__ __device__ bool next(int i, Unit& u) const {
        const long L = (long)i * G + c; if (L >= nwg) return false;
        int wgid = (int)L; { const int q = nwg / NXCD, r = nwg % NXCD, xcd = wgid % NXCD, off = wgid / NXCD; wgid = (xcd < r ? xcd * (q + 1) : r * (q + 1) + (xcd - r) * q) + off; }
        const int nig = WGM * nN, gid = wgid / nig, fm = gid * WGM, gsz = (nM - fm) < WGM ? (nM - fm) : WGM;
        u.pm = fm + ((wgid % nig) % gsz); u.pn = (wgid % nig) / gsz; return true;
    }
    __device__ __forceinline__ void a_ready(const Unit&) const {}
    __device__ __forceinline__ void done(const Unit&) const {}
};

__device__ __forceinline__ unsigned cvt_pk_bf16(float lo, float hi) { unsigned r; asm volatile("v_cvt_pk_bf16_f32 %0, %1, %2" : "=v"(r) : "v"(lo), "v"(hi)); return r; }
typedef float f32x2 __attribute__((ext_vector_type(2)));
__device__ __forceinline__ f32x2 gelu_pk(f32x2 v) {
    const f32x2 av = __builtin_elementwise_abs(v), d = av * 0.2316418882f + 1.0f;
    f32x2 t; t.x = __builtin_amdgcn_rcpf(d.x); t.y = __builtin_amdgcn_rcpf(d.y);
    f32x2 q = t * 0.5307027145f + (-0.7265760135f); q = q * t + 0.7107068705f; q = q * t + (-0.142248368f); q = q * t + 0.127414796f; q = q * t;
    const f32x2 s = (v * v) * (-0.72134752044f);
    f32x2 e; e.x = __builtin_amdgcn_exp2f(s.x); e.y = __builtin_amdgcn_exp2f(s.y);
    const f32x2 m = v * (q * e), r = v - m;
    f32x2 o; o.x = v.x < 0.f ? m.x : r.x; o.y = v.y < 0.f ? m.y : r.y; return o;
}

template <int ACT  > struct EpiBf16 {
    static constexpr bool PERM = true, AFTER_DRAIN = false; static_assert(ACT == 0 || ACT == 1, "EpiBf16: ACT is 0 (none) or 1 (gelu_pk)");
    bf16_t* O; int ldc; const float* bias; int split_cols; size_t split_stride; float scale0;
    __device__ __forceinline__ void operator()(const f32x4 (&acc)[2][2][4][2], const Unit& u, int wr, int wc, int fr, int fq) const {
        const int row0 = u.pm * BM + wr * 64 + fr; int colt = u.pn * BM; bf16_t* base = O;
        float sc = 1.f; if (split_cols) { const int t = colt / split_cols; base += (size_t)t * split_stride; colt -= t * split_cols; if (t == 0) sc = scale0; }
        const int col0 = colt + wc * 32 + 8 * fq, bcol0 = u.pn * BM + wc * 32 + 8 * fq;
        f32x4 bv[2][2];
#pragma unroll
        for (int bj = 0; bj < 2; ++bj)
#pragma unroll
            for (int n = 0; n < 2; ++n) bv[bj][n] = bias ? *(const f32x4*)(bias + bcol0 + bj * HALF + 4 * n) : (f32x4){0.f, 0.f, 0.f, 0.f};
#pragma unroll
        for (int ai = 0; ai < 2; ++ai)
#pragma unroll
            for (int m = 0; m < 4; ++m) { bf16_t* rowp = base + (size_t)(row0 + ai * HALF + m * 16) * ldc + col0;
#pragma unroll
                for (int bj = 0; bj < 2; ++bj) { f32x4 v0 = acc[ai][bj][m][0] + bv[bj][0], v1 = acc[ai][bj][m][1] + bv[bj][1];
                    if (ACT == 1) { f32x2 a = gelu_pk((f32x2){v0[0], v0[1]}), b = gelu_pk((f32x2){v0[2], v0[3]}), c = gelu_pk((f32x2){v1[0], v1[1]}), d = gelu_pk((f32x2){v1[2], v1[3]});
                        v0 = (f32x4){a.x, a.y, b.x, b.y}; v1 = (f32x4){c.x, c.y, d.x, d.y}; }
                    v0 = v0 * sc; v1 = v1 * sc; u32x4 w; w.x = cvt_pk_bf16(v0[0], v0[1]); w.y = cvt_pk_bf16(v0[2], v0[3]); w.z = cvt_pk_bf16(v1[0], v1[1]); w.w = cvt_pk_bf16(v1[2], v1[3]);
                    *(u32x4*)(rowp + bj * HALF) = w; } }
    }
};
template <class Epi, class Sched, bool ALIGN_EPI = false, bool SP2 = false>
__device__ __forceinline__ void gemm_phase(PG8_LAS unsigned char* lds, const Gemm g, const Sched& S, const Epi& E) {
    int tid = threadIdx.x; asm volatile("" : "+v"(tid));
    const int wid = __builtin_amdgcn_readfirstlane(tid >> 6), lane = tid & 63, wr = wid >> 2, wc = wid & 3, fr = lane & 15, fq = lane >> 4;
    const int K = g.K, nt = K / BK;
    unsigned voffA[2], voffB[2];
#pragma unroll
    for (int i = 0; i < 2; ++i) { int R, C; stage_rc(tid * 16 + i * 8192, R, C); const int Rb = Epi::PERM ? ((R & ~31) + perm32(R & 31)) : R;
        voffA[i] = (unsigned)(R * K + C) * 2u; voffB[i] = (unsigned)(Rb * K + C) * 2u; }
    const size_t kstep = (size_t)(BK * 2);
    const size_t hstep = (size_t)HALF * K * 2;
    const size_t tstep = 2 * hstep;
    const unsigned ldsw = (unsigned)wid * 1024u;
    const int aoff = lds_byte(wr * 64 + fr, fq * 8), boff = lds_byte(wc * 32 + fr, fq * 8);
#define PG8_SA(b, h) (((b) * 2 + (h)) * HTB)
#define PG8_SB(b, h) ((4 + (b) * 2 + (h)) * HTB)
#define PG8_STAGE(bufoff, gbase, voff) do { _Pragma("unroll") for (int _i = 0; _i < 2; ++_i) \
        __builtin_amdgcn_global_load_lds((const unsigned*)((const char*)(gbase) + (voff)[_i]), (PG8_LAS unsigned*)(lds + (bufoff) + ldsw + _i * 8192), 16, 0, 0); } while (0)
#define PG8_LDA(dst, b, h) do { _Pragma("unroll") for (int m = 0; m < 4; ++m) _Pragma("unroll") for (int k = 0; k < 2; ++k) dst[m][k] = *(const PG8_LAS bf16x8*)(lds + PG8_SA(b, h) + aoff + m * 2048 + k * 1024); } while (0)
#define PG8_LDB(dst, b, h) do { _Pragma("unroll") for (int n = 0; n < 2; ++n) _Pragma("unroll") for (int k = 0; k < 2; ++k) dst[n][k] = *(const PG8_LAS bf16x8*)(lds + PG8_SB(b, h) + boff + n * 2048 + k * 1024); } while (0)
#define PG8_MMA(ai, bj, At, Bt) do { __builtin_amdgcn_s_setprio(1); _Pragma("unroll") for (int m = 0; m < 4; ++m) _Pragma("unroll") for (int n = 0; n < 2; ++n) _Pragma("unroll") for (int k = 0; k < 2; ++k) \
        acc[ai][bj][m][n] = __builtin_amdgcn_mfma_f32_16x16x32_bf16(Bt[n][k], At[m][k], acc[ai][bj][m][n], 0, 0, 0); __builtin_amdgcn_s_setprio(0); } while (0)
#define PG8_WAIT_V(n) asm volatile("s_waitcnt vmcnt(" #n ")" ::: "memory")
#define PG8_WAIT_L(n) asm volatile("s_waitcnt lgkmcnt(" #n ")" ::: "memory")
#define PG8_BAR __builtin_amdgcn_s_barrier()
#define PG8_SCHED __builtin_amdgcn_sched_barrier(0)
    Unit cur, nxt; int ui = 0;
    if (!S.next(0, cur)) return;
    f32x4 acc[2][2][4][2];
#pragma unroll
    for (int a = 0; a < 2; ++a)
#pragma unroll
        for (int b = 0; b < 2; ++b)
#pragma unroll
            for (int m = 0; m < 4; ++m)
#pragma unroll
                for (int n = 0; n < 2; ++n) acc[a][b][m][n] = (f32x4){0.f, 0.f, 0.f, 0.f};
    bf16x8 At[4][2], B0[2][2], B1[2][2];
    const char* cA = (const char*)g.A + (size_t)cur.pm * tstep; const char* cB = (const char*)g.Bt + (size_t)cur.pn * tstep;
    S.a_ready(cur);
    if constexpr (SP2) {
        PG8_STAGE(PG8_SB(0, 0), cB, voffB); PG8_STAGE(PG8_SB(0, 1), cB + hstep, voffB); PG8_STAGE(PG8_SA(0, 0), cA, voffA); PG8_STAGE(PG8_SA(0, 1), cA + hstep, voffA);
        if (wr == 1) PG8_BAR;
        PG8_WAIT_V(2); PG8_BAR;
        PG8_STAGE(PG8_SB(1, 0), cB + kstep, voffB); PG8_STAGE(PG8_SA(1, 0), cA + kstep, voffA); PG8_STAGE(PG8_SB(1, 1), cB + hstep + kstep, voffB);
        PG8_WAIT_V(6); PG8_BAR;
    } else {
        PG8_STAGE(PG8_SB(0, 0), cB, voffB); PG8_STAGE(PG8_SA(0, 0), cA, voffA); PG8_STAGE(PG8_SB(0, 1), cB + hstep, voffB); PG8_STAGE(PG8_SA(0, 1), cA + hstep, voffA);
        if (wr == 1) PG8_BAR;
        PG8_WAIT_V(4); PG8_BAR;
        PG8_STAGE(PG8_SB(1, 0), cB + kstep, voffB); PG8_STAGE(PG8_SA(1, 0), cA + kstep, voffA); PG8_STAGE(PG8_SB(1, 1), cB + hstep + kstep, voffB);
        PG8_WAIT_V(6); PG8_BAR;
    }
    for (;;) {
        const bool has_next = S.next(ui + 1, nxt);
        const char* nA = has_next ? (const char*)g.A + (size_t)nxt.pm * tstep : cA; const char* nB = has_next ? (const char*)g.Bt + (size_t)nxt.pn * tstep : cB;
        for (int t = 0; t < nt; t += 2) {
            const bool last = (t == nt - 2);
            const char* a1 = cA + (size_t)(t + 1) * kstep;
            const char* a2 = last ? nA : cA + (size_t)(t + 2) * kstep; const char* b2 = last ? nB : cB + (size_t)(t + 2) * kstep;
            const char* a3 = a2 + kstep; const char* b3 = b2 + kstep;
            if (last && has_next) S.a_ready(nxt);
            if constexpr (SP2) {
            PG8_LDB(B0, 0, 0); PG8_LDB(B1, 0, 1); PG8_SCHED; PG8_LDA(At, 0, 0); PG8_STAGE(PG8_SA(1, 1), a1 + hstep, voffA);
            PG8_WAIT_V(8); PG8_WAIT_L(0); PG8_BAR; PG8_MMA(0, 0, At, B0); PG8_MMA(0, 1, At, B1); PG8_BAR; PG8_SCHED;
            PG8_LDA(At, 0, 1); PG8_STAGE(PG8_SB(0, 0), b2, voffB); PG8_STAGE(PG8_SB(0, 1), b2 + hstep, voffB); PG8_STAGE(PG8_SA(0, 0), a2, voffA);
            PG8_WAIT_V(8); PG8_WAIT_L(0); PG8_BAR; PG8_MMA(1, 0, At, B0); PG8_MMA(1, 1, At, B1); PG8_BAR; PG8_SCHED;
            PG8_LDB(B0, 1, 0); PG8_LDB(B1, 1, 1); PG8_SCHED; PG8_LDA(At, 1, 0); PG8_STAGE(PG8_SA(0, 1), a2 + hstep, voffA);
            PG8_WAIT_V(8); PG8_WAIT_L(0); PG8_BAR; PG8_MMA(0, 0, At, B0); PG8_MMA(0, 1, At, B1); PG8_BAR; PG8_SCHED;
            PG8_LDA(At, 1, 1); PG8_STAGE(PG8_SB(1, 0), b3, voffB); PG8_STAGE(PG8_SB(1, 1), b3 + hstep, voffB); PG8_STAGE(PG8_SA(1, 0), a3, voffA);
            PG8_WAIT_V(8); PG8_WAIT_L(0); PG8_BAR; PG8_MMA(1, 0, At, B0); PG8_MMA(1, 1, At, B1); PG8_BAR; PG8_SCHED;
            } else {
            PG8_LDB(B0, 0, 0); PG8_SCHED; PG8_LDA(At, 0, 0); PG8_STAGE(PG8_SA(1, 1), a1 + hstep, voffA);
            PG8_WAIT_L(8); PG8_BAR; PG8_WAIT_L(0); PG8_MMA(0, 0, At, B0); PG8_BAR; PG8_SCHED;
            PG8_LDB(B1, 0, 1); PG8_STAGE(PG8_SB(0, 0), b2, voffB);
            PG8_BAR; PG8_WAIT_L(0); PG8_MMA(0, 1, At, B1); PG8_BAR;
            PG8_LDA(At, 0, 1); PG8_STAGE(PG8_SA(0, 0), a2, voffA);
            PG8_BAR; PG8_WAIT_L(0); PG8_MMA(1, 0, At, B0); PG8_BAR; PG8_SCHED;
            PG8_STAGE(PG8_SB(0, 1), b2 + hstep, voffB);
            PG8_WAIT_V(6); PG8_BAR; PG8_MMA(1, 1, At, B1); PG8_BAR;
            PG8_LDB(B0, 1, 0); PG8_SCHED; PG8_LDA(At, 1, 0); PG8_STAGE(PG8_SA(0, 1), a2 + hstep, voffA);
            PG8_WAIT_L(8); PG8_BAR; PG8_WAIT_L(0); PG8_MMA(0, 0, At, B0); PG8_BAR; PG8_SCHED;
            PG8_LDB(B1, 1, 1); PG8_STAGE(PG8_SB(1, 0), b3, voffB);
            PG8_BAR; PG8_WAIT_L(0); PG8_MMA(0, 1, At, B1); PG8_BAR;
            PG8_LDA(At, 1, 1); PG8_STAGE(PG8_SA(1, 0), a3, voffA);
            PG8_BAR; PG8_WAIT_L(0); PG8_MMA(1, 0, At, B0); PG8_BAR; PG8_SCHED;
            PG8_STAGE(PG8_SB(1, 1), b3 + hstep, voffB);
            PG8_WAIT_V(6); PG8_BAR; PG8_MMA(1, 1, At, B1); PG8_BAR;
            }
        }
        if constexpr (ALIGN_EPI) { if (wr == 0) PG8_BAR; }
        if constexpr (!Epi::AFTER_DRAIN) { E(acc, cur, wr, wc, fr, fq); S.done(cur); }
        if (!has_next) break;
#pragma unroll
        for (int a = 0; a < 2; ++a)
#pragma unroll
            for (int b = 0; b < 2; ++b)
#pragma unroll
                for (int m = 0; m < 4; ++m)
#pragma unroll
                    for (int n = 0; n < 2; ++n) acc[a][b][m][n] = (f32x4){0.f, 0.f, 0.f, 0.f};
        cur = nxt; cA = nA; cB = nB; ++ui;
        if constexpr (ALIGN_EPI) { if (wr == 1) PG8_BAR; }
    }
    PG8_WAIT_V(0);
    if constexpr (!ALIGN_EPI) { if (wr == 0) PG8_BAR; }
    PG8_BAR;
    if constexpr (Epi::AFTER_DRAIN) { E.fused(acc, cur, wr, wc, fr, fq, lds, wid, lane); S.done(cur); }
#undef PG8_SA
#undef PG8_SB
#undef PG8_STAGE
#undef PG8_LDA
#undef PG8_LDB
#undef PG8_MMA
#undef PG8_WAIT_V
#undef PG8_WAIT_L
#undef PG8_BAR
#undef PG8_SCHED
}
}

namespace mk {
typedef unsigned short bf16;
typedef short bf16x8 __attribute__((ext_vector_type(8)));
typedef float f32x16 __attribute__((ext_vector_type(16)));
typedef float f32x4 __attribute__((ext_vector_type(4)));
typedef unsigned u32x4 __attribute__((ext_vector_type(4)));
typedef unsigned u32x2 __attribute__((ext_vector_type(2)));

constexpr int BATCH = 8, T = 4096, D = 1024, M = BATCH * T, DEPTH = 2, INC = 7976, FF = 2816, NZ = 5120;
constexpr size_t MiB = 1u << 20;
constexpr size_t WS_W = 1 * MiB, W_LAYER = 40 * MiB;
constexpr size_t OW_IN = 0, OW_G = 10 * MiB, OW_BR = 16 * MiB, OW_OUT = 19 * MiB, OW_GU = 21 * MiB, OW_D = 32 * MiB,
                 OW_C1K = 38 * MiB, OW_C1V = 38 * MiB + 512 * 1024, OW_C2K = 39 * MiB, OW_C2V = 39 * MiB + 256 * 1024;
constexpr size_t WS_KC = 81 * MiB, WS_VC = WS_KC + 512 * 1024;
constexpr size_t WS_H = 82 * MiB, WS_Z = 146 * MiB, SLAB = 32 * MiB, WS_END = WS_Z + 10 * SLAB;
constexpr int LDS_BYTES = 147456;
constexpr float C2 = 0.18033688011112042f;

struct Params { const float* in[23]; float* out; unsigned char* ws; };

__device__ __forceinline__ float bf2f(bf16 v) { return __uint_as_float(((unsigned)v) << 16); }
__device__ __forceinline__ unsigned f2bf(float f) { unsigned u = __float_as_uint(f); return (u + 0x7fffu + ((u >> 16) & 1u)) >> 16; }
__device__ __forceinline__ unsigned pk2(float lo, float hi) { return f2bf(lo) | (f2bf(hi) << 16); }
__device__ __forceinline__ float lo16(unsigned w) { return __uint_as_float(w << 16); }
__device__ __forceinline__ float hi16(unsigned w) { return __uint_as_float(w & 0xffff0000u); }
__device__ __forceinline__ f32x16 mfma32(bf16x8 a, bf16x8 b, f32x16 c) { return __builtin_amdgcn_mfma_f32_32x32x16_bf16(a, b, c, 0, 0, 0); }
__device__ __forceinline__ int crow(int r, int hi) { return (r & 3) + 8 * (r >> 2) + 4 * hi; }
__device__ __forceinline__ float wave_sum(float v) {
#pragma unroll
    for (int o = 1; o < 64; o <<= 1) v += __shfl_xor(v, o);
    return v;
}
__device__ __forceinline__ float sigmoidf_(float x) { return 1.f / (1.f + __expf(-x)); }
__device__ __forceinline__ float siluf_(float x) { return x / (1.f + __expf(-x)); }
#define LDS_WAIT() asm volatile("s_waitcnt lgkmcnt(0)" ::: "memory")
__device__ __forceinline__ int fresh_tid() { int t = threadIdx.x; asm volatile("" : "+v"(t)); return t; }
__device__ __forceinline__ int fresh_bid() { int t = blockIdx.x; asm volatile("" : "+s"(t)); return t; }

template <class F>
__device__ __forceinline__ void wt_convert(F colptr, int ld, int K, int N, bf16* WT, float* scr, int gw, int NGW, int lane) {
    const int nblk = N / 32, nitems = (K / 64) * nblk;
    for (int it = gw; it < nitems; it += NGW) {
        const int kb = it / nblk, nb = it % nblk, k0 = 64 * kb, n0 = 32 * nb;
        const float* cp = colptr(n0 + (lane & 31));
#pragma unroll 8
        for (int i = 0; i < 32; ++i) { const int kk = 2 * i + (lane >> 5); scr[kk * 33 + (lane & 31)] = cp ? cp[(size_t)(k0 + kk) * ld] : 0.f; }
        LDS_WAIT();
        const int c = lane & 7;
#pragma unroll
        for (int j = 0; j < 4; ++j) {
            const int n = (lane >> 3) + 8 * j; const float* s = scr + (8 * c) * 33 + n;
            u32x4 o; o.x = pk2(s[0 * 33], s[1 * 33]); o.y = pk2(s[2 * 33], s[3 * 33]); o.z = pk2(s[4 * 33], s[5 * 33]); o.w = pk2(s[6 * 33], s[7 * 33]);
            *(u32x4*)(WT + (size_t)(n0 + n) * K + k0 + 8 * c) = o;
        }
        LDS_WAIT();
    }
}

__device__ __forceinline__ void convert_weights(const Params& p, char* lds, int gw, int NGW, int wave, int lane) {
    float* scr = (float*)(lds + wave * 8448);
    for (int l = 0; l < DEPTH; ++l) {
        unsigned char* wb = p.ws + WS_W + (size_t)l * W_LAYER;
        const float* win = p.in[2] + (size_t)l * D * INC;
        wt_convert([=](int n) -> const float* {
            const int s = n >> 9, c = n & 511; int src;
            switch (s) { case 0: src = c; break; case 1: src = 512 + c; break; case 2: src = 1536 + c; break; case 3: src = 2048 + c; break; case 4: src = 3088 + c; break;
                         case 5: src = 4112 + c; break; case 6: src = c < 256 ? 4624 + c : (c < 272 ? 3072 + (c - 256) : (c < 296 ? 4880 + (c - 272) : -1)); break;
                         case 7: src = 1024 + c; break; case 8: src = 2560 + c; break; default: src = 3600 + c; break; }
            return src < 0 ? nullptr : win + src; }, INC, D, NZ, (bf16*)(wb + OW_IN), scr, gw, NGW, lane);
        wt_convert([=](int n) -> const float* { return win + 4904 + n; }, INC, D, 3072, (bf16*)(wb + OW_G), scr, gw, NGW, lane);
        for (int b = 0; b < 3; ++b) { const float* w = p.in[14 + b] + (size_t)l * 512 * D;
            wt_convert([=](int n) -> const float* { return w + n; }, D, 512, D, (bf16*)(wb + OW_BR) + (size_t)b * D * 512, scr, gw, NGW, lane); }
        { const float* w = p.in[17] + (size_t)l * D * D; wt_convert([=](int n) -> const float* { return w + n; }, D, D, D, (bf16*)(wb + OW_OUT), scr, gw, NGW, lane); }
        { const float* wg = p.in[19] + (size_t)l * D * FF; const float* wu = p.in[20] + (size_t)l * D * FF;
          wt_convert([=](int n) -> const float* { const int j = n >> 8, i = n & 255; return i < 128 ? wg + 128 * j + i : wu + 128 * j + (i - 128); }, FF, D, 2 * FF, (bf16*)(wb + OW_GU), scr, gw, NGW, lane); }
        { const float* w = p.in[21] + (size_t)l * FF * D; wt_convert([=](int n) -> const float* { return w + n; }, D, FF, D, (bf16*)(wb + OW_D), scr, gw, NGW, lane); }
        { const float* w = p.in[10] + (size_t)l * 2048 * 128; wt_convert([=](int n) -> const float* { return w + n; }, 128, 2048, 128, (bf16*)(wb + OW_C1K), scr, gw, NGW, lane); }
        { const float* w = p.in[12] + (size_t)l * 2048 * 128; wt_convert([=](int n) -> const float* { return w + n; }, 128, 2048, 128, (bf16*)(wb + OW_C1V), scr, gw, NGW, lane); }
        { const float* w = p.in[11] + (size_t)l * 128 * 64; wt_convert([=](int n) -> const float* { return w + n; }, 64, 128, 64, (bf16*)(wb + OW_C2K), scr, gw, NGW, lane); }
        { const float* w = p.in[13] + (size_t)l * 128 * 64; wt_convert([=](int n) -> const float* { return w + n; }, 64, 128, 64, (bf16*)(wb + OW_C2V), scr, gw, NGW, lane); }
    }
}

__device__ __forceinline__ void rms_to_bf16(const float* x, const float* g, bf16* out, int gw, int NGW, int lane) {
    for (int m = gw; m < M; m += NGW) {
        const f32x4* xr = (const f32x4*)(x + (size_t)m * D) + lane; f32x4 v[4]; float s = 0.f;
#pragma unroll
        for (int j = 0; j < 4; ++j) { v[j] = xr[64 * j]; s += (v[j].x * v[j].x + v[j].y * v[j].y) + (v[j].z * v[j].z + v[j].w * v[j].w); }
        const float r = rsqrtf(wave_sum(s) * (1.f / D) + 1e-6f);
        u32x2* o = (u32x2*)(out + (size_t)m * D) + lane;
#pragma unroll
        for (int j = 0; j < 4; ++j) { const f32x4 gg = ((const f32x4*)g)[lane + 64 * j]; u32x2 w; w.x = pk2(v[j].x * r * gg.x, v[j].y * r * gg.y); w.y = pk2(v[j].z * r * gg.z, v[j].w * r * gg.w); o[64 * j] = w; }
    }
}
__device__ __forceinline__ void rms_final(float* x, const float* g, int gw, int NGW, int lane) {
    for (int m = gw; m < M; m += NGW) {
        f32x4* xr = (f32x4*)(x + (size_t)m * D) + lane; f32x4 v[4]; float s = 0.f;
#pragma unroll
        for (int j = 0; j < 4; ++j) { v[j] = xr[64 * j]; s += (v[j].x * v[j].x + v[j].y * v[j].y) + (v[j].z * v[j].z + v[j].w * v[j].w); }
        const float r = rsqrtf(wave_sum(s) * (1.f / D) + 1e-6f);
#pragma unroll
        for (int j = 0; j < 4; ++j) { const f32x4 gg = ((const f32x4*)g)[lane + 64 * j]; xr[64 * j] = v[j] * r * gg; }
    }
}

__device__ __forceinline__ float inv_freq(int i) {
    switch (i) { case 0: return 1.0f; case 1: return 0.19392274474868576f; case 2: return 0.03760603093086393f; case 3: return 0.007292664737217109f;
                 case 4: return 0.001414213562373095f; case 5: return 0.0002742481756762073f; case 6: return 5.318295896944988e-05f; default: return 1.031338537721246e-05f; }
}
__device__ __forceinline__ void rope_cs(int t, int i, float& c, float& s) {
    const float ang = (float)t * inv_freq(i);
    const double rev = (double)ang * 0.15915494309189535; const float fr = (float)(rev - floor(rev));
    s = __builtin_amdgcn_sinf(fr); c = __builtin_amdgcn_cosf(fr);
}

__device__ __forceinline__ void rope_pass(const Params& p, int gw, int NGW, int lane) {
    bf16* Z = (bf16*)(p.ws + WS_Z);
    bf16* q = Z + 9 * (SLAB / 2); bf16* s5 = Z + 5 * (SLAB / 2); bf16* s6 = Z + 6 * (SLAB / 2);
    for (int m = gw; m < M; m += NGW) {
        const int t = m & (T - 1);
        float cl, sl; rope_cs(t, lane & 7, cl, sl);
        float cs[8], sn[8];
#pragma unroll
        for (int i = 0; i < 8; ++i) { cs[i] = __shfl(cl, i); sn[i] = __shfl(sl, i); }
        const int ch = lane & 7;
        {
            u32x4* ptr = (u32x4*)(q + (size_t)m * 512 + 8 * lane); const u32x4 w = *ptr; float v[8], o[8];
#pragma unroll
            for (int e = 0; e < 4; ++e) { v[2 * e] = lo16(w[e]); v[2 * e + 1] = hi16(w[e]); }
#pragma unroll
            for (int e = 0; e < 8; ++e) { const float pv = __shfl_xor(v[e], 1); o[e] = ch == 0 ? v[e] * cs[e] - pv * sn[e] : (ch == 1 ? v[e] * cs[e] + pv * sn[e] : v[e]); o[e] *= C2; }
            u32x4 r; r.x = pk2(o[0], o[1]); r.y = pk2(o[2], o[3]); r.z = pk2(o[4], o[5]); r.w = pk2(o[6], o[7]); *ptr = r;
        }
        {
            bf16* base = lane < 16 ? s5 + (size_t)m * 512 + 256 + 8 * lane : s6 + (size_t)m * 512 + 8 * (lane - 16);
            u32x4* ptr = (u32x4*)base; u32x4 w = (u32x4){0u, 0u, 0u, 0u}; if (lane < 32) w = *ptr; float v[8], o[8];
#pragma unroll
            for (int e = 0; e < 4; ++e) { v[2 * e] = lo16(w[e]); v[2 * e + 1] = hi16(w[e]); }
#pragma unroll
            for (int e = 0; e < 8; ++e) { const float pv = __shfl_xor(v[e], 1); o[e] = ch == 0 ? v[e] * cs[e] - pv * sn[e] : (ch == 1 ? v[e] * cs[e] + pv * sn[e] : v[e]); }
            u32x4 r; r.x = pk2(o[0], o[1]); r.y = pk2(o[2], o[3]); r.z = pk2(o[4], o[5]); r.w = pk2(o[6], o[7]); if (lane < 32) *ptr = r;
        }
    }
}

__device__ __forceinline__ float gelu_tanh(float x) { const float u = 0.7978845608028654f * (x + 0.044715f * x * x * x); const float e = __expf(2.f * u); const float th = 1.f - 2.f / (e + 1.f); return 0.5f * x * (1.f + th); }
__device__ __forceinline__ void compress_task(const Params& p, int layer, int task, char* lds) {
    const int tid = fresh_tid(), lane = tid & 63, w = __builtin_amdgcn_readfirstlane(tid >> 6), r32 = lane & 31, hi = lane >> 5;
    const int kind = task >> 7, rg = task & 127;
    const bf16* s5 = (const bf16*)(p.ws + WS_Z) + 5 * (SLAB / 2);
    const unsigned char* wb = p.ws + WS_W + (size_t)layer * W_LAYER;
    const bf16* w1T = (const bf16*)(wb + (kind ? OW_C1V : OW_C1K)); const bf16* w2T = (const bf16*)(wb + (kind ? OW_C2V : OW_C2K));
    const float* pos = p.in[kind ? 9 : 8] + (size_t)layer * 32 * 64;
    bf16* dst = (bf16*)(p.ws + (kind ? WS_VC : WS_KC));
    float* red = (float*)lds;
    bf16* hid = (bf16*)(lds + 131072);
    const int id = 32 * rg + r32; const bool valid = id < 4080; const int bg = valid ? id / 255 : 0, n = valid ? id % 255 : 0;
    const int b = bg >> 1, g = bg & 1;
    f32x16 acc[4];
#pragma unroll
    for (int i = 0; i < 4; ++i) acc[i] = (f32x16){};
    for (int s = 16 * w; s < 16 * w + 16; ++s) {
        const int j = s >> 2, d0 = 16 * (s & 3) + 8 * hi, tpos = 16 * n + j;
        const u32x4 wz = *(const u32x4*)(s5 + (size_t)(b * T + tpos) * 512 + kind * 128 + g * 64 + d0);
        float v[8];
#pragma unroll
        for (int e = 0; e < 4; ++e) { v[2 * e] = lo16(wz[e]); v[2 * e + 1] = hi16(wz[e]); }
        if (kind == 0 && (s & 3) == 0) {
#pragma unroll
            for (int e = 0; e < 8; ++e) { float c, sn; rope_cs(tpos, e, c, sn); const float pv = __shfl_xor(v[e], 32); v[e] = hi == 0 ? v[e] * c - pv * sn : v[e] * c + pv * sn; }
        }
        const f32x4 p0 = *(const f32x4*)(pos + j * 64 + d0), p1 = *(const f32x4*)(pos + j * 64 + d0 + 4);
        v[0] += p0.x; v[1] += p0.y; v[2] += p0.z; v[3] += p0.w; v[4] += p1.x; v[5] += p1.y; v[6] += p1.z; v[7] += p1.w;
        u32x4 aw; aw.x = pk2(v[0], v[1]); aw.y = pk2(v[2], v[3]); aw.z = pk2(v[4], v[5]); aw.w = pk2(v[6], v[7]);
        if (!valid) aw = (u32x4){0u, 0u, 0u, 0u};
        const bf16x8 a = __builtin_bit_cast(bf16x8, aw);
#pragma unroll
        for (int nb = 0; nb < 4; ++nb) { const bf16x8 bb = *(const bf16x8*)(w1T + (size_t)(32 * nb + r32) * 2048 + 16 * s + 8 * hi); acc[nb] = mfma32(a, bb, acc[nb]); }
    }
#pragma unroll
    for (int nb = 0; nb < 4; ++nb)
#pragma unroll
        for (int r = 0; r < 16; ++r) red[(w * 32 + crow(r, hi)) * 128 + 32 * nb + r32] = acc[nb][r];
    __syncthreads();
    for (int e = tid; e < 4096; e += 512) { float s = 0.f;
#pragma unroll
        for (int ww = 0; ww < 8; ++ww) s += red[ww * 4096 + e];
        hid[(e >> 7) * 136 + (e & 127)] = (bf16)f2bf(gelu_tanh(s)); }
    __syncthreads();
    if (w < 2) {
        f32x16 o = (f32x16){};
#pragma unroll
        for (int s = 0; s < 8; ++s) { const bf16x8 a = *(const bf16x8*)(hid + r32 * 136 + 16 * s + 8 * hi); const bf16x8 bb = *(const bf16x8*)(w2T + (size_t)(32 * w + r32) * 128 + 16 * s + 8 * hi); o = mfma32(a, bb, o); }
#pragma unroll
        for (int r = 0; r < 16; ++r) { const int id2 = 32 * rg + crow(r, hi); if (id2 < 4080) { const int bg2 = id2 / 255, n2 = id2 % 255; dst[((size_t)bg2 * 256 + n2) * 64 + 32 * w + r32] = (bf16)f2bf(o[r]); } }
    }
    __syncthreads();
}

template <int DK, bool HG>
__device__ __forceinline__ void scan_unit(const Params& p, int layer, int b, int h, int slice, char* lds) {
    constexpr int PARTS = 512 / DK, TP = 64 / PARTS, QS = DK + 8, NTS = DK / 32;
    const int tid = fresh_tid(), lane = tid & 63, w = __builtin_amdgcn_readfirstlane(tid >> 6), r32 = lane & 31, hi = lane >> 5;
    bf16* qe = (bf16*)lds; bf16* ke = qe + 64 * QS; bf16* keT = ke + 64 * QS; bf16* VT = keT + DK * 72; bf16* P = VT + 32 * 72; bf16* ST = P + 64 * 72;
    float* tot = (float*)(ST + 32 * QS); float* dec = tot + PARTS * DK;
    bf16* Z = (bf16*)(p.ws + WS_Z);
    const int d = tid % DK, part = tid / DK;
    const bf16 *qsrc, *ksrc; bf16* vsrc; const bf16* glr = Z + 6 * (SLAB / 2) + 256;
    float lb = 0.f, bias = 0.f, w2c[16];
    if (HG) {
        qsrc = Z + 0 * (SLAB / 2) + h * 128 + d; ksrc = Z + 1 * (SLAB / 2) + h * 128 + d; vsrc = Z + 7 * (SLAB / 2) + h * 128 + 32 * slice;
        if (layer == 1) { const float l0 = p.in[3][h * 128 + d], l1 = p.in[3][512 + h * 128 + d]; lb = 1.f / (1.f + __expf(l0 - l1)); }
#pragma unroll
        for (int j = 0; j < 16; ++j) w2c[j] = 0.f;
    } else {
        qsrc = Z + 3 * (SLAB / 2) + h * 64 + d; ksrc = Z + 3 * (SLAB / 2) + 256 + h * 64 + d; vsrc = Z + 8 * (SLAB / 2) + h * 128 + 32 * slice;
        bias = p.in[6][layer * 256 + h * 64 + d];
#pragma unroll
        for (int j = 0; j < 16; ++j) w2c[j] = p.in[5][(size_t)layer * 16 * 256 + j * 256 + h * 64 + d];
    }
    f32x16 S = (f32x16){};
    for (int c = 0; c < T / 64; ++c) {
        const size_t m0 = (size_t)b * T + 64 * c;
        float gl[TP], qv[TP], kv[TP]; float run = 0.f;
#pragma unroll
        for (int ii = 0; ii < TP; ++ii) {
            const size_t row = m0 + part * TP + ii;
            const float xq = bf2f(qsrc[row * 512]), xk = bf2f(ksrc[row * 512]);
            float g;
            if (HG) { const float sg = 1.f / (1.f + __expf(-xk)); const float f = lb + (1.f - lb) * sg; g = __logf(f); kv[ii] = (1.f - lb) / (1.f + __expf(xk)); qv[ii] = siluf_(xq); }
            else { float u = bias; const u32x4 g0 = *(const u32x4*)(glr + row * 512), g1 = *(const u32x4*)(glr + row * 512 + 8);
#pragma unroll
                for (int e = 0; e < 4; ++e) { u += lo16(g0[e]) * w2c[2 * e] + hi16(g0[e]) * w2c[2 * e + 1]; u += lo16(g1[e]) * w2c[8 + 2 * e] + hi16(g1[e]) * w2c[8 + 2 * e + 1]; }
                g = (fminf(u, 0.f) - log1pf(__expf(-fabsf(u)))) * (1.f / 16.f); kv[ii] = xk; qv[ii] = xq * 0.125f; }
            run += g; gl[ii] = run;
        }
        tot[part * DK + d] = run;
        {
            const int s = tid >> 3, v4 = (tid & 7) * 4; const u32x2 wv = *(const u32x2*)(vsrc + (m0 + s) * 512 + v4);
            VT[(v4 + 0) * 72 + s] = (bf16)(wv.x & 0xffffu); VT[(v4 + 1) * 72 + s] = (bf16)(wv.x >> 16); VT[(v4 + 2) * 72 + s] = (bf16)(wv.y & 0xffffu); VT[(v4 + 3) * 72 + s] = (bf16)(wv.y >> 16);
        }
        __syncthreads();
        float off = 0.f, total = 0.f;
#pragma unroll
        for (int pp = 0; pp < PARTS; ++pp) { const float tv = tot[pp * DK + d]; total += tv; if (pp < part) off += tv; }
        if (part == 0) dec[d] = __expf(total);
#pragma unroll
        for (int ii = 0; ii < TP; ++ii) {
            const int i = part * TP + ii; const float bb = off + gl[ii];
            const float eq = __expf(fminf(bb - total, 80.f)), ek = __expf(total - bb);
            const bf16 qb16 = (bf16)f2bf(qv[ii] * eq), kb16 = (bf16)f2bf(kv[ii] * ek);
            qe[i * QS + d] = qb16; ke[i * QS + d] = kb16; keT[d * 72 + i] = kb16;
        }
        __syncthreads();
        if (w < NTS) {
            const float dc = dec[32 * w + r32];
#pragma unroll
            for (int r = 0; r < 16; ++r) { S[r] *= dc; ST[crow(r, hi) * QS + 32 * w + r32] = (bf16)f2bf(S[r]); }
#pragma unroll
            for (int ks = 0; ks < 4; ++ks) { const bf16x8 a = *(const bf16x8*)(VT + r32 * 72 + 16 * ks + 8 * hi); const bf16x8 bb = *(const bf16x8*)(keT + (32 * w + r32) * 72 + 16 * ks + 8 * hi); S = mfma32(a, bb, S); }
        } else if (w < 7) {
            const int ti = w == 4 ? 0 : 1, si = w == 6 ? 1 : 0;
            f32x16 sc = (f32x16){};
#pragma unroll
            for (int ks = 0; ks < DK / 16; ++ks) { const bf16x8 a = *(const bf16x8*)(qe + (32 * ti + r32) * QS + 16 * ks + 8 * hi); const bf16x8 bb = *(const bf16x8*)(ke + (32 * si + r32) * QS + 16 * ks + 8 * hi); sc = mfma32(a, bb, sc); }
#pragma unroll
            for (int r = 0; r < 16; ++r) { const int tt = 32 * ti + crow(r, hi), ss = 32 * si + r32; P[tt * 72 + ss] = (ss <= tt) ? (bf16)f2bf(sc[r]) : (bf16)0; }
        } else {
#pragma unroll
            for (int r = 0; r < 16; ++r) P[crow(r, hi) * 72 + 32 + r32] = (bf16)0;
        }
        __syncthreads();
        if (w < 2) {
            f32x16 o = (f32x16){};
#pragma unroll
            for (int ks = 0; ks < DK / 16; ++ks) { const bf16x8 a = *(const bf16x8*)(qe + (32 * w + r32) * QS + 16 * ks + 8 * hi); const bf16x8 bb = *(const bf16x8*)(ST + r32 * QS + 16 * ks + 8 * hi); o = mfma32(a, bb, o); }
#pragma unroll
            for (int ks = 0; ks < 4; ++ks) { const bf16x8 a = *(const bf16x8*)(P + (32 * w + r32) * 72 + 16 * ks + 8 * hi); const bf16x8 bb = *(const bf16x8*)(VT + r32 * 72 + 16 * ks + 8 * hi); o = mfma32(a, bb, o); }
#pragma unroll
            for (int r = 0; r < 16; ++r) vsrc[(m0 + 32 * w + crow(r, hi)) * 512 + r32] = (bf16)f2bf(o[r]);
        }
        __syncthreads();
    }
}

__device__ __forceinline__ void finish_pass(const Params& p, int layer, int gw, int NGW, int lane) {
    bf16* Z = (bf16*)(p.ws + WS_Z);
    for (int it = gw; it < 2 * M; it += NGW) {
        const int mix = it & 1, m = it >> 1;
        bf16* o = Z + (mix ? 8 : 7) * (SLAB / 2) + (size_t)m * 512 + 8 * lane; const bf16* og = Z + (mix ? 4 : 2) * (SLAB / 2) + (size_t)m * 512 + 8 * lane;
        const float* g = p.in[mix ? 7 : 4] + layer * 512 + 8 * lane;
        const u32x4 wo = *(const u32x4*)o, wg = *(const u32x4*)og; float v[8], gt[8]; float s = 0.f;
#pragma unroll
        for (int e = 0; e < 4; ++e) { v[2 * e] = lo16(wo[e]); v[2 * e + 1] = hi16(wo[e]); gt[2 * e] = lo16(wg[e]); gt[2 * e + 1] = hi16(wg[e]); }
#pragma unroll
        for (int e = 0; e < 8; ++e) s += v[e] * v[e];
        s += __shfl_xor(s, 1); s += __shfl_xor(s, 2); s += __shfl_xor(s, 4); s += __shfl_xor(s, 8);
        const float r = rsqrtf(s * (1.f / 128.f) + 1e-6f);
        const f32x4 g0 = *(const f32x4*)g, g1 = *(const f32x4*)(g + 4); const float gg[8] = {g0.x, g0.y, g0.z, g0.w, g1.x, g1.y, g1.z, g1.w};
        float y[8];
#pragma unroll
        for (int e = 0; e < 8; ++e) y[e] = v[e] * r * gg[e] * siluf_(gt[e]);
        u32x4 w; w.x = pk2(y[0], y[1]); w.y = pk2(y[2], y[3]); w.z = pk2(y[4], y[5]); w.w = pk2(y[6], y[7]); *(u32x4*)o = w;
    }
}

__device__ __forceinline__ void qk_tile(const bf16* Kt, const bf16x8* qr, f32x16& p0, f32x16& p1, int r32, int hi) {
    p0 = (f32x16){}; p1 = (f32x16){};
#pragma unroll
    for (int s = 0; s < 4; ++s) { const bf16x8 a0 = *(const bf16x8*)(Kt + r32 * 72 + 16 * s + 8 * hi), a1 = *(const bf16x8*)(Kt + (32 + r32) * 72 + 16 * s + 8 * hi); p0 = mfma32(a0, qr[s], p0); p1 = mfma32(a1, qr[s], p1); }
}
__device__ __forceinline__ void pv_tile(const bf16* Vt, const f32x16& p0, const f32x16& p1, f32x16* o, int r32, int hi) {
#pragma unroll
    for (int s = 0; s < 4; ++s) {
        u32x4 pw;
#pragma unroll
        for (int i = 0; i < 4; ++i) { const float a = (s < 2) ? p0[8 * (s & 1) + 2 * i] : p1[8 * (s & 1) + 2 * i], bq = (s < 2) ? p0[8 * (s & 1) + 2 * i + 1] : p1[8 * (s & 1) + 2 * i + 1]; pw[i] = pk2(a, bq); }
        const bf16x8 pb = __builtin_bit_cast(bf16x8, pw);
#pragma unroll
        for (int db = 0; db < 2; ++db) { const bf16* vp = Vt + (32 * db + r32) * 72 + 16 * s + 4 * hi; const u32x2 lo = *(const u32x2*)vp, hi8 = *(const u32x2*)(vp + 8);
            u32x4 aw; aw.x = lo.x; aw.y = lo.y; aw.z = hi8.x; aw.w = hi8.y; o[db] = mfma32(__builtin_bit_cast(bf16x8, aw), pb, o[db]); }
    }
}
template <int MODE>
__device__ __forceinline__ void run_tiles(const bf16* Kb, const bf16* Vb, int pitch, int j0, int j1, bf16* Kt, bf16* Vt, const bf16x8* qr, int t, unsigned long long sel,
                                          float& m, float& l, f32x16* o, float mc, float invlc, float* impme, int tid, int r32, int hi) {
    const int key = tid >> 3, ch = tid & 7;
    u32x4 kreg, vreg = (u32x4){0u, 0u, 0u, 0u};
    kreg = *(const u32x4*)(Kb + (size_t)(64 * j0 + key) * pitch + 8 * ch); if (MODE != 0) vreg = *(const u32x4*)(Vb + (size_t)(64 * j0 + key) * pitch + 8 * ch);
    for (int j = j0; j <= j1; ++j) {
        __syncthreads();
        *(u32x4*)(Kt + key * 72 + 8 * ch) = kreg;
        if (MODE != 0) {
#pragma unroll
            for (int e = 0; e < 4; ++e) { Vt[(8 * ch + 2 * e) * 72 + key] = (bf16)(vreg[e] & 0xffffu); Vt[(8 * ch + 2 * e + 1) * 72 + key] = (bf16)(vreg[e] >> 16); }
        }
        if (j < j1) { kreg = *(const u32x4*)(Kb + (size_t)(64 * (j + 1) + key) * pitch + 8 * ch); if (MODE != 0) vreg = *(const u32x4*)(Vb + (size_t)(64 * (j + 1) + key) * pitch + 8 * ch); }
        __syncthreads();
        f32x16 p0, p1; qk_tile(Kt, qr, p0, p1, r32, hi);
        const float NEG = -INFINITY;
        const bool selbit = (sel >> j) & 1ull;
#pragma unroll
        for (int r = 0; r < 16; ++r) {
            const int k0 = 64 * j + crow(r, hi), k1 = k0 + 32; bool ok0, ok1;
            if (MODE <= 1) { ok0 = 16 * k0 + 31 <= t; ok1 = 16 * k1 + 31 <= t; }
            else if (MODE == 2) { ok0 = selbit && k0 <= t; ok1 = selbit && k1 <= t; }
            else { ok0 = k0 <= t && k0 > t - 512; ok1 = k1 <= t && k1 > t - 512; }
            p0[r] = ok0 ? p0[r] : NEG; p1[r] = ok1 ? p1[r] : NEG;
        }
        if (MODE == 1) {
#pragma unroll
            for (int r = 0; r < 16; ++r) { p0[r] = __builtin_amdgcn_exp2f(p0[r] - mc) * invlc; p1[r] = __builtin_amdgcn_exp2f(p1[r] - mc) * invlc; }
#pragma unroll
            for (int half = 0; half < 2; ++half)
#pragma unroll
                for (int g4 = 0; g4 < 4; ++g4) {
                    const float c3 = half ? p1[4 * g4 + 3] : p0[4 * g4 + 3];
                    const float a = half ? (p1[4 * g4] + p1[4 * g4 + 1]) + (p1[4 * g4 + 2] + c3) : (p0[4 * g4] + p0[4 * g4 + 1]) + (p0[4 * g4 + 2] + c3);
                    const float cp = __shfl_xor(c3, 32); const int jj = 16 * j + 8 * half + 2 * g4 + hi;
                    if (hi) impme[jj] += a + cp; else { impme[jj] += a; impme[jj + 2] += cp; }
                }
            pv_tile(Vt, p0, p1, o, r32, hi);
        } else {
            float mx = p0[0];
#pragma unroll
            for (int r = 0; r < 16; ++r) { mx = fmaxf(mx, p0[r]); mx = fmaxf(mx, p1[r]); }
            mx = fmaxf(mx, __shfl_xor(mx, 32));
            const float mn = fmaxf(m, mx), alpha = __builtin_amdgcn_exp2f(m - mn); m = mn;
            float ls = 0.f;
#pragma unroll
            for (int r = 0; r < 16; ++r) { p0[r] = __builtin_amdgcn_exp2f(p0[r] - mn); p1[r] = __builtin_amdgcn_exp2f(p1[r] - mn); ls += p0[r] + p1[r]; }
            l = l * alpha + ls;
            if (MODE != 0) { o[0] *= alpha; o[1] *= alpha; pv_tile(Vt, p0, p1, o, r32, hi); }
        }
    }
}

__device__ __forceinline__ void nsa_unit(const Params& p, int bg, int qb, char* lds) {
    const int tid = fresh_tid(), lane = tid & 63, w = __builtin_amdgcn_readfirstlane(tid >> 6), r32 = lane & 31, hi = lane >> 5;
    const int b = bg >> 1, g = bg & 1;
    bf16* Kt = (bf16*)lds; bf16* Vt = Kt + 64 * 72; float* impw = (float*)(Vt + 64 * 72); unsigned long long* selm = (unsigned long long*)(impw + 8 * 32 * 65);
    bf16* Z = (bf16*)(p.ws + WS_Z);
    bf16* s5 = Z + 5 * (SLAB / 2); bf16* s6 = Z + 6 * (SLAB / 2); bf16* s9 = Z + 9 * (SLAB / 2);
    const bf16* KC = (const bf16*)(p.ws + WS_KC) + (size_t)bg * 256 * 64; const bf16* VC = (const bf16*)(p.ws + WS_VC) + (size_t)bg * 256 * 64;
    const size_t rowb = (size_t)b * T;
    const int hh = g * 4 + (w >> 1), tokl = 32 * (w & 1) + r32, t = 64 * qb + tokl; const size_t mrow = rowb + t;
    bf16x8 qr[4];
#pragma unroll
    for (int s = 0; s < 4; ++s) qr[s] = *(const bf16x8*)(s9 + mrow * 512 + hh * 64 + 16 * s + 8 * hi);
    for (int e = tid; e < 8 * 32 * 65; e += 512) impw[e] = 0.f;
    const bf16* gp = s6 + mrow * 512 + 272 + hh * 3;
    const float gc = sigmoidf_(bf2f(gp[0])), gs = sigmoidf_(bf2f(gp[1])), gwn = sigmoidf_(bf2f(gp[2]));
    f32x16 oacc[2]; oacc[0] = (f32x16){}; oacc[1] = (f32x16){};
    f32x16 o[2];
    float* impme = impw + (w * 32 + r32) * 65;
    const int ntc = (qb >> 4) + 1;
    float mc = -1e30f, lc = 0.f;
    run_tiles<0>(KC, VC, 64, 0, ntc - 1, Kt, Vt, qr, t, 0ull, mc, lc, o, 0.f, 0.f, impme, tid, r32, hi);
    lc += __shfl_xor(lc, 32);
    const float invlc = lc > 0.f ? 1.f / lc : 0.f;
    o[0] = (f32x16){}; o[1] = (f32x16){};
    { float dm = 0.f, dl = 0.f; run_tiles<1>(KC, VC, 64, 0, ntc - 1, Kt, Vt, qr, t, 0ull, dm, dl, o, mc, invlc, impme, tid, r32, hi); }
    oacc[0] += o[0] * gc; oacc[1] += o[1] * gc;
    __syncthreads();
    for (int tk = w; tk < 64; tk += 8) {
        float v = 0.f;
#pragma unroll
        for (int r = 0; r < 4; ++r) v += impw[((2 * r + (tk >> 5)) * 32 + (tk & 31)) * 65 + lane];
        const int cur = qb; const bool valid = lane <= cur, forced = lane == 0 || lane == cur || lane == cur - 1;
        const float sc = valid ? (forced ? 1e9f : v) : -1e9f;
        int rank = 0;
#pragma unroll 4
        for (int i = 0; i < 64; ++i) { const float si = __shfl(sc, i); rank += (si > sc || (si == sc && i < lane)) ? 1 : 0; }
        const unsigned long long mk = __ballot(rank < 16 && sc > -1e8f);
        if (lane == 0) selm[tk] = mk;
    }
    __syncthreads();
    const unsigned long long sel = selm[tokl];
    {
        float ms = -1e30f, ls = 0.f; o[0] = (f32x16){}; o[1] = (f32x16){};
        run_tiles<2>(s5 + rowb * 512 + 256 + g * 64, s5 + rowb * 512 + 384 + g * 64, 512, 0, qb, Kt, Vt, qr, t, sel, ms, ls, o, 0.f, 0.f, impme, tid, r32, hi);
        ls += __shfl_xor(ls, 32); const float sc = gs / ls; oacc[0] += o[0] * sc; oacc[1] += o[1] * sc;
    }
    {
        float ms = -1e30f, ls = 0.f; o[0] = (f32x16){}; o[1] = (f32x16){};
        run_tiles<3>(s6 + rowb * 512 + g * 64, s6 + rowb * 512 + 128 + g * 64, 512, qb > 8 ? qb - 8 : 0, qb, Kt, Vt, qr, t, 0ull, ms, ls, o, 0.f, 0.f, impme, tid, r32, hi);
        ls += __shfl_xor(ls, 32); const float sc = gwn / ls; oacc[0] += o[0] * sc; oacc[1] += o[1] * sc;
    }
#pragma unroll
    for (int db = 0; db < 2; ++db)
#pragma unroll
        for (int rg = 0; rg < 4; ++rg) { u32x2 wv; wv.x = pk2(oacc[db][4 * rg], oacc[db][4 * rg + 1]); wv.y = pk2(oacc[db][4 * rg + 2], oacc[db][4 * rg + 3]);
            *(u32x2*)(s9 + mrow * 512 + hh * 64 + 32 * db + 8 * rg + 4 * hi) = wv; }
    __syncthreads();
}
}

namespace pg8 {
template <int ACT  > struct EpiStore {
    static constexpr bool PERM = true, AFTER_DRAIN = false;
    bf16_t* O; int ldc; int split_cols; size_t split_stride;
    __device__ __forceinline__ void operator()(const f32x4 (&acc)[2][2][4][2], const Unit& u, int wr, int wc, int fr, int fq) const {
        const int row0 = u.pm * BM + wr * 64 + fr; int colt = u.pn * BM; bf16_t* base = O;
        { const int t = colt / split_cols; base += (size_t)t * split_stride; colt -= t * split_cols; }
        const int col0 = colt + wc * 32 + 8 * fq;
#pragma unroll
        for (int ai = 0; ai < 2; ++ai)
#pragma unroll
            for (int m = 0; m < 4; ++m) { bf16_t* rowp = base + (size_t)(row0 + ai * HALF + m * 16) * ldc + col0;
#pragma unroll
                for (int bj = 0; bj < 2; ++bj) { f32x4 v0 = acc[ai][bj][m][0], v1 = acc[ai][bj][m][1];
                    if (ACT == 2) {
#pragma unroll
                        for (int e = 0; e < 4; ++e) { v0[e] = 1.f / (1.f + __expf(-v0[e])); v1[e] = 1.f / (1.f + __expf(-v1[e])); } }
                    u32x4 w; w.x = cvt_pk_bf16(v0[0], v0[1]); w.y = cvt_pk_bf16(v0[2], v0[3]); w.z = cvt_pk_bf16(v1[0], v1[1]); w.w = cvt_pk_bf16(v1[2], v1[3]);
                    *(u32x4*)(rowp + bj * HALF) = w; } }
    }
};
__device__ __forceinline__ float bflo(unsigned w) { return __uint_as_float(w << 16); }
__device__ __forceinline__ float bfhi(unsigned w) { return __uint_as_float(w & 0xffff0000u); }
template <bool FIRST> struct EpiBranch {
    static constexpr bool PERM = true, AFTER_DRAIN = false;
    bf16_t* Mo; const bf16_t* G;
    __device__ __forceinline__ void operator()(const f32x4 (&acc)[2][2][4][2], const Unit& u, int wr, int wc, int fr, int fq) const {
        const int row0 = u.pm * BM + wr * 64 + fr, col0 = u.pn * BM + wc * 32 + 8 * fq;
#pragma unroll
        for (int ai = 0; ai < 2; ++ai)
#pragma unroll
            for (int m = 0; m < 4; ++m) { const size_t off = (size_t)(row0 + ai * HALF + m * 16) * 1024 + col0;
#pragma unroll
                for (int bj = 0; bj < 2; ++bj) { const f32x4 v0 = acc[ai][bj][m][0], v1 = acc[ai][bj][m][1];
                    const u32x4 g = *(const u32x4*)(G + off + bj * HALF);
                    float r[8] = {bflo(g.x) * v0[0], bfhi(g.x) * v0[1], bflo(g.y) * v0[2], bfhi(g.y) * v0[3], bflo(g.z) * v1[0], bfhi(g.z) * v1[1], bflo(g.w) * v1[2], bfhi(g.w) * v1[3]};
                    if (!FIRST) { const u32x4 o = *(const u32x4*)(Mo + off + bj * HALF);
                        r[0] += bflo(o.x); r[1] += bfhi(o.x); r[2] += bflo(o.y); r[3] += bfhi(o.y); r[4] += bflo(o.z); r[5] += bfhi(o.z); r[6] += bflo(o.w); r[7] += bfhi(o.w); }
                    u32x4 w; w.x = cvt_pk_bf16(r[0], r[1]); w.y = cvt_pk_bf16(r[2], r[3]); w.z = cvt_pk_bf16(r[4], r[5]); w.w = cvt_pk_bf16(r[6], r[7]);
                    *(u32x4*)(Mo + off + bj * HALF) = w; } }
    }
};
struct EpiResid {
    static constexpr bool PERM = false, AFTER_DRAIN = false;
    const float* base; float* out;
    __device__ __forceinline__ void operator()(const f32x4 (&acc)[2][2][4][2], const Unit& u, int wr, int wc, int fr, int fq) const {
        const int row0 = u.pm * BM + wr * 64 + fr, col0 = u.pn * BM + wc * 32 + 4 * fq;
#pragma unroll
        for (int ai = 0; ai < 2; ++ai)
#pragma unroll
            for (int m = 0; m < 4; ++m) { const size_t off = (size_t)(row0 + ai * HALF + m * 16) * 1024 + col0;
#pragma unroll
                for (int bj = 0; bj < 2; ++bj)
#pragma unroll
                    for (int n = 0; n < 2; ++n) { const f32x4 bs = *(const f32x4*)(base + off + bj * HALF + n * 16); *(f32x4*)(out + off + bj * HALF + n * 16) = bs + acc[ai][bj][m][n]; } }
    }
};
struct EpiSwiGLU {
    static constexpr bool PERM = true, AFTER_DRAIN = false;
    bf16_t* Hd;
    __device__ __forceinline__ void operator()(const f32x4 (&acc)[2][2][4][2], const Unit& u, int wr, int wc, int fr, int fq) const {
        const int row0 = u.pm * BM + wr * 64 + fr, col0 = u.pn * 128 + wc * 32 + 8 * fq;
#pragma unroll
        for (int ai = 0; ai < 2; ++ai)
#pragma unroll
            for (int m = 0; m < 4; ++m) { float r[8];
#pragma unroll
                for (int n = 0; n < 2; ++n)
#pragma unroll
                    for (int e = 0; e < 4; ++e) { const float gt = acc[ai][0][m][n][e], up = acc[ai][1][m][n][e]; r[4 * n + e] = gt / (1.f + __expf(-gt)) * up; }
                u32x4 w; w.x = cvt_pk_bf16(r[0], r[1]); w.y = cvt_pk_bf16(r[2], r[3]); w.z = cvt_pk_bf16(r[4], r[5]); w.w = cvt_pk_bf16(r[6], r[7]);
                *(u32x4*)(Hd + (size_t)(row0 + ai * HALF + m * 16) * 2816 + col0) = w; }
    }
};
}

#ifndef MK_ONE_LAUNCH
#define MK_ONE_LAUNCH 1
#endif
constexpr int N_PHASES = 1 + 11 * 2;

using namespace mk;
__global__ void __launch_bounds__(512, 2) mk_fwd(Params p, int ph_lo, int ph_hi) {
    extern __shared__ __attribute__((aligned(16))) unsigned char lds_raw[];
    char* lds = (char*)lds_raw;
    PG8_LAS unsigned char* lds3 = (PG8_LAS unsigned char*)lds_raw;
    const int G = gridDim.x, NGW = G * 8;
#define FRESH() const int tid = fresh_tid(), lane = tid & 63, wave = __builtin_amdgcn_readfirstlane(tid >> 6), bid = fresh_bid(), gw = bid * 8 + wave; (void)lane; (void)gw; (void)bid
    unsigned char* ws = p.ws;
    bf16* H = (bf16*)(ws + WS_H); bf16* Z = (bf16*)(ws + WS_Z);
    int ph = 0;
#if MK_ONE_LAUNCH
    cg::grid_group grid = cg::this_grid();
#define SEAM() do { grid.sync(); ++ph; } while (0)
#else
#define SEAM() do { ++ph; } while (0)
#endif
#define RUN (ph >= ph_lo && ph < ph_hi)
    if (RUN) { FRESH();
#ifndef NO_CONV
 convert_weights(p, lds, gw, NGW, wave, lane);
#endif
 rms_to_bf16(p.in[0], p.in[1], H, gw, NGW, lane); }
    SEAM();
    for (int l = 0; l < DEPTH; ++l) {
        const unsigned char* wb = ws + WS_W + (size_t)l * W_LAYER;
        const float* xin = l == 0 ? p.in[0] : p.out;
        if (RUN) { FRESH(); pg8::Gemm g{H, (const bf16*)(wb + OW_IN), M, NZ, D}; pg8::StaticOrder S; S.init(M, NZ, G, bid);
            pg8::EpiStore<0> E{Z, 512, 512, (size_t)M * 512};
#ifndef NO_G1
pg8::gemm_phase<pg8::EpiStore<0>, pg8::StaticOrder, true, true>(lds3, g, S, E);
#endif
 }
        SEAM();
        if (RUN) { FRESH();
#ifndef NO_CMP
 for (int task = bid; task < 256; task += G) compress_task(p, l, task, lds);
#endif
#ifndef NO_ROPE
 rope_pass(p, gw, NGW, lane);
#endif
 }
        SEAM();
        if (RUN) { FRESH();
#ifndef NO_SCAN
            for (int u = bid; u < 256; u += G) { const int bb = (u & 127) >> 4, hh = (u & 15) >> 2, sl = u & 3; if (u < 128) scan_unit<128, true>(p, l, bb, hh, sl, lds); else scan_unit<64, false>(p, l, bb, hh, sl, lds); }
#endif
#ifndef NO_NSA
            for (int vc = bid; vc < 256; vc += G) { const int bg = vc >> 4, s = vc & 15;
                for (int i = 0; i < 4; ++i) { const int qb = i == 0 ? 63 - s : (i == 1 ? 32 + s : (i == 2 ? 31 - s : s)); nsa_unit(p, bg, qb, lds); } }
#endif
        }
        SEAM();
        if (RUN) { FRESH(); finish_pass(p, l, gw, NGW, lane); }
        SEAM();
        if (RUN) { FRESH(); pg8::Gemm g{H, (const bf16*)(wb + OW_G), M, 3072, D}; pg8::StaticOrder S; S.init(M, 3072, G, bid);
            pg8::EpiStore<2> E{Z, 1024, 1024, (size_t)M * 1024};
#ifndef NO_G2
pg8::gemm_phase<pg8::EpiStore<2>, pg8::StaticOrder, true, true>(lds3, g, S, E);
#endif
 }
        SEAM();
        if (RUN) { FRESH();
            pg8::StaticOrder S; S.init(M, D, G, bid);
            { pg8::Gemm g{Z + 7 * (SLAB / 2), (const bf16*)(wb + OW_BR), M, D, 512}; pg8::EpiBranch<true> E{H, Z};
#ifndef NO_G3
pg8::gemm_phase<pg8::EpiBranch<true>, pg8::StaticOrder, true, true>(lds3, g, S, E);
#endif
 }
            asm volatile("s_waitcnt vmcnt(0)" ::: "memory"); __syncthreads();
            { pg8::Gemm g{Z + 8 * (SLAB / 2), (const bf16*)(wb + OW_BR) + (size_t)D * 512, M, D, 512}; pg8::EpiBranch<false> E{H, Z + (size_t)M * 1024};
#ifndef NO_G4
pg8::gemm_phase<pg8::EpiBranch<false>, pg8::StaticOrder, true, true>(lds3, g, S, E);
#endif
 }
            asm volatile("s_waitcnt vmcnt(0)" ::: "memory"); __syncthreads();
            { pg8::Gemm g{Z + 9 * (SLAB / 2), (const bf16*)(wb + OW_BR) + (size_t)2 * D * 512, M, D, 512}; pg8::EpiBranch<false> E{H, Z + (size_t)2 * M * 1024};
#ifndef NO_G5
pg8::gemm_phase<pg8::EpiBranch<false>, pg8::StaticOrder, true, true>(lds3, g, S, E);
#endif
 }
        }
        SEAM();
        if (RUN) { FRESH(); pg8::Gemm g{H, (const bf16*)(wb + OW_OUT), M, D, D}; pg8::StaticOrder S; S.init(M, D, G, bid);
            pg8::EpiResid E{xin, p.out};
#ifndef NO_G6
pg8::gemm_phase<pg8::EpiResid, pg8::StaticOrder, true, true>(lds3, g, S, E);
#endif
 }
        SEAM();
        if (RUN) { FRESH(); rms_to_bf16(p.out, p.in[18] + l * D, H, gw, NGW, lane); }
        SEAM();
        if (RUN) { FRESH(); pg8::Gemm g{H, (const bf16*)(wb + OW_GU), M, 2 * FF, D}; pg8::StaticOrder S; S.init(M, 2 * FF, G, bid);
            pg8::EpiSwiGLU E{Z};
#ifndef NO_G7
pg8::gemm_phase<pg8::EpiSwiGLU, pg8::StaticOrder, true, true>(lds3, g, S, E);
#endif
 }
        SEAM();
        if (RUN) { FRESH(); pg8::Gemm g{Z, (const bf16*)(wb + OW_D), M, D, FF}; pg8::StaticOrder S; S.init(M, D, G, bid);
            pg8::EpiResid E{p.out, p.out};
#ifndef NO_G8
pg8::gemm_phase<pg8::EpiResid, pg8::StaticOrder, true, true>(lds3, g, S, E);
#endif
 }
        SEAM();
        if (RUN) { FRESH(); if (l + 1 < DEPTH) rms_to_bf16(p.out, p.in[1] + (l + 1) * D, H, gw, NGW, lane); else rms_final(p.out, p.in[22], gw, NGW, lane); }
        if (l + 1 < DEPTH) SEAM();
    }
}

extern "C" void kernel_launch(void* const* d_in, const int* in_sizes, int n_in, void* d_out, int out_size, void* d_ws, size_t ws_size, hipStream_t stream) {
    static int grid = 0;
    if (grid == 0) {
        if (n_in != 23 || in_sizes[0] != M * D || out_size != M * D || ws_size < WS_END) { fprintf(stderr, "kernel_launch: unexpected shapes (n_in %d, in0 %d, out %d, ws %zu)\n", n_in, n_in > 0 ? in_sizes[0] : -1, out_size, ws_size); grid = -1; return; }
        int dev = 0, cus = 0, per_cu = 0;
        hipGetDevice(&dev); hipDeviceGetAttribute(&cus, hipDeviceAttributeMultiprocessorCount, dev);
        hipFuncSetAttribute((const void*)mk_fwd, hipFuncAttributeMaxDynamicSharedMemorySize, LDS_BYTES);
        hipOccupancyMaxActiveBlocksPerMultiprocessor(&per_cu, (const void*)mk_fwd, 512, LDS_BYTES);
        (void)hipGetLastError();
        if (per_cu < 1) per_cu = 1;
        grid = cus;
    }
    if (grid < 0) return;
    Params p{};
    for (int i = 0; i < 23; ++i) p.in[i] = (const float*)d_in[i];
    p.out = (float*)d_out; p.ws = (unsigned char*)d_ws;
#if MK_ONE_LAUNCH
    int lo = 0, hi = 1000;
    void* args[] = {&p, &lo, &hi};
    hipError_t e = hipLaunchCooperativeKernel((const void*)mk_fwd, dim3(grid), dim3(512), args, LDS_BYTES, stream);
    if (e != hipSuccess) fprintf(stderr, "cooperative launch failed: %s (grid %d)\n", hipGetErrorString(e), grid);
#else
    for (int ph = 0; ph < N_PHASES; ++ph) hipLaunchKernelGGL(mk_fwd, dim3(grid), dim3(512), LDS_BYTES, stream, p, ph, ph + 1);
#endif
}
```

```cpp
#include <hip/hip_runtime.h>
#include <hip/hip_cooperative_groups.h>
#include <cstdio>
#include <cstdint>
namespace cg = cooperative_groups;
namespace pg8 {
#define PG8_LAS __attribute__((address_space(3)))
typedef unsigned short bf16_t;
typedef short bf16x8 __attribute__((ext_vector_type(8)));
typedef float f32x4 __attribute__((ext_vector_type(4)));
typedef unsigned u32x4 __attribute__((ext_vector_type(4)));
constexpr int BM = 256, BK = 64, HALF = 128, HTB = HALF * BK * 2  , STAGE_BYTES = 8 * HTB, NXCD = 8, WGM = 8;

__host__ __device__ __forceinline__ int lds_byte(int r, int c) { const int st = (r >> 4) * 2 + (c >> 5), rr = r & 15, cc = c & 31, ob = rr * 64 + cc * 2; return st * 1024 + (ob ^ (((ob >> 9) & 1) << 5)); }
__host__ __device__ __forceinline__ void stage_rc(int b, int& R, int& C) { const int st = b / 1024, sb = b % 1024, swz = sb ^ (((sb >> 9) & 1) << 5); R = (st >> 1) * 16 + swz / 64; C = (st & 1) * 32 + (swz % 64) / 2; }
__host__ __device__ __forceinline__ int perm32(int rho) { const int n = rho >> 4, i = rho & 15; return 8 * (i >> 2) + 4 * n + (i & 3); }

struct Unit { int pm, pn; };
struct Gemm { const bf16_t* A; const bf16_t* Bt; int M, N, K; };

struct StaticOrder {
    int nM, nN, nwg, G, c;
    __host__ __device__ void init(int M, int N, int G_, int c_) { nM = M / BM; nN = N / BM; nwg = nM * nN; G = G_; c = c_; }
    __host__ __device__ bool next(int i, Unit& u) const {
        const long L = (long)i * G + c; if (L >= nwg) return false;
        int wgid = (int)L; { const int q = nwg / NXCD, r = nwg % NXCD, xcd = wgid % NXCD, off = wgid / NXCD; wgid = (xcd < r ? xcd * (q + 1) : r * (q + 1) + (xcd - r) * q) + off; }
        const int nig = WGM * nN, gid = wgid / nig, fm = gid * WGM, gsz = (nM - fm) < WGM ? (nM - fm) : WGM;
        u.pm = fm + ((wgid % nig) % gsz); u.pn = (wgid % nig) / gsz; return true;
    }
    __device__ __forceinline__ void a_ready(const Unit&) const {}
    __device__ __forceinline__ void done(const Unit&) const {}
};

__device__ __forceinline__ unsigned cvt_pk_bf16(float lo, float hi) { unsigned r; asm volatile("v_cvt_pk_bf16_f32 %0, %1, %2" : "=v"(r) : "v"(lo), "v"(hi)); return r; }
typedef float f32x2 __attribute__((ext_vector_type(2)));
__device__ __forceinline__ f32x2 gelu_pk(f32x2 v) {
    const f32x2 av = __builtin_elementwise_abs(v), d = av * 0.2316418882f + 1.0f;
    f32x2 t; t.x = __builtin_amdgcn_rcpf(d.x); t.y = __builtin_amdgcn_rcpf(d.y);
    f32x2 q = t * 0.5307027145f + (-0.7265760135f); q = q * t + 0.7107068705f; q = q * t + (-0.142248368f); q = q * t + 0.127414796f; q = q * t;
    const f32x2 s = (v * v) * (-0.72134752044f);
    f32x2 e; e.x = __builtin_amdgcn_exp2f(s.x); e.y = __builtin_amdgcn_exp2f(s.y);
    const f32x2 m = v * (q * e), r = v - m;
    f32x2 o; o.x = v.x < 0.f ? m.x : r.x; o.y = v.y < 0.f ? m.y : r.y; return o;
}

template <int ACT  > struct EpiBf16 {
    static constexpr bool PERM = true, AFTER_DRAIN = false; static_assert(ACT == 0 || ACT == 1, "EpiBf16: ACT is 0 (none) or 1 (gelu_pk)");
    bf16_t* O; int ldc; const float* bias; int split_cols; size_t split_stride; float scale0;
    __device__ __forceinline__ void operator()(const f32x4 (&acc)[2][2][4][2], const Unit& u, int wr, int wc, int fr, int fq) const {
        const int row0 = u.pm * BM + wr * 64 + fr; int colt = u.pn * BM; bf16_t* base = O;
        float sc = 1.f; if (split_cols) { const int t = colt / split_cols; base += (size_t)t * split_stride; colt -= t * split_cols; if (t == 0) sc = scale0; }
        const int col0 = colt + wc * 32 + 8 * fq, bcol0 = u.pn * BM + wc * 32 + 8 * fq;
        f32x4 bv[2][2];
#pragma unroll
        for (int bj = 0; bj < 2; ++bj)
#pragma unroll
            for (int n = 0; n < 2; ++n) bv[bj][n] = bias ? *(const f32x4*)(bias + bcol0 + bj * HALF + 4 * n) : (f32x4){0.f, 0.f, 0.f, 0.f};
#pragma unroll
        for (int ai = 0; ai < 2; ++ai)
#pragma unroll
            for (int m = 0; m < 4; ++m) { bf16_t* rowp = base + (size_t)(row0 + ai * HALF + m * 16) * ldc + col0;
#pragma unroll
                for (int bj = 0; bj < 2; ++bj) { f32x4 v0 = acc[ai][bj][m][0] + bv[bj][0], v1 = acc[ai][bj][m][1] + bv[bj][1];
                    if (ACT == 1) { f32x2 a = gelu_pk((f32x2){v0[0], v0[1]}), b = gelu_pk((f32x2){v0[2], v0[3]}), c = gelu_pk((f32x2){v1[0], v1[1]}), d = gelu_pk((f32x2){v1[2], v1[3]});
                        v0 = (f32x4){a.x, a.y, b.x, b.y}; v1 = (f32x4){c.x, c.y, d.x, d.y}; }
                    v0 = v0 * sc; v1 = v1 * sc; u32x4 w; w.x = cvt_pk_bf16(v0[0], v0[1]); w.y = cvt_pk_bf16(v0[2], v0[3]); w.z = cvt_pk_bf16(v1[0], v1[1]); w.w = cvt_pk_bf16(v1[2], v1[3]);
                    *(u32x4*)(rowp + bj * HALF) = w; } }
    }
};
template <class Epi, class Sched, bool ALIGN_EPI = false, bool SP2 = false>
__device__ __forceinline__ void gemm_phase(PG8_LAS unsigned char* lds, const Gemm g, const Sched& S, const Epi& E) {
    int tid = threadIdx.x; asm volatile("" : "+v"(tid));
    const int wid = __builtin_amdgcn_readfirstlane(tid >> 6), lane = tid & 63, wr = wid >> 2, wc = wid & 3, fr = lane & 15, fq = lane >> 4;
    const int K = g.K, nt = K / BK;
    unsigned voffA[2], voffB[2];
#pragma unroll
    for (int i = 0; i < 2; ++i) { int R, C; stage_rc(tid * 16 + i * 8192, R, C); const int Rb = Epi::PERM ? ((R & ~31) + perm32(R & 31)) : R;
        voffA[i] = (unsigned)(R * K + C) * 2u; voffB[i] = (unsigned)(Rb * K + C) * 2u; }
    const size_t kstep = (size_t)(BK * 2);
    const size_t hstep = (size_t)HALF * K * 2;
    const size_t tstep = 2 * hstep;
    const unsigned ldsw = (unsigned)wid * 1024u;
    const int aoff = lds_byte(wr * 64 + fr, fq * 8), boff = lds_byte(wc * 32 + fr, fq * 8);
#define PG8_SA(b, h) (((b) * 2 + (h)) * HTB)
#define PG8_SB(b, h) ((4 + (b) * 2 + (h)) * HTB)
#define PG8_STAGE(bufoff, gbase, voff) do { _Pragma("unroll") for (int _i = 0; _i < 2; ++_i) \
        __builtin_amdgcn_global_load_lds((const unsigned*)((const char*)(gbase) + (voff)[_i]), (PG8_LAS unsigned*)(lds + (bufoff) + ldsw + _i * 8192), 16, 0, 0); } while (0)
#define PG8_LDA(dst, b, h) do { _Pragma("unroll") for (int m = 0; m < 4; ++m) _Pragma("unroll") for (int k = 0; k < 2; ++k) dst[m][k] = *(const PG8_LAS bf16x8*)(lds + PG8_SA(b, h) + aoff + m * 2048 + k * 1024); } while (0)
#define PG8_LDB(dst, b, h) do { _Pragma("unroll") for (int n = 0; n < 2; ++n) _Pragma("unroll") for (int k = 0; k < 2; ++k) dst[n][k] = *(const PG8_LAS bf16x8*)(lds + PG8_SB(b, h) + boff + n * 2048 + k * 1024); } while (0)
#define PG8_MMA(ai, bj, At, Bt) do { __builtin_amdgcn_s_setprio(1); _Pragma("unroll") for (int m = 0; m < 4; ++m) _Pragma("unroll") for (int n = 0; n < 2; ++n) _Pragma("unroll") for (int k = 0; k < 2; ++k) \
        acc[ai][bj][m][n] = __builtin_amdgcn_mfma_f32_16x16x32_bf16(Bt[n][k], At[m][k], acc[ai][bj][m][n], 0, 0, 0); __builtin_amdgcn_s_setprio(0); } while (0)
#define PG8_WAIT_V(n) asm volatile("s_waitcnt vmcnt(" #n ")" ::: "memory")
#define PG8_WAIT_L(n) asm volatile("s_waitcnt lgkmcnt(" #n ")" ::: "memory")
#define PG8_BAR __builtin_amdgcn_s_barrier()
#define PG8_SCHED __builtin_amdgcn_sched_barrier(0)
    Unit cur, nxt; int ui = 0;
    if (!S.next(0, cur)) return;
    f32x4 acc[2][2][4][2];
#pragma unroll
    for (int a = 0; a < 2; ++a)
#pragma unroll
        for (int b = 0; b < 2; ++b)
#pragma unroll
            for (int m = 0; m < 4; ++m)
#pragma unroll
                for (int n = 0; n < 2; ++n) acc[a][b][m][n] = (f32x4){0.f, 0.f, 0.f, 0.f};
    bf16x8 At[4][2], B0[2][2], B1[2][2];
    const char* cA = (const char*)g.A + (size_t)cur.pm * tstep; const char* cB = (const char*)g.Bt + (size_t)cur.pn * tstep;
    S.a_ready(cur);
    if constexpr (SP2) {
        PG8_STAGE(PG8_SB(0, 0), cB, voffB); PG8_STAGE(PG8_SB(0, 1), cB + hstep, voffB); PG8_STAGE(PG8_SA(0, 0), cA, voffA); PG8_STAGE(PG8_SA(0, 1), cA + hstep, voffA);
        if (wr == 1) PG8_BAR;
        PG8_WAIT_V(2); PG8_BAR;
        PG8_STAGE(PG8_SB(1, 0), cB + kstep, voffB); PG8_STAGE(PG8_SA(1, 0), cA + kstep, voffA); PG8_STAGE(PG8_SB(1, 1), cB + hstep + kstep, voffB);
        PG8_WAIT_V(6); PG8_BAR;
    } else {
        PG8_STAGE(PG8_SB(0, 0), cB, voffB); PG8_STAGE(PG8_SA(0, 0), cA, voffA); PG8_STAGE(PG8_SB(0, 1), cB + hstep, voffB); PG8_STAGE(PG8_SA(0, 1), cA + hstep, voffA);
        if (wr == 1) PG8_BAR;
        PG8_WAIT_V(4); PG8_BAR;
        PG8_STAGE(PG8_SB(1, 0), cB + kstep, voffB); PG8_STAGE(PG8_SA(1, 0), cA + kstep, voffA); PG8_STAGE(PG8_SB(1, 1), cB + hstep + kstep, voffB);
        PG8_WAIT_V(6); PG8_BAR;
    }
    for (;;) {
        const bool has_next = S.next(ui + 1, nxt);
        const char* nA = has_next ? (const char*)g.A + (size_t)nxt.pm * tstep : cA; const char* nB = has_next ? (const char*)g.Bt + (size_t)nxt.pn * tstep : cB;
        for (int t = 0; t < nt; t += 2) {
            const bool last = (t == nt - 2);
            const char* a1 = cA + (size_t)(t + 1) * kstep;
            const char* a2 = last ? nA : cA + (size_t)(t + 2) * kstep; const char* b2 = last ? nB : cB + (size_t)(t + 2) * kstep;
            const char* a3 = a2 + kstep; const char* b3 = b2 + kstep;
            if (last && has_next) S.a_ready(nxt);
            if constexpr (SP2) {
            PG8_LDB(B0, 0, 0); PG8_LDB(B1, 0, 1); PG8_SCHED; PG8_LDA(At, 0, 0); PG8_STAGE(PG8_SA(1, 1), a1 + hstep, voffA);
            PG8_WAIT_V(8); PG8_WAIT_L(0); PG8_BAR; PG8_MMA(0, 0, At, B0); PG8_MMA(0, 1, At, B1); PG8_BAR; PG8_SCHED;
            PG8_LDA(At, 0, 1); PG8_STAGE(PG8_SB(0, 0), b2, voffB); PG8_STAGE(PG8_SB(0, 1), b2 + hstep, voffB); PG8_STAGE(PG8_SA(0, 0), a2, voffA);
            PG8_WAIT_V(8); PG8_WAIT_L(0); PG8_BAR; PG8_MMA(1, 0, At, B0); PG8_MMA(1, 1, At, B1); PG8_BAR; PG8_SCHED;
            PG8_LDB(B0, 1, 0); PG8_LDB(B1, 1, 1); PG8_SCHED; PG8_LDA(At, 1, 0); PG8_STAGE(PG8_SA(0, 1), a2 + hstep, voffA);
            PG8_WAIT_V(8); PG8_WAIT_L(0); PG8_BAR; PG8_MMA(0, 0, At, B0); PG8_MMA(0, 1, At, B1); PG8_BAR; PG8_SCHED;
            PG8_LDA(At, 1, 1); PG8_STAGE(PG8_SB(1, 0), b3, voffB); PG8_STAGE(PG8_SB(1, 1), b3 + hstep, voffB); PG8_STAGE(PG8_SA(1, 0), a3, voffA);
            PG8_WAIT_V(8); PG8_WAIT_L(0); PG8_BAR; PG8_MMA(1, 0, At, B0); PG8_MMA(1, 1, At, B1); PG8_BAR; PG8_SCHED;
            } else {
            PG8_LDB(B0, 0, 0); PG8_SCHED; PG8_LDA(At, 0, 0); PG8_STAGE(PG8_SA(1, 1), a1 + hstep, voffA);
            PG8_WAIT_L(8); PG8_BAR; PG8_WAIT_L(0); PG8_MMA(0, 0, At, B0); PG8_BAR; PG8_SCHED;
            PG8_LDB(B1, 0, 1); PG8_STAGE(PG8_SB(0, 0), b2, voffB);
            PG8_BAR; PG8_WAIT_L(0); PG8_MMA(0, 1, At, B1); PG8_BAR;
            PG8_LDA(At, 0, 1); PG8_STAGE(PG8_SA(0, 0), a2, voffA);
            PG8_BAR; PG8_WAIT_L(0); PG8_MMA(1, 0, At, B0); PG8_BAR; PG8_SCHED;
            PG8_STAGE(PG8_SB(0, 1), b2 + hstep, voffB);
            PG8_WAIT_V(6); PG8_BAR; PG8_MMA(1, 1, At, B1); PG8_BAR;
            PG8_LDB(B0, 1, 0); PG8_SCHED; PG8_LDA(At, 1, 0); PG8_STAGE(PG8_SA(0, 1), a2 + hstep, voffA);
            PG8_WAIT_L(8); PG8_BAR; PG8_WAIT_L(0); PG8_MMA(0, 0, At, B0); PG8_BAR; PG8_SCHED;
            PG8_LDB(B1, 1, 1); PG8_STAGE(PG8_SB(1, 0), b3, voffB);
            PG8_BAR; PG8_WAIT_L(0); PG8_MMA(0, 1, At, B1); PG8_BAR;
            PG8_LDA(At, 1, 1); PG8_STAGE(PG8_SA(1, 0), a3, voffA);
            PG8_BAR; PG8_WAIT_L(0); PG8_MMA(1, 0, At, B0); PG8_BAR; PG8_SCHED;
            PG8_STAGE(PG8_SB(1, 1), b3 + hstep, voffB);
            PG8_WAIT_V(6); PG8_BAR; PG8_MMA(1, 1, At, B1); PG8_BAR;
            }
        }
        if constexpr (ALIGN_EPI) { if (wr == 0) PG8_BAR; }
        if constexpr (!Epi::AFTER_DRAIN) { E(acc, cur, wr, wc, fr, fq); S.done(cur); }
        if (!has_next) break;
#pragma unroll
        for (int a = 0; a < 2; ++a)
#pragma unroll
            for (int b = 0; b < 2; ++b)
#pragma unroll
                for (int m = 0; m < 4; ++m)
#pragma unroll
                    for (int n = 0; n < 2; ++n) acc[a][b][m][n] = (f32x4){0.f, 0.f, 0.f, 0.f};
        cur = nxt; cA = nA; cB = nB; ++ui;
        if constexpr (ALIGN_EPI) { if (wr == 1) PG8_BAR; }
    }
    PG8_WAIT_V(0);
    if constexpr (!ALIGN_EPI) { if (wr == 0) PG8_BAR; }
    PG8_BAR;
    if constexpr (Epi::AFTER_DRAIN) { E.fused(acc, cur, wr, wc, fr, fq, lds, wid, lane); S.done(cur); }
#undef PG8_SA
#undef PG8_SB
#undef PG8_STAGE
#undef PG8_LDA
#undef PG8_LDB
#undef PG8_MMA
#undef PG8_WAIT_V
#undef PG8_WAIT_L
#undef PG8_BAR
#undef PG8_SCHED
}
}

namespace mk {
typedef unsigned short bf16;
typedef short bf16x8 __attribute__((ext_vector_type(8)));
typedef float f32x16 __attribute__((ext_vector_type(16)));
typedef float f32x4 __attribute__((ext_vector_type(4)));
typedef unsigned u32x4 __attribute__((ext_vector_type(4)));
typedef unsigned u32x2 __attribute__((ext_vector_type(2)));

constexpr int BATCH = 8, T = 4096, D = 1024, M = BATCH * T, DEPTH = 2, INC = 7976, FF = 2816, NZ = 5120;
constexpr size_t MiB = 1u << 20;
constexpr size_t WS_W = 1 * MiB, W_LAYER = 40 * MiB;
constexpr size_t OW_IN = 0, OW_G = 10 * MiB, OW_BR = 16 * MiB, OW_OUT = 19 * MiB, OW_GU = 21 * MiB, OW_D = 32 * MiB,
                 OW_C1K = 38 * MiB, OW_C1V = 38 * MiB + 512 * 1024, OW_C2K = 39 * MiB, OW_C2V = 39 * MiB + 256 * 1024;
constexpr size_t WS_KC = 81 * MiB, WS_VC = WS_KC + 512 * 1024;
constexpr size_t WS_H = 82 * MiB, WS_Z = 146 * MiB, SLAB = 32 * MiB, WS_END = WS_Z + 10 * SLAB;
constexpr int LDS_BYTES = 147456;
constexpr float C2 = 0.18033688011112042f;

struct Params { const float* in[23]; float* out; unsigned char* ws; };

__device__ __forceinline__ float bf2f(bf16 v) { return __uint_as_float(((unsigned)v) << 16); }
__device__ __forceinline__ unsigned f2bf(float f) { unsigned u = __float_as_uint(f); return (u + 0x7fffu + ((u >> 16) & 1u)) >> 16; }
__device__ __forceinline__ unsigned pk2(float lo, float hi) { return f2bf(lo) | (f2bf(hi) << 16); }
__device__ __forceinline__ float lo16(unsigned w) { return __uint_as_float(w << 16); }
__device__ __forceinline__ float hi16(unsigned w) { return __uint_as_float(w & 0xffff0000u); }
__device__ __forceinline__ f32x16 mfma32(bf16x8 a, bf16x8 b, f32x16 c) { return __builtin_amdgcn_mfma_f32_32x32x16_bf16(a, b, c, 0, 0, 0); }
__device__ __forceinline__ int crow(int r, int hi) { return (r & 3) + 8 * (r >> 2) + 4 * hi; }
__device__ __forceinline__ float wave_sum(float v) {
#pragma unroll
    for (int o = 1; o < 64; o <<= 1) v += __shfl_xor(v, o);
    return v;
}
__device__ __forceinline__ float sigmoidf_(float x) { return 1.f / (1.f + __expf(-x)); }
__device__ __forceinline__ float siluf_(float x) { return x / (1.f + __expf(-x)); }
#define LDS_WAIT() asm volatile("s_waitcnt lgkmcnt(0)" ::: "memory")
__device__ __forceinline__ int fresh_tid() { int t = threadIdx.x; asm volatile("" : "+v"(t)); return t; }
__device__ __forceinline__ int fresh_bid() { int t = blockIdx.x; asm volatile("" : "+s"(t)); return t; }

template <class F>
__device__ __forceinline__ void wt_convert(F colptr, int ld, int K, int N, bf16* WT, float* scr, int gw, int NGW, int lane) {
    const int nblk = N / 32, nitems = (K / 64) * nblk;
    for (int it = gw; it < nitems; it += NGW) {
        const int kb = it / nblk, nb = it % nblk, k0 = 64 * kb, n0 = 32 * nb;
        const float* cp = colptr(n0 + (lane & 31));
#pragma unroll 8
        for (int i = 0; i < 32; ++i) { const int kk = 2 * i + (lane >> 5); scr[kk * 33 + (lane & 31)] = cp ? cp[(size_t)(k0 + kk) * ld] : 0.f; }
        LDS_WAIT();
        const int c = lane & 7;
#pragma unroll
        for (int j = 0; j < 4; ++j) {
            const int n = (lane >> 3) + 8 * j; const float* s = scr + (8 * c) * 33 + n;
            u32x4 o; o.x = pk2(s[0 * 33], s[1 * 33]); o.y = pk2(s[2 * 33], s[3 * 33]); o.z = pk2(s[4 * 33], s[5 * 33]); o.w = pk2(s[6 * 33], s[7 * 33]);
            *(u32x4*)(WT + (size_t)(n0 + n) * K + k0 + 8 * c) = o;
        }
        LDS_WAIT();
    }
}

__device__ __forceinline__ void convert_weights(const Params& p, char* lds, int gw, int NGW, int wave, int lane) {
    float* scr = (float*)(lds + wave * 8448);
    for (int l = 0; l < DEPTH; ++l) {
        unsigned char* wb = p.ws + WS_W + (size_t)l * W_LAYER;
        const float* win = p.in[2] + (size_t)l * D * INC;
        wt_convert([=](int n) -> const float* {
            const int s = n >> 9, c = n & 511; int src;
            switch (s) { case 0: src = c; break; case 1: src = 512 + c; break; case 2: src = 1536 + c; break; case 3: src = 2048 + c; break; case 4: src = 3088 + c; break;
                         case 5: src = 4112 + c; break; case 6: src = c < 256 ? 4624 + c : (c < 272 ? 3072 + (c - 256) : (c < 296 ? 4880 + (c - 272) : -1)); break;
                         case 7: src = 1024 + c; break; case 8: src = 2560 + c; break; default: src = 3600 + c; break; }
            return src < 0 ? nullptr : win + src; }, INC, D, NZ, (bf16*)(wb + OW_IN), scr, gw, NGW, lane);
        wt_convert([=](int n) -> const float* { return win + 4904 + n; }, INC, D, 3072, (bf16*)(wb + OW_G), scr, gw, NGW, lane);
        for (int b = 0; b < 3; ++b) { const float* w = p.in[14 + b] + (size_t)l * 512 * D;
            wt_convert([=](int n) -> const float* { return w + n; }, D, 512, D, (bf16*)(wb + OW_BR) + (size_t)b * D * 512, scr, gw, NGW, lane); }
        { const float* w = p.in[17] + (size_t)l * D * D; wt_convert([=](int n) -> const float* { return w + n; }, D, D, D, (bf16*)(wb + OW_OUT), scr, gw, NGW, lane); }
        { const float* wg = p.in[19] + (size_t)l * D * FF; const float* wu = p.in[20] + (size_t)l * D * FF;
          wt_convert([=](int n) -> const float* { const int j = n >> 8, i = n & 255; return i < 128 ? wg + 128 * j + i : wu + 128 * j + (i - 128); }, FF, D, 2 * FF, (bf16*)(wb + OW_GU), scr, gw, NGW, lane); }
        { const float* w = p.in[21] + (size_t)l * FF * D; wt_convert([=](int n) -> const float* { return w + n; }, D, FF, D, (bf16*)(wb + OW_D), scr, gw, NGW, lane); }
        { const float* w = p.in[10] + (size_t)l * 2048 * 128; wt_convert([=](int n) -> const float* { return w + n; }, 128, 2048, 128, (bf16*)(wb + OW_C1K), scr, gw, NGW, lane); }
        { const float* w = p.in[12] + (size_t)l * 2048 * 128; wt_convert([=](int n) -> const float* { return w + n; }, 128, 2048, 128, (bf16*)(wb + OW_C1V), scr, gw, NGW, lane); }
        { const float* w = p.in[11] + (size_t)l * 128 * 64; wt_convert([=](int n) -> const float* { return w + n; }, 64, 128, 64, (bf16*)(wb + OW_C2K), scr, gw, NGW, lane); }
        { const float* w = p.in[13] + (size_t)l * 128 * 64; wt_convert([=](int n) -> const float* { return w + n; }, 64, 128, 64, (bf16*)(wb + OW_C2V), scr, gw, NGW, lane); }
    }
}

__device__ __forceinline__ void rms_to_bf16(const float* x, const float* g, bf16* out, int gw, int NGW, int lane) {
    for (int m = gw; m < M; m += NGW) {
        const f32x4* xr = (const f32x4*)(x + (size_t)m * D) + lane; f32x4 v[4]; float s = 0.f;
#pragma unroll
        for (int j = 0; j < 4; ++j) { v[j] = xr[64 * j]; s += (v[j].x * v[j].x + v[j].y * v[j].y) + (v[j].z * v[j].z + v[j].w * v[j].w); }
        const float r = rsqrtf(wave_sum(s) * (1.f / D) + 1e-6f);
        u32x2* o = (u32x2*)(out + (size_t)m * D) + lane;
#pragma unroll
        for (int j = 0; j < 4; ++j) { const f32x4 gg = ((const f32x4*)g)[lane + 64 * j]; u32x2 w; w.x = pk2(v[j].x * r * gg.x, v[j].y * r * gg.y); w.y = pk2(v[j].z * r * gg.z, v[j].w * r * gg.w); o[64 * j] = w; }
    }
}
__device__ __forceinline__ void rms_final(float* x, const float* g, int gw, int NGW, int lane) {
    for (int m = gw; m < M; m += NGW) {
        f32x4* xr = (f32x4*)(x + (size_t)m * D) + lane; f32x4 v[4]; float s = 0.f;
#pragma unroll
        for (int j = 0; j < 4; ++j) { v[j] = xr[64 * j]; s += (v[j].x * v[j].x + v[j].y * v[j].y) + (v[j].z * v[j].z + v[j].w * v[j].w); }
        const float r = rsqrtf(wave_sum(s) * (1.f / D) + 1e-6f);
#pragma unroll
        for (int j = 0; j < 4; ++j) { const f32x4 gg = ((const f32x4*)g)[lane + 64 * j]; xr[64 * j] = v[j] * r * gg; }
    }
}

__device__ __forceinline__ float inv_freq(int i) {
    switch (i) { case 0: return 1.0f; case 1: return 0.19392274474868576f; case 2: return 0.03760603093086393f; case 3: return 0.007292664737217109f;
                 case 4: return 0.001414213562373095f; case 5: return 0.0002742481756762073f; case 6: return 5.318295896944988e-05f; default: return 1.031338537721246e-05f; }
}
__device__ __forceinline__ void rope_cs(int t, int i, float& c, float& s) {
    const float ang = (float)t * inv_freq(i);
    const double rev = (double)ang * 0.15915494309189535; const float fr = (float)(rev - floor(rev));
    s = __builtin_amdgcn_sinf(fr); c = __builtin_amdgcn_cosf(fr);
}

__device__ __forceinline__ void rope_pass(const Params& p, int gw, int NGW, int lane) {
    bf16* Z = (bf16*)(p.ws + WS_Z);
    bf16* q = Z + 9 * (SLAB / 2); bf16* s5 = Z + 5 * (SLAB / 2); bf16* s6 = Z + 6 * (SLAB / 2);
    for (int m = gw; m < M; m += NGW) {
        const int t = m & (T - 1);
        float cl, sl; rope_cs(t, lane & 7, cl, sl);
        float cs[8], sn[8];
#pragma unroll
        for (int i = 0; i < 8; ++i) { cs[i] = __shfl(cl, i); sn[i] = __shfl(sl, i); }
        const int ch = lane & 7;
        {
            u32x4* ptr = (u32x4*)(q + (size_t)m * 512 + 8 * lane); const u32x4 w = *ptr; float v[8], o[8];
#pragma unroll
            for (int e = 0; e < 4; ++e) { v[2 * e] = lo16(w[e]); v[2 * e + 1] = hi16(w[e]); }
#pragma unroll
            for (int e = 0; e < 8; ++e) { const float pv = __shfl_xor(v[e], 1); o[e] = ch == 0 ? v[e] * cs[e] - pv * sn[e] : (ch == 1 ? v[e] * cs[e] + pv * sn[e] : v[e]); o[e] *= C2; }
            u32x4 r; r.x = pk2(o[0], o[1]); r.y = pk2(o[2], o[3]); r.z = pk2(o[4], o[5]); r.w = pk2(o[6], o[7]); *ptr = r;
        }
        {
            bf16* base = lane < 16 ? s5 + (size_t)m * 512 + 256 + 8 * lane : s6 + (size_t)m * 512 + 8 * (lane - 16);
            u32x4* ptr = (u32x4*)base; u32x4 w = (u32x4){0u, 0u, 0u, 0u}; if (lane < 32) w = *ptr; float v[8], o[8];
#pragma unroll
            for (int e = 0; e < 4; ++e) { v[2 * e] = lo16(w[e]); v[2 * e + 1] = hi16(w[e]); }
#pragma unroll
            for (int e = 0; e < 8; ++e) { const float pv = __shfl_xor(v[e], 1); o[e] = ch == 0 ? v[e] * cs[e] - pv * sn[e] : (ch == 1 ? v[e] * cs[e] + pv * sn[e] : v[e]); }
            u32x4 r; r.x = pk2(o[0], o[1]); r.y = pk2(o[2], o[3]); r.z = pk2(o[4], o[5]); r.w = pk2(o[6], o[7]); if (lane < 32) *ptr = r;
        }
    }
}

__device__ __forceinline__ float gelu_tanh(float x) { const float u = 0.7978845608028654f * (x + 0.044715f * x * x * x); const float e = __expf(2.f * u); const float th = 1.f - 2.f / (e + 1.f); return 0.5f * x * (1.f + th); }
__device__ __forceinline__ void compress_task(const Params& p, int layer, int task, char* lds) {
    const int tid = fresh_tid(), lane = tid & 63, w = __builtin_amdgcn_readfirstlane(tid >> 6), r32 = lane & 31, hi = lane >> 5;
    const int kind = task >> 7, rg = task & 127;
    const bf16* s5 = (const bf16*)(p.ws + WS_Z) + 5 * (SLAB / 2);
    const unsigned char* wb = p.ws + WS_W + (size_t)layer * W_LAYER;
    const bf16* w1T = (const bf16*)(wb + (kind ? OW_C1V : OW_C1K)); const bf16* w2T = (const bf16*)(wb + (kind ? OW_C2V : OW_C2K));
    const float* pos = p.in[kind ? 9 : 8] + (size_t)layer * 32 * 64;
    bf16* dst = (bf16*)(p.ws + (kind ? WS_VC : WS_KC));
    float* red = (float*)lds;
    bf16* hid = (bf16*)(lds + 131072);
    const int id = 32 * rg + r32; const bool valid = id < 4080; const int bg = valid ? id / 255 : 0, n = valid ? id % 255 : 0;
    const int b = bg >> 1, g = bg & 1;
    f32x16 acc[4];
#pragma unroll
    for (int i = 0; i < 4; ++i) acc[i] = (f32x16){};
    for (int s = 16 * w; s < 16 * w + 16; ++s) {
        const int j = s >> 2, d0 = 16 * (s & 3) + 8 * hi, tpos = 16 * n + j;
        const u32x4 wz = *(const u32x4*)(s5 + (size_t)(b * T + tpos) * 512 + kind * 128 + g * 64 + d0);
        float v[8];
#pragma unroll
        for (int e = 0; e < 4; ++e) { v[2 * e] = lo16(wz[e]); v[2 * e + 1] = hi16(wz[e]); }
        if (kind == 0 && (s & 3) == 0) {
#pragma unroll
            for (int e = 0; e < 8; ++e) { float c, sn; rope_cs(tpos, e, c, sn); const float pv = __shfl_xor(v[e], 32); v[e] = hi == 0 ? v[e] * c - pv * sn : v[e] * c + pv * sn; }
        }
        const f32x4 p0 = *(const f32x4*)(pos + j * 64 + d0), p1 = *(const f32x4*)(pos + j * 64 + d0 + 4);
        v[0] += p0.x; v[1] += p0.y; v[2] += p0.z; v[3] += p0.w; v[4] += p1.x; v[5] += p1.y; v[6] += p1.z; v[7] += p1.w;
        u32x4 aw; aw.x = pk2(v[0], v[1]); aw.y = pk2(v[2], v[3]); aw.z = pk2(v[4], v[5]); aw.w = pk2(v[6], v[7]);
        if (!valid) aw = (u32x4){0u, 0u, 0u, 0u};
        const bf16x8 a = __builtin_bit_cast(bf16x8, aw);
#pragma unroll
        for (int nb = 0; nb < 4; ++nb) { const bf16x8 bb = *(const bf16x8*)(w1T + (size_t)(32 * nb + r32) * 2048 + 16 * s + 8 * hi); acc[nb] = mfma32(a, bb, acc[nb]); }
    }
#pragma unroll
    for (int nb = 0; nb < 4; ++nb)
#pragma unroll
        for (int r = 0; r < 16; ++r) red[(w * 32 + crow(r, hi)) * 128 + 32 * nb + r32] = acc[nb][r];
    __syncthreads();
    for (int e = tid; e < 4096; e += 512) { float s = 0.f;
#pragma unroll
        for (int ww = 0; ww < 8; ++ww) s += red[ww * 4096 + e];
        hid[(e >> 7) * 136 + (e & 127)] = (bf16)f2bf(gelu_tanh(s)); }
    __syncthreads();
    if (w < 2) {
        f32x16 o = (f32x16){};
#pragma unroll
        for (int s = 0; s < 8; ++s) { const bf16x8 a = *(const bf16x8*)(hid + r32 * 136 + 16 * s + 8 * hi); const bf16x8 bb = *(const bf16x8*)(w2T + (size_t)(32 * w + r32) * 128 + 16 * s + 8 * hi); o = mfma32(a, bb, o); }
#pragma unroll
        for (int r = 0; r < 16; ++r) { const int id2 = 32 * rg + crow(r, hi); if (id2 < 4080) { const int bg2 = id2 / 255, n2 = id2 % 255; dst[((size_t)bg2 * 256 + n2) * 64 + 32 * w + r32] = (bf16)f2bf(o[r]); } }
    }
    __syncthreads();
}

template <int DK, bool HG>
__device__ __forceinline__ void scan_unit(const Params& p, int layer, int b, int h, int slice, char* lds, size_t dst_off) {
    constexpr int PARTS = 512 / DK, TP = 64 / PARTS, QS = DK + 8, NTS = DK / 32;
    const int tid = fresh_tid(), lane = tid & 63, w = __builtin_amdgcn_readfirstlane(tid >> 6), r32 = lane & 31, hi = lane >> 5;
    bf16* qe = (bf16*)lds; bf16* ke = qe + 64 * QS; bf16* keT = ke + 64 * QS; bf16* VT = keT + DK * 72; bf16* P = VT + 32 * 72; bf16* ST = P + 64 * 72;
    float* tot = (float*)(ST + 32 * QS); float* dec = tot + PARTS * DK;
    bf16* Z = (bf16*)(p.ws + WS_Z);
    const int d = tid % DK, part = tid / DK;
    const bf16 *qsrc, *ksrc; bf16* vsrc; const bf16* glr = Z + 6 * (SLAB / 2) + 256;
    float lb = 0.f, bias = 0.f, w2c[16];
    if (HG) {
        qsrc = Z + 0 * (SLAB / 2) + h * 128 + d; ksrc = Z + 1 * (SLAB / 2) + h * 128 + d; vsrc = Z + 7 * (SLAB / 2) + h * 128 + 32 * slice;
        if (layer == 1) { const float l0 = p.in[3][h * 128 + d], l1 = p.in[3][512 + h * 128 + d]; lb = 1.f / (1.f + __expf(l0 - l1)); }
#pragma unroll
        for (int j = 0; j < 16; ++j) w2c[j] = 0.f;
    } else {
        qsrc = Z + 3 * (SLAB / 2) + h * 64 + d; ksrc = Z + 3 * (SLAB / 2) + 256 + h * 64 + d; vsrc = Z + 8 * (SLAB / 2) + h * 128 + 32 * slice;
        bias = p.in[6][layer * 256 + h * 64 + d];
#pragma unroll
        for (int j = 0; j < 16; ++j) w2c[j] = p.in[5][(size_t)layer * 16 * 256 + j * 256 + h * 64 + d];
    }
    f32x16 S = (f32x16){};
    for (int c = 0; c < T / 64; ++c) {
        const size_t m0 = (size_t)b * T + 64 * c;
        float gl[TP], qv[TP], kv[TP]; float run = 0.f;
#pragma unroll
        for (int ii = 0; ii < TP; ++ii) {
            const size_t row = m0 + part * TP + ii;
            const float xq = bf2f(qsrc[row * 512]), xk = bf2f(ksrc[row * 512]);
            float g;
            if (HG) { const float sg = 1.f / (1.f + __expf(-xk)); const float f = lb + (1.f - lb) * sg; g = __logf(f); kv[ii] = (1.f - lb) / (1.f + __expf(xk)); qv[ii] = siluf_(xq); }
            else { float u = bias; const u32x4 g0 = *(const u32x4*)(glr + row * 512), g1 = *(const u32x4*)(glr + row * 512 + 8);
#pragma unroll
                for (int e = 0; e < 4; ++e) { u += lo16(g0[e]) * w2c[2 * e] + hi16(g0[e]) * w2c[2 * e + 1]; u += lo16(g1[e]) * w2c[8 + 2 * e] + hi16(g1[e]) * w2c[8 + 2 * e + 1]; }
                g = (fminf(u, 0.f) - log1pf(__expf(-fabsf(u)))) * (1.f / 16.f); kv[ii] = xk; qv[ii] = xq * 0.125f; }
            run += g; gl[ii] = run;
        }
        tot[part * DK + d] = run;
        {
            const int s = tid >> 3, v4 = (tid & 7) * 4; const u32x2 wv = *(const u32x2*)(vsrc + (m0 + s) * 512 + v4);
            VT[(v4 + 0) * 72 + s] = (bf16)(wv.x & 0xffffu); VT[(v4 + 1) * 72 + s] = (bf16)(wv.x >> 16); VT[(v4 + 2) * 72 + s] = (bf16)(wv.y & 0xffffu); VT[(v4 + 3) * 72 + s] = (bf16)(wv.y >> 16);
        }
        __syncthreads();
        float off = 0.f, total = 0.f;
#pragma unroll
        for (int pp = 0; pp < PARTS; ++pp) { const float tv = tot[pp * DK + d]; total += tv; if (pp < part) off += tv; }
        if (part == 0) dec[d] = __expf(total);
#pragma unroll
        for (int ii = 0; ii < TP; ++ii) {
            const int i = part * TP + ii; const float bb = off + gl[ii];
            const float eq = __expf(fminf(bb - total, 80.f)), ek = __expf(total - bb);
            const bf16 qb16 = (bf16)f2bf(qv[ii] * eq), kb16 = (bf16)f2bf(kv[ii] * ek);
            qe[i * QS + d] = qb16; ke[i * QS + d] = kb16; keT[d * 72 + i] = kb16;
        }
        __syncthreads();
        if (w < NTS) {
            const float dc = dec[32 * w + r32];
#pragma unroll
            for (int r = 0; r < 16; ++r) { S[r] *= dc; ST[crow(r, hi) * QS + 32 * w + r32] = (bf16)f2bf(S[r]); }
#pragma unroll
            for (int ks = 0; ks < 4; ++ks) { const bf16x8 a = *(const bf16x8*)(VT + r32 * 72 + 16 * ks + 8 * hi); const bf16x8 bb = *(const bf16x8*)(keT + (32 * w + r32) * 72 + 16 * ks + 8 * hi); S = mfma32(a, bb, S); }
        } else if (w < 7) {
            const int ti = w == 4 ? 0 : 1, si = w == 6 ? 1 : 0;
            f32x16 sc = (f32x16){};
#pragma unroll
            for (int ks = 0; ks < DK / 16; ++ks) { const bf16x8 a = *(const bf16x8*)(qe + (32 * ti + r32) * QS + 16 * ks + 8 * hi); const bf16x8 bb = *(const bf16x8*)(ke + (32 * si + r32) * QS + 16 * ks + 8 * hi); sc = mfma32(a, bb, sc); }
#pragma unroll
            for (int r = 0; r < 16; ++r) { const int tt = 32 * ti + crow(r, hi), ss = 32 * si + r32; P[tt * 72 + ss] = (ss <= tt) ? (bf16)f2bf(sc[r]) : (bf16)0; }
        } else {
#pragma unroll
            for (int r = 0; r < 16; ++r) P[crow(r, hi) * 72 + 32 + r32] = (bf16)0;
        }
        __syncthreads();
        if (w < 2) {
            f32x16 o = (f32x16){};
#pragma unroll
            for (int ks = 0; ks < DK / 16; ++ks) { const bf16x8 a = *(const bf16x8*)(qe + (32 * w + r32) * QS + 16 * ks + 8 * hi); const bf16x8 bb = *(const bf16x8*)(ST + r32 * QS + 16 * ks + 8 * hi); o = mfma32(a, bb, o); }
#pragma unroll
            for (int ks = 0; ks < 4; ++ks) { const bf16x8 a = *(const bf16x8*)(P + (32 * w + r32) * 72 + 16 * ks + 8 * hi); const bf16x8 bb = *(const bf16x8*)(VT + r32 * 72 + 16 * ks + 8 * hi); o = mfma32(a, bb, o); }
#pragma unroll
            for (int r = 0; r < 16; ++r) vsrc[dst_off + (m0 + 32 * w + crow(r, hi)) * 512 + r32] = (bf16)f2bf(o[r]);
        }
        __syncthreads();
    }
}

__device__ __forceinline__ void finish_pass(const Params& p, int layer, int gw, int NGW, int lane) {
    bf16* Z = (bf16*)(p.ws + WS_Z);
    for (int it = gw; it < 2 * M; it += NGW) {
        const int mix = it & 1, m = it >> 1;
        bf16* o = Z + (mix ? 8 : 7) * (SLAB / 2) + (size_t)m * 512 + 8 * lane; const bf16* og = Z + (mix ? 4 : 2) * (SLAB / 2) + (size_t)m * 512 + 8 * lane;
        const float* g = p.in[mix ? 7 : 4] + layer * 512 + 8 * lane;
        const u32x4 wo = *(const u32x4*)o, wg = *(const u32x4*)og; float v[8], gt[8]; float s = 0.f;
#pragma unroll
        for (int e = 0; e < 4; ++e) { v[2 * e] = lo16(wo[e]); v[2 * e + 1] = hi16(wo[e]); gt[2 * e] = lo16(wg[e]); gt[2 * e + 1] = hi16(wg[e]); }
#pragma unroll
        for (int e = 0; e < 8; ++e) s += v[e] * v[e];
        s += __shfl_xor(s, 1); s += __shfl_xor(s, 2); s += __shfl_xor(s, 4); s += __shfl_xor(s, 8);
        const float r = rsqrtf(s * (1.f / 128.f) + 1e-6f);
        const f32x4 g0 = *(const f32x4*)g, g1 = *(const f32x4*)(g + 4); const float gg[8] = {g0.x, g0.y, g0.z, g0.w, g1.x, g1.y, g1.z, g1.w};
        float y[8];
#pragma unroll
        for (int e = 0; e < 8; ++e) y[e] = v[e] * r * gg[e] * siluf_(gt[e]);
        u32x4 w; w.x = pk2(y[0], y[1]); w.y = pk2(y[2], y[3]); w.z = pk2(y[4], y[5]); w.w = pk2(y[6], y[7]); *(u32x4*)o = w;
    }
}

__device__ __forceinline__ void qk_tile(const bf16* Kt, const bf16x8* qr, f32x16& p0, f32x16& p1, int r32, int hi) {
    p0 = (f32x16){}; p1 = (f32x16){};
#pragma unroll
    for (int s = 0; s < 4; ++s) { const bf16x8 a0 = *(const bf16x8*)(Kt + r32 * 72 + 16 * s + 8 * hi), a1 = *(const bf16x8*)(Kt + (32 + r32) * 72 + 16 * s + 8 * hi); p0 = mfma32(a0, qr[s], p0); p1 = mfma32(a1, qr[s], p1); }
}
__device__ __forceinline__ void pv_tile(const bf16* Vt, const f32x16& p0, const f32x16& p1, f32x16* o, int r32, int hi) {
#pragma unroll
    for (int s = 0; s < 4; ++s) {
        u32x4 pw;
#pragma unroll
        for (int i = 0; i < 4; ++i) { const float a = (s < 2) ? p0[8 * (s & 1) + 2 * i] : p1[8 * (s & 1) + 2 * i], bq = (s < 2) ? p0[8 * (s & 1) + 2 * i + 1] : p1[8 * (s & 1) + 2 * i + 1]; pw[i] = pk2(a, bq); }
        const bf16x8 pb = __builtin_bit_cast(bf16x8, pw);
#pragma unroll
        for (int db = 0; db < 2; ++db) { const bf16* vp = Vt + (32 * db + r32) * 72 + 16 * s + 4 * hi; const u32x2 lo = *(const u32x2*)vp, hi8 = *(const u32x2*)(vp + 8);
            u32x4 aw; aw.x = lo.x; aw.y = lo.y; aw.z = hi8.x; aw.w = hi8.y; o[db] = mfma32(__builtin_bit_cast(bf16x8, aw), pb, o[db]); }
    }
}
template <int MODE>
__device__ __forceinline__ void run_tiles(const bf16* Kb, const bf16* Vb, int pitch, int j0, int j1, bf16* Kt, bf16* Vt, const bf16x8* qr, int t, unsigned long long sel,
                                          float& m, float& l, f32x16* o, float mc, float invlc, float* impme, int tid, int r32, int hi) {
    const int key = tid >> 3, ch = tid & 7;
    u32x4 kreg, vreg = (u32x4){0u, 0u, 0u, 0u};
    kreg = *(const u32x4*)(Kb + (size_t)(64 * j0 + key) * pitch + 8 * ch); if (MODE != 0) vreg = *(const u32x4*)(Vb + (size_t)(64 * j0 + key) * pitch + 8 * ch);
    for (int j = j0; j <= j1; ++j) {
        __syncthreads();
        *(u32x4*)(Kt + key * 72 + 8 * ch) = kreg;
        if (MODE != 0) {
#pragma unroll
            for (int e = 0; e < 4; ++e) { Vt[(8 * ch + 2 * e) * 72 + key] = (bf16)(vreg[e] & 0xffffu); Vt[(8 * ch + 2 * e + 1) * 72 + key] = (bf16)(vreg[e] >> 16); }
        }
        if (j < j1) { kreg = *(const u32x4*)(Kb + (size_t)(64 * (j + 1) + key) * pitch + 8 * ch); if (MODE != 0) vreg = *(const u32x4*)(Vb + (size_t)(64 * (j + 1) + key) * pitch + 8 * ch); }
        __syncthreads();
        f32x16 p0, p1; qk_tile(Kt, qr, p0, p1, r32, hi);
        const float NEG = -INFINITY;
        const bool selbit = (sel >> j) & 1ull;
#pragma unroll
        for (int r = 0; r < 16; ++r) {
            const int k0 = 64 * j + crow(r, hi), k1 = k0 + 32; bool ok0, ok1;
            if (MODE <= 1) { ok0 = 16 * k0 + 31 <= t; ok1 = 16 * k1 + 31 <= t; }
            else if (MODE == 2) { ok0 = selbit && k0 <= t; ok1 = selbit && k1 <= t; }
            else { ok0 = k0 <= t && k0 > t - 512; ok1 = k1 <= t && k1 > t - 512; }
            p0[r] = ok0 ? p0[r] : NEG; p1[r] = ok1 ? p1[r] : NEG;
        }
        if (MODE == 1) {
#pragma unroll
            for (int r = 0; r < 16; ++r) { p0[r] = __builtin_amdgcn_exp2f(p0[r] - mc) * invlc; p1[r] = __builtin_amdgcn_exp2f(p1[r] - mc) * invlc; }
#pragma unroll
            for (int half = 0; half < 2; ++half)
#pragma unroll
                for (int g4 = 0; g4 < 4; ++g4) {
                    const float c3 = half ? p1[4 * g4 + 3] : p0[4 * g4 + 3];
                    const float a = half ? (p1[4 * g4] + p1[4 * g4 + 1]) + (p1[4 * g4 + 2] + c3) : (p0[4 * g4] + p0[4 * g4 + 1]) + (p0[4 * g4 + 2] + c3);
                    const float cp = __shfl_xor(c3, 32); const int jj = 16 * j + 8 * half + 2 * g4 + hi;
                    if (hi) impme[jj] += a + cp; else { impme[jj] += a; impme[jj + 2] += cp; }
                }
            pv_tile(Vt, p0, p1, o, r32, hi);
        } else {
            float mx = p0[0];
#pragma unroll
            for (int r = 0; r < 16; ++r) { mx = fmaxf(mx, p0[r]); mx = fmaxf(mx, p1[r]); }
            mx = fmaxf(mx, __shfl_xor(mx, 32));
            const float mn = fmaxf(m, mx), alpha = __builtin_amdgcn_exp2f(m - mn); m = mn;
            float ls = 0.f;
#pragma unroll
            for (int r = 0; r < 16; ++r) { p0[r] = __builtin_amdgcn_exp2f(p0[r] - mn); p1[r] = __builtin_amdgcn_exp2f(p1[r] - mn); ls += p0[r] + p1[r]; }
            l = l * alpha + ls;
            if (MODE != 0) { o[0] *= alpha; o[1] *= alpha; pv_tile(Vt, p0, p1, o, r32, hi); }
        }
    }
}

__device__ __forceinline__ void nsa_unit(const Params& p, int bg, int qb, char* lds, size_t dst_off) {
    const int tid = fresh_tid(), lane = tid & 63, w = __builtin_amdgcn_readfirstlane(tid >> 6), r32 = lane & 31, hi = lane >> 5;
    const int b = bg >> 1, g = bg & 1;
    bf16* Kt = (bf16*)lds; bf16* Vt = Kt + 64 * 72; float* impw = (float*)(Vt + 64 * 72); unsigned long long* selm = (unsigned long long*)(impw + 8 * 32 * 65);
    bf16* Z = (bf16*)(p.ws + WS_Z);
    bf16* s5 = Z + 5 * (SLAB / 2); bf16* s6 = Z + 6 * (SLAB / 2); bf16* s9 = Z + 9 * (SLAB / 2);
    const bf16* KC = (const bf16*)(p.ws + WS_KC) + (size_t)bg * 256 * 64; const bf16* VC = (const bf16*)(p.ws + WS_VC) + (size_t)bg * 256 * 64;
    const size_t rowb = (size_t)b * T;
    const int hh = g * 4 + (w >> 1), tokl = 32 * (w & 1) + r32, t = 64 * qb + tokl; const size_t mrow = rowb + t;
    bf16x8 qr[4];
#pragma unroll
    for (int s = 0; s < 4; ++s) qr[s] = *(const bf16x8*)(s9 + mrow * 512 + hh * 64 + 16 * s + 8 * hi);
    for (int e = tid; e < 8 * 32 * 65; e += 512) impw[e] = 0.f;
    const bf16* gp = s6 + mrow * 512 + 272 + hh * 3;
    const float gc = sigmoidf_(bf2f(gp[0])), gs = sigmoidf_(bf2f(gp[1])), gwn = sigmoidf_(bf2f(gp[2]));
    f32x16 oacc[2]; oacc[0] = (f32x16){}; oacc[1] = (f32x16){};
    f32x16 o[2];
    float* impme = impw + (w * 32 + r32) * 65;
    const int ntc = (qb >> 4) + 1;
    float mc = -1e30f, lc = 0.f;
    run_tiles<0>(KC, VC, 64, 0, ntc - 1, Kt, Vt, qr, t, 0ull, mc, lc, o, 0.f, 0.f, impme, tid, r32, hi);
    lc += __shfl_xor(lc, 32);
    const float invlc = lc > 0.f ? 1.f / lc : 0.f;
    o[0] = (f32x16){}; o[1] = (f32x16){};
    { float dm = 0.f, dl = 0.f; run_tiles<1>(KC, VC, 64, 0, ntc - 1, Kt, Vt, qr, t, 0ull, dm, dl, o, mc, invlc, impme, tid, r32, hi); }
    oacc[0] += o[0] * gc; oacc[1] += o[1] * gc;
    __syncthreads();
    for (int tk = w; tk < 64; tk += 8) {
        float v = 0.f;
#pragma unroll
        for (int r = 0; r < 4; ++r) v += impw[((2 * r + (tk >> 5)) * 32 + (tk & 31)) * 65 + lane];
        const int cur = qb; const bool valid = lane <= cur, forced = lane == 0 || lane == cur || lane == cur - 1;
        const float sc = valid ? (forced ? 1e9f : v) : -1e9f;
        int rank = 0;
#pragma unroll 4
        for (int i = 0; i < 64; ++i) { const float si = __shfl(sc, i); rank += (si > sc || (si == sc && i < lane)) ? 1 : 0; }
        const unsigned long long mk = __ballot(rank < 16 && sc > -1e8f);
        if (lane == 0) selm[tk] = mk;
    }
    __syncthreads();
    const unsigned long long sel = selm[tokl];
    {
        float ms = -1e30f, ls = 0.f; o[0] = (f32x16){}; o[1] = (f32x16){};
        run_tiles<2>(s5 + rowb * 512 + 256 + g * 64, s5 + rowb * 512 + 384 + g * 64, 512, 0, qb, Kt, Vt, qr, t, sel, ms, ls, o, 0.f, 0.f, impme, tid, r32, hi);
        ls += __shfl_xor(ls, 32); const float sc = gs / ls; oacc[0] += o[0] * sc; oacc[1] += o[1] * sc;
    }
    {
        float ms = -1e30f, ls = 0.f; o[0] = (f32x16){}; o[1] = (f32x16){};
        run_tiles<3>(s6 + rowb * 512 + g * 64, s6 + rowb * 512 + 128 + g * 64, 512, qb > 8 ? qb - 8 : 0, qb, Kt, Vt, qr, t, 0ull, ms, ls, o, 0.f, 0.f, impme, tid, r32, hi);
        ls += __shfl_xor(ls, 32); const float sc = gwn / ls; oacc[0] += o[0] * sc; oacc[1] += o[1] * sc;
    }
#pragma unroll
    for (int db = 0; db < 2; ++db)
#pragma unroll
        for (int rg = 0; rg < 4; ++rg) { u32x2 wv; wv.x = pk2(oacc[db][4 * rg], oacc[db][4 * rg + 1]); wv.y = pk2(oacc[db][4 * rg + 2], oacc[db][4 * rg + 3]);
            *(u32x2*)(s9 + dst_off + mrow * 512 + hh * 64 + 32 * db + 8 * rg + 4 * hi) = wv; }
    __syncthreads();
}
}

namespace pg8 {
template <int ACT  > struct EpiStore {
    static constexpr bool PERM = true, AFTER_DRAIN = false;
    bf16_t* O; int ldc; int split_cols; size_t split_stride;
    __device__ __forceinline__ void operator()(const f32x4 (&acc)[2][2][4][2], const Unit& u, int wr, int wc, int fr, int fq) const {
        const int row0 = u.pm * BM + wr * 64 + fr; int colt = u.pn * BM; bf16_t* base = O;
        { const int t = colt / split_cols; base += (size_t)t * split_stride; colt -= t * split_cols; }
        const int col0 = colt + wc * 32 + 8 * fq;
#pragma unroll
        for (int ai = 0; ai < 2; ++ai)
#pragma unroll
            for (int m = 0; m < 4; ++m) { bf16_t* rowp = base + (size_t)(row0 + ai * HALF + m * 16) * ldc + col0;
#pragma unroll
                for (int bj = 0; bj < 2; ++bj) { f32x4 v0 = acc[ai][bj][m][0], v1 = acc[ai][bj][m][1];
                    if (ACT == 2) {
#pragma unroll
                        for (int e = 0; e < 4; ++e) { v0[e] = 1.f / (1.f + __expf(-v0[e])); v1[e] = 1.f / (1.f + __expf(-v1[e])); } }
                    u32x4 w; w.x = cvt_pk_bf16(v0[0], v0[1]); w.y = cvt_pk_bf16(v0[2], v0[3]); w.z = cvt_pk_bf16(v1[0], v1[1]); w.w = cvt_pk_bf16(v1[2], v1[3]);
                    *(u32x4*)(rowp + bj * HALF) = w; } }
    }
};
__device__ __forceinline__ float bflo(unsigned w) { return __uint_as_float(w << 16); }
__device__ __forceinline__ float bfhi(unsigned w) { return __uint_as_float(w & 0xffff0000u); }
template <bool FIRST> struct EpiBranch {
    static constexpr bool PERM = true, AFTER_DRAIN = false;
    bf16_t* Mo; const bf16_t* G;
    __device__ __forceinline__ void operator()(const f32x4 (&acc)[2][2][4][2], const Unit& u, int wr, int wc, int fr, int fq) const {
        const int row0 = u.pm * BM + wr * 64 + fr, col0 = u.pn * BM + wc * 32 + 8 * fq;
#pragma unroll
        for (int ai = 0; ai < 2; ++ai)
#pragma unroll
            for (int m = 0; m < 4; ++m) { const size_t off = (size_t)(row0 + ai * HALF + m * 16) * 1024 + col0;
#pragma unroll
                for (int bj = 0; bj < 2; ++bj) { const f32x4 v0 = acc[ai][bj][m][0], v1 = acc[ai][bj][m][1];
                    const u32x4 g = *(const u32x4*)(G + off + bj * HALF);
                    float r[8] = {bflo(g.x) * v0[0], bfhi(g.x) * v0[1], bflo(g.y) * v0[2], bfhi(g.y) * v0[3], bflo(g.z) * v1[0], bfhi(g.z) * v1[1], bflo(g.w) * v1[2], bfhi(g.w) * v1[3]};
                    if (!FIRST) { const u32x4 o = *(const u32x4*)(Mo + off + bj * HALF);
                        r[0] += bflo(o.x); r[1] += bfhi(o.x); r[2] += bflo(o.y); r[3] += bfhi(o.y); r[4] += bflo(o.z); r[5] += bfhi(o.z); r[6] += bflo(o.w); r[7] += bfhi(o.w); }
                    u32x4 w; w.x = cvt_pk_bf16(r[0], r[1]); w.y = cvt_pk_bf16(r[2], r[3]); w.z = cvt_pk_bf16(r[4], r[5]); w.w = cvt_pk_bf16(r[6], r[7]);
                    *(u32x4*)(Mo + off + bj * HALF) = w; } }
    }
};
struct EpiResid {
    static constexpr bool PERM = false, AFTER_DRAIN = false;
    const float* base; float* out;
    __device__ __forceinline__ void operator()(const f32x4 (&acc)[2][2][4][2], const Unit& u, int wr, int wc, int fr, int fq) const {
        const int row0 = u.pm * BM + wr * 64 + fr, col0 = u.pn * BM + wc * 32 + 4 * fq;
#pragma unroll
        for (int ai = 0; ai < 2; ++ai)
#pragma unroll
            for (int m = 0; m < 4; ++m) { const size_t off = (size_t)(row0 + ai * HALF + m * 16) * 1024 + col0;
#pragma unroll
                for (int bj = 0; bj < 2; ++bj)
#pragma unroll
                    for (int n = 0; n < 2; ++n) { const f32x4 bs = *(const f32x4*)(base + off + bj * HALF + n * 16); *(f32x4*)(out + off + bj * HALF + n * 16) = bs + acc[ai][bj][m][n]; } }
    }
};
struct EpiSwiGLU {
    static constexpr bool PERM = true, AFTER_DRAIN = false;
    bf16_t* Hd;
    __device__ __forceinline__ void operator()(const f32x4 (&acc)[2][2][4][2], const Unit& u, int wr, int wc, int fr, int fq) const {
        const int row0 = u.pm * BM + wr * 64 + fr, col0 = u.pn * 128 + wc * 32 + 8 * fq;
#pragma unroll
        for (int ai = 0; ai < 2; ++ai)
#pragma unroll
            for (int m = 0; m < 4; ++m) { float r[8];
#pragma unroll
                for (int n = 0; n < 2; ++n)
#pragma unroll
                    for (int e = 0; e < 4; ++e) { const float gt = acc[ai][0][m][n][e], up = acc[ai][1][m][n][e]; r[4 * n + e] = gt / (1.f + __expf(-gt)) * up; }
                u32x4 w; w.x = cvt_pk_bf16(r[0], r[1]); w.y = cvt_pk_bf16(r[2], r[3]); w.z = cvt_pk_bf16(r[4], r[5]); w.w = cvt_pk_bf16(r[6], r[7]);
                *(u32x4*)(Hd + (size_t)(row0 + ai * HALF + m * 16) * 2816 + col0) = w; }
    }
};
}

#define LAS __attribute__((address_space(3)))
#define XB_TMO      128
#define XB_XCNT(j)  (256  + 64 * (j))
#define XB_XSUB(j)  (1280 + 64 * (j))
#define XB_XGEN(j)  (2304 + 64 * (j))
#define XB_TOP      3328
#define XB_TOPGEN   3392
#define XCD_BAR_WORDS 3456
#define XB_SPIN_CAP (1u << 18)

__device__ __forceinline__ unsigned xb_ld(unsigned* p)              { return __hip_atomic_load(p, __ATOMIC_RELAXED, __HIP_MEMORY_SCOPE_AGENT); }
__device__ __forceinline__ unsigned xb_add(unsigned* p, unsigned v) { return __hip_atomic_fetch_add(p, v, __ATOMIC_RELAXED, __HIP_MEMORY_SCOPE_AGENT); }
__device__ __forceinline__ unsigned xb_xcc_id() { return (unsigned)__builtin_amdgcn_s_getreg((3 << 11) | 20) & 0xFu; }
#define XB_SPIN(cond, bar) do { unsigned _sp = 0; while (cond) { __builtin_amdgcn_s_sleep(1); \
    if ((++_sp & 255u) == 0u) { if (xb_ld(&(bar)[XB_TMO])) break; if (_sp > XB_SPIN_CAP) { atomicAdd(&(bar)[XB_TMO], 1u); break; } } } } while (0)

struct XcdBarrier {
    unsigned* bar; unsigned x;
    volatile LAS unsigned* st;
};

__device__ __forceinline__ XcdBarrier xcd_barrier_post(unsigned* bar, volatile LAS unsigned* st) {
    XcdBarrier b; b.bar = bar; b.x = xb_xcc_id(); b.st = st;
    if (threadIdx.x == 0) (void)xb_add(&bar[XB_XCNT(b.x)], 1u);
    return b;
}
__device__ __forceinline__ void xcd_barrier_complete(unsigned* bar, unsigned x, unsigned& nloc, unsigned& nx) {
    const unsigned G = gridDim.x * gridDim.y * gridDim.z;
    unsigned sum, cnt, mine, sp = 0u;
    for (;;) {
        sum = 0u; cnt = 0u; mine = 0u;
#pragma unroll
        for (unsigned j = 0; j < 16; ++j) { const unsigned c = xb_ld(&bar[XB_XCNT(j)]); sum += c; cnt += (c > 0u) ? 1u : 0u; mine = (j == x) ? c : mine; }
        if (sum == G) break;
        __builtin_amdgcn_s_sleep(1);
        if ((++sp & 255u) == 0u) { if (xb_ld(&bar[XB_TMO])) break; if (sp > XB_SPIN_CAP) { atomicAdd(&bar[XB_TMO], 1u); break; } }
    }
    nloc = mine > 0u ? mine : 1u; nx = cnt > 0u ? cnt : 1u;
}

__device__ __forceinline__ void xcd_barrier(const XcdBarrier& b) {
    asm volatile("s_waitcnt vmcnt(0)" ::: "memory");
    __syncthreads();
    if (threadIdx.x == 0) {
        unsigned* bar = b.bar;
        __builtin_amdgcn_s_waitcnt(0);
        unsigned nloc = b.st[0], nx = b.st[1];
        if (nloc == 0u) { xcd_barrier_complete(bar, b.x, nloc, nx); b.st[0] = nloc; b.st[1] = nx; }
        const unsigned old = xb_add(&bar[XB_XSUB(b.x)], 1u);
        const unsigned gen = old / nloc;
        if (old + 1u == (gen + 1u) * nloc) {
            __builtin_amdgcn_fence(__ATOMIC_RELEASE, "agent");
            asm volatile("s_waitcnt vmcnt(0)" ::: "memory");
            const unsigned og = xb_add(&bar[XB_TOP], 1u);
            const unsigned tg = og / nx;
            if (og + 1u == (tg + 1u) * nx) xb_add(&bar[XB_TOPGEN], 1u);
            else XB_SPIN(xb_ld(&bar[XB_TOPGEN]) == tg, bar);
            __builtin_amdgcn_fence(__ATOMIC_ACQUIRE, "agent");
            xb_add(&bar[XB_XGEN(b.x)], 1u);
            asm volatile("s_waitcnt vmcnt(0)" ::: "memory");
        } else {
            XB_SPIN(xb_ld(&bar[XB_XGEN(b.x)]) == gen, bar);
            __builtin_amdgcn_fence(__ATOMIC_ACQUIRE, "agent");
            asm volatile("s_waitcnt vmcnt(0)" ::: "memory");
        }
    }
    __syncthreads();
}

#ifndef PROBE_SCAN
#define PROBE_SCAN 0
#endif
#ifndef PROBE_NSA
#define PROBE_NSA 0
#endif
#ifndef PROBE_GEMM
#define PROBE_GEMM 0
#endif
#ifndef PROBE_SYNC
#define PROBE_SYNC 0
#endif
#ifndef PROBE_EW
#define PROBE_EW 0
#endif
#ifndef MK_ONE_LAUNCH
#define MK_ONE_LAUNCH 1
#endif
constexpr int N_PHASES = 1 + 11 * 2;

using namespace mk;
__global__ void __launch_bounds__(512, 2) mk_fwd(Params p, int ph_lo, int ph_hi) {
    extern __shared__ __attribute__((aligned(16))) unsigned char lds_raw[];
    char* lds = (char*)lds_raw;
    PG8_LAS unsigned char* lds3 = (PG8_LAS unsigned char*)lds_raw;
    const int G = gridDim.x, NGW = G * 8;
#define FRESH() const int tid = fresh_tid(), lane = tid & 63, wave = __builtin_amdgcn_readfirstlane(tid >> 6), bid = fresh_bid(), gw = bid * 8 + wave; (void)lane; (void)gw; (void)bid
    unsigned char* ws = p.ws;
    bf16* H = (bf16*)(ws + WS_H); bf16* Z = (bf16*)(ws + WS_Z);
    int ph = 0;
#if MK_ONE_LAUNCH
    cg::grid_group grid = cg::this_grid();
    { volatile LAS unsigned* st0 = (volatile LAS unsigned*)(lds3 + LDS_BYTES - 64); if (threadIdx.x < 2) st0[threadIdx.x] = 0u; __syncthreads(); }
    XcdBarrier xbar = xcd_barrier_post((unsigned*)ws, (volatile LAS unsigned*)(lds3 + LDS_BYTES - 64));
#define SEAM() do { if (ph == 0) grid.sync(); else xcd_barrier(xbar); for (int q_ = 0; q_ < PROBE_SYNC; ++q_) xcd_barrier(xbar); ++ph; } while (0)
#else
#define SEAM() do { ++ph; } while (0)
#endif
#define RUN (ph >= ph_lo && ph < ph_hi)
    if (RUN) { FRESH();
_Pragma("nounroll") for (int rep = 0; rep < 1 + PROBE_EW; ++rep) {
#ifndef NO_CONV
 convert_weights(p, lds, gw, NGW, wave, lane);
#endif
 rms_to_bf16(p.in[0], p.in[1], H, gw, NGW, lane); } }
    SEAM();
    for (int l = 0; l < DEPTH; ++l) {
        const unsigned char* wb = ws + WS_W + (size_t)l * W_LAYER;
        const float* xin = l == 0 ? p.in[0] : p.out;
        if (RUN) { FRESH(); pg8::Gemm g{H, (const bf16*)(wb + OW_IN), M, NZ, D}; pg8::StaticOrder S; S.init(M, NZ, G, bid);
            pg8::EpiStore<0> E{Z, 512, 512, (size_t)M * 512};
_Pragma("nounroll") for (int rep = 0; rep < 1 + PROBE_GEMM; ++rep)
#ifndef NO_G1
pg8::gemm_phase<pg8::EpiStore<0>, pg8::StaticOrder, true, true>(lds3, g, S, E);
#endif
 }
        SEAM();
        if (RUN) { FRESH();
#ifndef NO_CMP
 for (int task = bid; task < 256; task += G) compress_task(p, l, task, lds);
#endif
#ifndef NO_ROPE
 rope_pass(p, gw, NGW, lane);
#endif
 }
        SEAM();
        if (RUN) { FRESH();
_Pragma("nounroll")          for (int rep = 0; rep < 1 + PROBE_SCAN; ++rep) { const size_t sc_off7 = (PROBE_SCAN && rep == 0) ? (WS_END - (WS_Z + 7 * SLAB)) / 2 : 0, sc_off8 = (PROBE_SCAN && rep == 0) ? (WS_END - (WS_Z + 8 * SLAB)) / 2 : 0;
#ifndef NO_SCAN
            for (int u = bid; u < 256; u += G) { const int bb = (u & 127) >> 4, hh = (u & 15) >> 2, sl = u & 3; if (u < 128) scan_unit<128, true>(p, l, bb, hh, sl, lds, sc_off7); else scan_unit<64, false>(p, l, bb, hh, sl, lds, sc_off8); }
#endif
          }
_Pragma("nounroll")          for (int rep = 0; rep < 1 + PROBE_NSA; ++rep) { const size_t ns_off = (PROBE_NSA && rep == 0) ? (WS_END - (WS_Z + 9 * SLAB)) / 2 : 0;
#ifndef NO_NSA
            for (int vc = bid; vc < 256; vc += G) { const int bg = vc >> 4, s = vc & 15;
                for (int i = 0; i < 4; ++i) { const int qb = i == 0 ? 63 - s : (i == 1 ? 32 + s : (i == 2 ? 31 - s : s)); nsa_unit(p, bg, qb, lds, ns_off); } }
#endif
          }
        }
        SEAM();
        if (RUN) { FRESH(); finish_pass(p, l, gw, NGW, lane); }
        SEAM();
        if (RUN) { FRESH(); pg8::Gemm g{H, (const bf16*)(wb + OW_G), M, 3072, D}; pg8::StaticOrder S; S.init(M, 3072, G, bid);
            pg8::EpiStore<2> E{Z, 1024, 1024, (size_t)M * 1024};
_Pragma("nounroll") for (int rep = 0; rep < 1 + PROBE_GEMM; ++rep)
#ifndef NO_G2
pg8::gemm_phase<pg8::EpiStore<2>, pg8::StaticOrder, true, true>(lds3, g, S, E);
#endif
 }
        SEAM();
        if (RUN) { FRESH();
            pg8::StaticOrder S; S.init(M, D, G, bid);
_Pragma("nounroll") for (int rep = 0; rep < 1 + PROBE_GEMM; ++rep) {
            { pg8::Gemm g{Z + 7 * (SLAB / 2), (const bf16*)(wb + OW_BR), M, D, 512}; pg8::EpiBranch<true> E{H, Z};
#ifndef NO_G3
pg8::gemm_phase<pg8::EpiBranch<true>, pg8::StaticOrder, true, true>(lds3, g, S, E);
#endif
 }
            asm volatile("s_waitcnt vmcnt(0)" ::: "memory"); __syncthreads();
            { pg8::Gemm g{Z + 8 * (SLAB / 2), (const bf16*)(wb + OW_BR) + (size_t)D * 512, M, D, 512}; pg8::EpiBranch<false> E{H, Z + (size_t)M * 1024};
#ifndef NO_G4
pg8::gemm_phase<pg8::EpiBranch<false>, pg8::StaticOrder, true, true>(lds3, g, S, E);
#endif
 }
            asm volatile("s_waitcnt vmcnt(0)" ::: "memory"); __syncthreads();
            { pg8::Gemm g{Z + 9 * (SLAB / 2), (const bf16*)(wb + OW_BR) + (size_t)2 * D * 512, M, D, 512}; pg8::EpiBranch<false> E{H, Z + (size_t)2 * M * 1024};
#ifndef NO_G5
pg8::gemm_phase<pg8::EpiBranch<false>, pg8::StaticOrder, true, true>(lds3, g, S, E);
#endif
 }
            if (rep < PROBE_GEMM) { asm volatile("s_waitcnt vmcnt(0)" ::: "memory"); __syncthreads(); } }
        }
        SEAM();
        if (RUN) { FRESH(); pg8::Gemm g{H, (const bf16*)(wb + OW_OUT), M, D, D}; pg8::StaticOrder S; S.init(M, D, G, bid);
            pg8::EpiResid E{xin, p.out};
#ifndef NO_G6
pg8::gemm_phase<pg8::EpiResid, pg8::StaticOrder, true, true>(lds3, g, S, E);
#endif
 }
        SEAM();
        if (RUN) { FRESH(); _Pragma("nounroll") for (int rep = 0; rep < 1 + PROBE_EW; ++rep) rms_to_bf16(p.out, p.in[18] + l * D, H, gw, NGW, lane); }
        SEAM();
        if (RUN) { FRESH(); pg8::Gemm g{H, (const bf16*)(wb + OW_GU), M, 2 * FF, D}; pg8::StaticOrder S; S.init(M, 2 * FF, G, bid);
            pg8::EpiSwiGLU E{Z};
_Pragma("nounroll") for (int rep = 0; rep < 1 + PROBE_GEMM; ++rep)
#ifndef NO_G7
pg8::gemm_phase<pg8::EpiSwiGLU, pg8::StaticOrder, true, true>(lds3, g, S, E);
#endif
 }
        SEAM();
        if (RUN) { FRESH(); pg8::Gemm g{Z, (const bf16*)(wb + OW_D), M, D, FF}; pg8::StaticOrder S; S.init(M, D, G, bid);
            pg8::EpiResid E{p.out, p.out};
#ifndef NO_G8
pg8::gemm_phase<pg8::EpiResid, pg8::StaticOrder, true, true>(lds3, g, S, E);
#endif
 }
        SEAM();
        if (RUN) { FRESH(); if (l + 1 < DEPTH) rms_to_bf16(p.out, p.in[1] + (l + 1) * D, H, gw, NGW, lane); else rms_final(p.out, p.in[22], gw, NGW, lane); }
        if (l + 1 < DEPTH) SEAM();
    }
}

extern "C" void kernel_launch(void* const* d_in, const int* in_sizes, int n_in, void* d_out, int out_size, void* d_ws, size_t ws_size, hipStream_t stream) {
    static int grid = 0;
    if (grid == 0) {
        if (n_in != 23 || in_sizes[0] != M * D || out_size != M * D || ws_size < WS_END) { fprintf(stderr, "kernel_launch: unexpected shapes (n_in %d, in0 %d, out %d, ws %zu)\n", n_in, n_in > 0 ? in_sizes[0] : -1, out_size, ws_size); grid = -1; return; }
        int dev = 0, cus = 0, per_cu = 0;
        hipGetDevice(&dev); hipDeviceGetAttribute(&cus, hipDeviceAttributeMultiprocessorCount, dev);
        hipFuncSetAttribute((const void*)mk_fwd, hipFuncAttributeMaxDynamicSharedMemorySize, LDS_BYTES);
        hipOccupancyMaxActiveBlocksPerMultiprocessor(&per_cu, (const void*)mk_fwd, 512, LDS_BYTES);
        (void)hipGetLastError();
        if (per_cu < 1) per_cu = 1;
        grid = cus;
    }
    if (grid < 0) return;
    Params p{};
    for (int i = 0; i < 23; ++i) p.in[i] = (const float*)d_in[i];
    p.out = (float*)d_out; p.ws = (unsigned char*)d_ws;
#if MK_ONE_LAUNCH
    int lo = 0, hi = 1000;
    void* args[] = {&p, &lo, &hi};
    if (hipMemsetAsync(d_ws, 0, 65536, stream) != hipSuccess) { fprintf(stderr, "memset failed\n"); return; }
    hipError_t e = hipLaunchCooperativeKernel((const void*)mk_fwd, dim3(grid), dim3(512), args, LDS_BYTES, stream);
    if (e != hipSuccess) fprintf(stderr, "cooperative launch failed: %s (grid %d)\n", hipGetErrorString(e), grid);
#else
    for (int ph = 0; ph < N_PHASES; ++ph) hipLaunchKernelGGL(mk_fwd, dim3(grid), dim3(512), LDS_BYTES, stream, p, ph, ph + 1);
#endif
}
```

```cpp
#include <hip/hip_runtime.h>
#include <hip/hip_cooperative_groups.h>
#include <cstdio>
#include <cstdint>
namespace cg = cooperative_groups;
namespace pg8 {
#define PG8_LAS __attribute__((address_space(3)))
typedef unsigned short bf16_t;
typedef short bf16x8 __attribute__((ext_vector_type(8)));
typedef float f32x4 __attribute__((ext_vector_type(4)));
typedef unsigned u32x4 __attribute__((ext_vector_type(4)));
constexpr int BM = 256, BK = 64, HALF = 128, HTB = HALF * BK * 2  , STAGE_BYTES = 8 * HTB, NXCD = 8, WGM = 8;

__host__ __device__ __forceinline__ int lds_byte(int r, int c) { const int st = (r >> 4) * 2 + (c >> 5), rr = r & 15, cc = c & 31, ob = rr * 64 + cc * 2; return st * 1024 + (ob ^ (((ob >> 9) & 1) << 5)); }
__host__ __device__ __forceinline__ void stage_rc(int b, int& R, int& C) { const int st = b / 1024, sb = b % 1024, swz = sb ^ (((sb >> 9) & 1) << 5); R = (st >> 1) * 16 + swz / 64; C = (st & 1) * 32 + (swz % 64) / 2; }
__host__ __device__ __forceinline__ int perm32(int rho) { const int n = rho >> 4, i = rho & 15; return 8 * (i >> 2) + 4 * n + (i & 3); }

struct Unit { int pm, pn; };
struct Gemm { const bf16_t* A; const bf16_t* Bt; int M, N, K; };

struct StaticOrder {
    int nM, nN, nwg, G, c;
    __host__ __device__ void init(int M, int N, int G_, int c_) { nM = M / BM; nN = N / BM; nwg = nM * nN; G = G_; c = c_; }
    __host__ __device__ bool next(int i, Unit& u) const {
        const long L = (long)i * G + c; if (L >= nwg) return false;
        int wgid = (int)L; { const int q = nwg / NXCD, r = nwg % NXCD, xcd = wgid % NXCD, off = wgid / NXCD; wgid = (xcd < r ? xcd * (q + 1) : r * (q + 1) + (xcd - r) * q) + off; }
        const int nig = WGM * nN, gid = wgid / nig, fm = gid * WGM, gsz = (nM - fm) < WGM ? (nM - fm) : WGM;
        u.pm = fm + ((wgid % nig) % gsz); u.pn = (wgid % nig) / gsz; return true;
    }
    __device__ __forceinline__ void a_ready(const Unit&) const {}
    __device__ __forceinline__ void done(const Unit&) const {}
};

__device__ __forceinline__ unsigned cvt_pk_bf16(float lo, float hi) { unsigned r; asm volatile("v_cvt_pk_bf16_f32 %0, %1, %2" : "=v"(r) : "v"(lo), "v"(hi)); return r; }
typedef float f32x2 __attribute__((ext_vector_type(2)));
__device__ __forceinline__ f32x2 gelu_pk(f32x2 v) {
    const f32x2 av = __builtin_elementwise_abs(v), d = av * 0.2316418882f + 1.0f;
    f32x2 t; t.x = __builtin_amdgcn_rcpf(d.x); t.y = __builtin_amdgcn_rcpf(d.y);
    f32x2 q = t * 0.5307027145f + (-0.7265760135f); q = q * t + 0.7107068705f; q = q * t + (-0.142248368f); q = q * t + 0.127414796f; q = q * t;
    const f32x2 s = (v * v) * (-0.72134752044f);
    f32x2 e; e.x = __builtin_amdgcn_exp2f(s.x); e.y = __builtin_amdgcn_exp2f(s.y);
    const f32x2 m = v * (q * e), r = v - m;
    f32x2 o; o.x = v.x < 0.f ? m.x : r.x; o.y = v.y < 0.f ? m.y : r.y; return o;
}

template <int ACT  > struct EpiBf16 {
    static constexpr bool PERM = true, AFTER_DRAIN = false; static_assert(ACT == 0 || ACT == 1, "EpiBf16: ACT is 0 (none) or 1 (gelu_pk)");
    bf16_t* O; int ldc; const float* bias; int split_cols; size_t split_stride; float scale0;
    __device__ __forceinline__ void operator()(const f32x4 (&acc)[2][2][4][2], const Unit& u, int wr, int wc, int fr, int fq) const {
        const int row0 = u.pm * BM + wr * 64 + fr; int colt = u.pn * BM; bf16_t* base = O;
        float sc = 1.f; if (split_cols) { const int t = colt / split_cols; base += (size_t)t * split_stride; colt -= t * split_cols; if (t == 0) sc = scale0; }
        const int col0 = colt + wc * 32 + 8 * fq, bcol0 = u.pn * BM + wc * 32 + 8 * fq;
        f32x4 bv[2][2];
#pragma unroll
        for (int bj = 0; bj < 2; ++bj)
#pragma unroll
            for (int n = 0; n < 2; ++n) bv[bj][n] = bias ? *(const f32x4*)(bias + bcol0 + bj * HALF + 4 * n) : (f32x4){0.f, 0.f, 0.f, 0.f};
#pragma unroll
        for (int ai = 0; ai < 2; ++ai)
#pragma unroll
            for (int m = 0; m < 4; ++m) { bf16_t* rowp = base + (size_t)(row0 + ai * HALF + m * 16) * ldc + col0;
#pragma unroll
                for (int bj = 0; bj < 2; ++bj) { f32x4 v0 = acc[ai][bj][m][0] + bv[bj][0], v1 = acc[ai][bj][m][1] + bv[bj][1];
                    if (ACT == 1) { f32x2 a = gelu_pk((f32x2){v0[0], v0[1]}), b = gelu_pk((f32x2){v0[2], v0[3]}), c = gelu_pk((f32x2){v1[0], v1[1]}), d = gelu_pk((f32x2){v1[2], v1[3]});
                        v0 = (f32x4){a.x, a.y, b.x, b.y}; v1 = (f32x4){c.x, c.y, d.x, d.y}; }
                    v0 = v0 * sc; v1 = v1 * sc; u32x4 w; w.x = cvt_pk_bf16(v0[0], v0[1]); w.y = cvt_pk_bf16(v0[2], v0[3]); w.z = cvt_pk_bf16(v1[0], v1[1]); w.w = cvt_pk_bf16(v1[2], v1[3]);
                    *(u32x4*)(rowp + bj * HALF) = w; } }
    }
};
template <class Epi, class Sched, bool ALIGN_EPI = false, bool SP2 = false>
__device__ __forceinline__ void gemm_phase(PG8_LAS unsigned char* lds, const Gemm g, const Sched& S, const Epi& E) {
    int tid = threadIdx.x; asm volatile("" : "+v"(tid));
    const int wid = __builtin_amdgcn_readfirstlane(tid >> 6), lane = tid & 63, wr = wid >> 2, wc = wid & 3, fr = lane & 15, fq = lane >> 4;
    const int K = g.K, nt = K / BK;
    unsigned voffA[2], voffB[2];
#pragma unroll
    for (int i = 0; i < 2; ++i) { int R, C; stage_rc(tid * 16 + i * 8192, R, C); const int Rb = Epi::PERM ? ((R & ~31) + perm32(R & 31)) : R;
        voffA[i] = (unsigned)(R * K + C) * 2u; voffB[i] = (unsigned)(Rb * K + C) * 2u; }
    const size_t kstep = (size_t)(BK * 2);
    const size_t hstep = (size_t)HALF * K * 2;
    const size_t tstep = 2 * hstep;
    const unsigned ldsw = (unsigned)wid * 1024u;
    const int aoff = lds_byte(wr * 64 + fr, fq * 8), boff = lds_byte(wc * 32 + fr, fq * 8);
#define PG8_SA(b, h) (((b) * 2 + (h)) * HTB)
#define PG8_SB(b, h) ((4 + (b) * 2 + (h)) * HTB)
#define PG8_STAGE(bufoff, gbase, voff) do { _Pragma("unroll") for (int _i = 0; _i < 2; ++_i) \
        __builtin_amdgcn_global_load_lds((const unsigned*)((const char*)(gbase) + (voff)[_i]), (PG8_LAS unsigned*)(lds + (bufoff) + ldsw + _i * 8192), 16, 0, 0); } while (0)
#define PG8_LDA(dst, b, h) do { _Pragma("unroll") for (int m = 0; m < 4; ++m) _Pragma("unroll") for (int k = 0; k < 2; ++k) dst[m][k] = *(const PG8_LAS bf16x8*)(lds + PG8_SA(b, h) + aoff + m * 2048 + k * 1024); } while (0)
#define PG8_LDB(dst, b, h) do { _Pragma("unroll") for (int n = 0; n < 2; ++n) _Pragma("unroll") for (int k = 0; k < 2; ++k) dst[n][k] = *(const PG8_LAS bf16x8*)(lds + PG8_SB(b, h) + boff + n * 2048 + k * 1024); } while (0)
#define PG8_MMA(ai, bj, At, Bt) do { __builtin_amdgcn_s_setprio(1); _Pragma("unroll") for (int m = 0; m < 4; ++m) _Pragma("unroll") for (int n = 0; n < 2; ++n) _Pragma("unroll") for (int k = 0; k < 2; ++k) \
        acc[ai][bj][m][n] = __builtin_amdgcn_mfma_f32_16x16x32_bf16(Bt[n][k], At[m][k], acc[ai][bj][m][n], 0, 0, 0); __builtin_amdgcn_s_setprio(0); } while (0)
#define PG8_WAIT_V(n) asm volatile("s_waitcnt vmcnt(" #n ")" ::: "memory")
#define PG8_WAIT_L(n) asm volatile("s_waitcnt lgkmcnt(" #n ")" ::: "memory")
#define PG8_BAR __builtin_amdgcn_s_barrier()
#define PG8_SCHED __builtin_amdgcn_sched_barrier(0)
    Unit cur, nxt; int ui = 0;
    if (!S.next(0, cur)) return;
    f32x4 acc[2][2][4][2];
#pragma unroll
    for (int a = 0; a < 2; ++a)
#pragma unroll
        for (int b = 0; b < 2; ++b)
#pragma unroll
            for (int m = 0; m < 4; ++m)
#pragma unroll
                for (int n = 0; n < 2; ++n) acc[a][b][m][n] = (f32x4){0.f, 0.f, 0.f, 0.f};
    bf16x8 At[4][2], B0[2][2], B1[2][2];
    const char* cA = (const char*)g.A + (size_t)cur.pm * tstep; const char* cB = (const char*)g.Bt + (size_t)cur.pn * tstep;
    S.a_ready(cur);
    if constexpr (SP2) {
        PG8_STAGE(PG8_SB(0, 0), cB, voffB); PG8_STAGE(PG8_SB(0, 1), cB + hstep, voffB); PG8_STAGE(PG8_SA(0, 0), cA, voffA); PG8_STAGE(PG8_SA(0, 1), cA + hstep, voffA);
        if (wr == 1) PG8_BAR;
        PG8_WAIT_V(2); PG8_BAR;
        PG8_STAGE(PG8_SB(1, 0), cB + kstep, voffB); PG8_STAGE(PG8_SA(1, 0), cA + kstep, voffA); PG8_STAGE(PG8_SB(1, 1), cB + hstep + kstep, voffB);
        PG8_WAIT_V(6); PG8_BAR;
    } else {
        PG8_STAGE(PG8_SB(0, 0), cB, voffB); PG8_STAGE(PG8_SA(0, 0), cA, voffA); PG8_STAGE(PG8_SB(0, 1), cB + hstep, voffB); PG8_STAGE(PG8_SA(0, 1), cA + hstep, voffA);
        if (wr == 1) PG8_BAR;
        PG8_WAIT_V(4); PG8_BAR;
        PG8_STAGE(PG8_SB(1, 0), cB + kstep, voffB); PG8_STAGE(PG8_SA(1, 0), cA + kstep, voffA); PG8_STAGE(PG8_SB(1, 1), cB + hstep + kstep, voffB);
        PG8_WAIT_V(6); PG8_BAR;
    }
    for (;;) {
        const bool has_next = S.next(ui + 1, nxt);
        const char* nA = has_next ? (const char*)g.A + (size_t)nxt.pm * tstep : cA; const char* nB = has_next ? (const char*)g.Bt + (size_t)nxt.pn * tstep : cB;
        for (int t = 0; t < nt; t += 2) {
            const bool last = (t == nt - 2);
            const char* a1 = cA + (size_t)(t + 1) * kstep;
            const char* a2 = last ? nA : cA + (size_t)(t + 2) * kstep; const char* b2 = last ? nB : cB + (size_t)(t + 2) * kstep;
            const char* a3 = a2 + kstep; const char* b3 = b2 + kstep;
            if (last && has_next) S.a_ready(nxt);
            if constexpr (SP2) {
            PG8_LDB(B0, 0, 0); PG8_LDB(B1, 0, 1); PG8_SCHED; PG8_LDA(At, 0, 0); PG8_STAGE(PG8_SA(1, 1), a1 + hstep, voffA);
            PG8_WAIT_V(8); PG8_WAIT_L(0); PG8_BAR; PG8_MMA(0, 0, At, B0); PG8_MMA(0, 1, At, B1); PG8_BAR; PG8_SCHED;
            PG8_LDA(At, 0, 1); PG8_STAGE(PG8_SB(0, 0), b2, voffB); PG8_STAGE(PG8_SB(0, 1), b2 + hstep, voffB); PG8_STAGE(PG8_SA(0, 0), a2, voffA);
            PG8_WAIT_V(8); PG8_WAIT_L(0); PG8_BAR; PG8_MMA(1, 0, At, B0); PG8_MMA(1, 1, At, B1); PG8_BAR; PG8_SCHED;
            PG8_LDB(B0, 1, 0); PG8_LDB(B1, 1, 1); PG8_SCHED; PG8_LDA(At, 1, 0); PG8_STAGE(PG8_SA(0, 1), a2 + hstep, voffA);
            PG8_WAIT_V(8); PG8_WAIT_L(0); PG8_BAR; PG8_MMA(0, 0, At, B0); PG8_MMA(0, 1, At, B1); PG8_BAR; PG8_SCHED;
            PG8_LDA(At, 1, 1); PG8_STAGE(PG8_SB(1, 0), b3, voffB); PG8_STAGE(PG8_SB(1, 1), b3 + hstep, voffB); PG8_STAGE(PG8_SA(1, 0), a3, voffA);
            PG8_WAIT_V(8); PG8_WAIT_L(0); PG8_BAR; PG8_MMA(1, 0, At, B0); PG8_MMA(1, 1, At, B1); PG8_BAR; PG8_SCHED;
            } else {
            PG8_LDB(B0, 0, 0); PG8_SCHED; PG8_LDA(At, 0, 0); PG8_STAGE(PG8_SA(1, 1), a1 + hstep, voffA);
            PG8_WAIT_L(8); PG8_BAR; PG8_WAIT_L(0); PG8_MMA(0, 0, At, B0); PG8_BAR; PG8_SCHED;
            PG8_LDB(B1, 0, 1); PG8_STAGE(PG8_SB(0, 0), b2, voffB);
            PG8_BAR; PG8_WAIT_L(0); PG8_MMA(0, 1, At, B1); PG8_BAR;
            PG8_LDA(At, 0, 1); PG8_STAGE(PG8_SA(0, 0), a2, voffA);
            PG8_BAR; PG8_WAIT_L(0); PG8_MMA(1, 0, At, B0); PG8_BAR; PG8_SCHED;
            PG8_STAGE(PG8_SB(0, 1), b2 + hstep, voffB);
            PG8_WAIT_V(6); PG8_BAR; PG8_MMA(1, 1, At, B1); PG8_BAR;
            PG8_LDB(B0, 1, 0); PG8_SCHED; PG8_LDA(At, 1, 0); PG8_STAGE(PG8_SA(0, 1), a2 + hstep, voffA);
            PG8_WAIT_L(8); PG8_BAR; PG8_WAIT_L(0); PG8_MMA(0, 0, At, B0); PG8_BAR; PG8_SCHED;
            PG8_LDB(B1, 1, 1); PG8_STAGE(PG8_SB(1, 0), b3, voffB);
            PG8_BAR; PG8_WAIT_L(0); PG8_MMA(0, 1, At, B1); PG8_BAR;
            PG8_LDA(At, 1, 1); PG8_STAGE(PG8_SA(1, 0), a3, voffA);
            PG8_BAR; PG8_WAIT_L(0); PG8_MMA(1, 0, At, B0); PG8_BAR; PG8_SCHED;
            PG8_STAGE(PG8_SB(1, 1), b3 + hstep, voffB);
            PG8_WAIT_V(6); PG8_BAR; PG8_MMA(1, 1, At, B1); PG8_BAR;
            }
        }
        if constexpr (ALIGN_EPI) { if (wr == 0) PG8_BAR; }
        if constexpr (!Epi::AFTER_DRAIN) { E(acc, cur, wr, wc, fr, fq); S.done(cur); }
        if (!has_next) break;
#pragma unroll
        for (int a = 0; a < 2; ++a)
#pragma unroll
            for (int b = 0; b < 2; ++b)
#pragma unroll
                for (int m = 0; m < 4; ++m)
#pragma unroll
                    for (int n = 0; n < 2; ++n) acc[a][b][m][n] = (f32x4){0.f, 0.f, 0.f, 0.f};
        cur = nxt; cA = nA; cB = nB; ++ui;
        if constexpr (ALIGN_EPI) { if (wr == 1) PG8_BAR; }
    }
    PG8_WAIT_V(0);
    if constexpr (!ALIGN_EPI) { if (wr == 0) PG8_BAR; }
    PG8_BAR;
    if constexpr (Epi::AFTER_DRAIN) { E.fused(acc, cur, wr, wc, fr, fq, lds, wid, lane); S.done(cur); }
#undef PG8_SA
#undef PG8_SB
#undef PG8_STAGE
#undef PG8_LDA
#undef PG8_LDB
#undef PG8_MMA
#undef PG8_WAIT_V
#undef PG8_WAIT_L
#undef PG8_BAR
#undef PG8_SCHED
}
}

namespace mk {
typedef unsigned short bf16;
typedef short bf16x8 __attribute__((ext_vector_type(8)));
typedef float f32x16 __attribute__((ext_vector_type(16)));
typedef float f32x4 __attribute__((ext_vector_type(4)));
typedef unsigned u32x4 __attribute__((ext_vector_type(4)));
typedef unsigned u32x2 __attribute__((ext_vector_type(2)));

constexpr int BATCH = 8, T = 4096, D = 1024, M = BATCH * T, DEPTH = 2, INC = 7976, FF = 2816, NZ = 5120;
constexpr size_t MiB = 1u << 20;
constexpr size_t WS_W = 1 * MiB, W_LAYER = 40 * MiB;
constexpr size_t OW_IN = 0, OW_G = 10 * MiB, OW_BR = 16 * MiB, OW_OUT = 19 * MiB, OW_GU = 21 * MiB, OW_D = 32 * MiB,
                 OW_C1K = 38 * MiB, OW_C1V = 38 * MiB + 512 * 1024, OW_C2K = 39 * MiB, OW_C2V = 39 * MiB + 256 * 1024;
constexpr size_t WS_KC = 81 * MiB, WS_VC = WS_KC + 512 * 1024;
constexpr size_t WS_H = 82 * MiB, WS_Z = 146 * MiB, SLAB = 32 * MiB, WS_END = WS_Z + 10 * SLAB;
constexpr int LDS_BYTES = 147456;
constexpr float C2 = 0.18033688011112042f;

struct Params { const float* in[23]; float* out; unsigned char* ws; };

__device__ __forceinline__ float bf2f(bf16 v) { return __uint_as_float(((unsigned)v) << 16); }
__device__ __forceinline__ unsigned f2bf(float f) { unsigned u = __float_as_uint(f); return (u + 0x7fffu + ((u >> 16) & 1u)) >> 16; }
__device__ __forceinline__ unsigned pk2(float lo, float hi) { return f2bf(lo) | (f2bf(hi) << 16); }
__device__ __forceinline__ float lo16(unsigned w) { return __uint_as_float(w << 16); }
__device__ __forceinline__ float hi16(unsigned w) { return __uint_as_float(w & 0xffff0000u); }
__device__ __forceinline__ f32x16 mfma32(bf16x8 a, bf16x8 b, f32x16 c) { return __builtin_amdgcn_mfma_f32_32x32x16_bf16(a, b, c, 0, 0, 0); }
__device__ __forceinline__ int crow(int r, int hi) { return (r & 3) + 8 * (r >> 2) + 4 * hi; }
__device__ __forceinline__ float wave_sum(float v) {
#pragma unroll
    for (int o = 1; o < 64; o <<= 1) v += __shfl_xor(v, o);
    return v;
}
__device__ __forceinline__ float sigmoidf_(float x) { return 1.f / (1.f + __expf(-x)); }
__device__ __forceinline__ float siluf_(float x) { return x / (1.f + __expf(-x)); }
#define LDS_WAIT() asm volatile("s_waitcnt lgkmcnt(0)" ::: "memory")
__device__ __forceinline__ int fresh_tid() { int t = threadIdx.x; asm volatile("" : "+v"(t)); return t; }
__device__ __forceinline__ int fresh_bid() { int t = blockIdx.x; asm volatile("" : "+s"(t)); return t; }

template <class F>
__device__ __forceinline__ void wt_convert(F colptr, int ld, int K, int N, bf16* WT, float* scr, int gw, int NGW, int lane) {
    const int nblk = N / 32, nitems = (K / 64) * nblk;
    for (int it = gw; it < nitems; it += NGW) {
        const int kb = it / nblk, nb = it % nblk, k0 = 64 * kb, n0 = 32 * nb;
        const float* cp = colptr(n0 + (lane & 31));
#pragma unroll 8
        for (int i = 0; i < 32; ++i) { const int kk = 2 * i + (lane >> 5); scr[kk * 33 + (lane & 31)] = cp ? cp[(size_t)(k0 + kk) * ld] : 0.f; }
        LDS_WAIT();
        const int c = lane & 7;
#pragma unroll
        for (int j = 0; j < 4; ++j) {
            const int n = (lane >> 3) + 8 * j; const float* s = scr + (8 * c) * 33 + n;
            u32x4 o; o.x = pk2(s[0 * 33], s[1 * 33]); o.y = pk2(s[2 * 33], s[3 * 33]); o.z = pk2(s[4 * 33], s[5 * 33]); o.w = pk2(s[6 * 33], s[7 * 33]);
            *(u32x4*)(WT + (size_t)(n0 + n) * K + k0 + 8 * c) = o;
        }
        LDS_WAIT();
    }
}

__device__ __forceinline__ void convert_weights(const Params& p, char* lds, int gw, int NGW, int wave, int lane) {
    float* scr = (float*)(lds + wave * 8448);
    for (int l = 0; l < DEPTH; ++l) {
        unsigned char* wb = p.ws + WS_W + (size_t)l * W_LAYER;
        const float* win = p.in[2] + (size_t)l * D * INC;
        wt_convert([=](int n) -> const float* {
            const int s = n >> 9, c = n & 511; int src;
            switch (s) { case 0: src = c; break; case 1: src = 512 + c; break; case 2: src = 1536 + c; break; case 3: src = 2048 + c; break; case 4: src = 3088 + c; break;
                         case 5: src = 4112 + c; break; case 6: src = c < 256 ? 4624 + c : (c < 272 ? 3072 + (c - 256) : (c < 296 ? 4880 + (c - 272) : -1)); break;
                         case 7: src = 1024 + c; break; case 8: src = 2560 + c; break; default: src = 3600 + c; break; }
            return src < 0 ? nullptr : win + src; }, INC, D, NZ, (bf16*)(wb + OW_IN), scr, gw, NGW, lane);
        wt_convert([=](int n) -> const float* { return win + 4904 + n; }, INC, D, 3072, (bf16*)(wb + OW_G), scr, gw, NGW, lane);
        for (int b = 0; b < 3; ++b) { const float* w = p.in[14 + b] + (size_t)l * 512 * D;
            wt_convert([=](int n) -> const float* { return w + n; }, D, 512, D, (bf16*)(wb + OW_BR) + (size_t)b * D * 512, scr, gw, NGW, lane); }
        { const float* w = p.in[17] + (size_t)l * D * D; wt_convert([=](int n) -> const float* { return w + n; }, D, D, D, (bf16*)(wb + OW_OUT), scr, gw, NGW, lane); }
        { const float* wg = p.in[19] + (size_t)l * D * FF; const float* wu = p.in[20] + (size_t)l * D * FF;
          wt_convert([=](int n) -> const float* { const int j = n >> 8, i = n & 255; return i < 128 ? wg + 128 * j + i : wu + 128 * j + (i - 128); }, FF, D, 2 * FF, (bf16*)(wb + OW_GU), scr, gw, NGW, lane); }
        { const float* w = p.in[21] + (size_t)l * FF * D; wt_convert([=](int n) -> const float* { return w + n; }, D, FF, D, (bf16*)(wb + OW_D), scr, gw, NGW, lane); }
        { const float* w = p.in[10] + (size_t)l * 2048 * 128; wt_convert([=](int n) -> const float* { return w + n; }, 128, 2048, 128, (bf16*)(wb + OW_C1K), scr, gw, NGW, lane); }
        { const float* w = p.in[12] + (size_t)l * 2048 * 128; wt_convert([=](int n) -> const float* { return w + n; }, 128, 2048, 128, (bf16*)(wb + OW_C1V), scr, gw, NGW, lane); }
        { const float* w = p.in[11] + (size_t)l * 128 * 64; wt_convert([=](int n) -> const float* { return w + n; }, 64, 128, 64, (bf16*)(wb + OW_C2K), scr, gw, NGW, lane); }
        { const float* w = p.in[13] + (size_t)l * 128 * 64; wt_convert([=](int n) -> const float* { return w + n; }, 64, 128, 64, (bf16*)(wb + OW_C2V), scr, gw, NGW, lane); }
    }
}

__device__ __forceinline__ void rms_to_bf16(const float* x, const float* g, bf16* out, int gw, int NGW, int lane) {
    for (int m = gw; m < M; m += NGW) {
        const f32x4* xr = (const f32x4*)(x + (size_t)m * D) + lane; f32x4 v[4]; float s = 0.f;
#pragma unroll
        for (int j = 0; j < 4; ++j) { v[j] = xr[64 * j]; s += (v[j].x * v[j].x + v[j].y * v[j].y) + (v[j].z * v[j].z + v[j].w * v[j].w); }
        const float r = rsqrtf(wave_sum(s) * (1.f / D) + 1e-6f);
        u32x2* o = (u32x2*)(out + (size_t)m * D) + lane;
#pragma unroll
        for (int j = 0; j < 4; ++j) { const f32x4 gg = ((const f32x4*)g)[lane + 64 * j]; u32x2 w; w.x = pk2(v[j].x * r * gg.x, v[j].y * r * gg.y); w.y = pk2(v[j].z * r * gg.z, v[j].w * r * gg.w); o[64 * j] = w; }
    }
}
__device__ __forceinline__ void rms_final(float* x, const float* g, int gw, int NGW, int lane) {
    for (int m = gw; m < M; m += NGW) {
        f32x4* xr = (f32x4*)(x + (size_t)m * D) + lane; f32x4 v[4]; float s = 0.f;
#pragma unroll
        for (int j = 0; j < 4; ++j) { v[j] = xr[64 * j]; s += (v[j].x * v[j].x + v[j].y * v[j].y) + (v[j].z * v[j].z + v[j].w * v[j].w); }
        const float r = rsqrtf(wave_sum(s) * (1.f / D) + 1e-6f);
#pragma unroll
        for (int j = 0; j < 4; ++j) { const f32x4 gg = ((const f32x4*)g)[lane + 64 * j]; xr[64 * j] = v[j] * r * gg; }
    }
}

__device__ __forceinline__ float inv_freq(int i) {
    switch (i) { case 0: return 1.0f; case 1: return 0.19392274474868576f; case 2: return 0.03760603093086393f; case 3: return 0.007292664737217109f;
                 case 4: return 0.001414213562373095f; case 5: return 0.0002742481756762073f; case 6: return 5.318295896944988e-05f; default: return 1.031338537721246e-05f; }
}
__device__ __forceinline__ void rope_cs(int t, int i, float& c, float& s) {
    const float ang = (float)t * inv_freq(i);
    const double rev = (double)ang * 0.15915494309189535; const float fr = (float)(rev - floor(rev));
    s = __builtin_amdgcn_sinf(fr); c = __builtin_amdgcn_cosf(fr);
}

__device__ __forceinline__ void rope_pass(const Params& p, int gw, int NGW, int lane) {
    bf16* Z = (bf16*)(p.ws + WS_Z);
    bf16* q = Z + 9 * (SLAB / 2); bf16* s5 = Z + 5 * (SLAB / 2); bf16* s6 = Z + 6 * (SLAB / 2);
    for (int m = gw; m < M; m += NGW) {
        const int t = m & (T - 1);
        float cl, sl; rope_cs(t, lane & 7, cl, sl);
        float cs[8], sn[8];
#pragma unroll
        for (int i = 0; i < 8; ++i) { cs[i] = __shfl(cl, i); sn[i] = __shfl(sl, i); }
        const int ch = lane & 7;
        {
            u32x4* ptr = (u32x4*)(q + (size_t)m * 512 + 8 * lane); const u32x4 w = *ptr; float v[8], o[8];
#pragma unroll
            for (int e = 0; e < 4; ++e) { v[2 * e] = lo16(w[e]); v[2 * e + 1] = hi16(w[e]); }
#pragma unroll
            for (int e = 0; e < 8; ++e) { const float pv = __shfl_xor(v[e], 1); o[e] = ch == 0 ? v[e] * cs[e] - pv * sn[e] : (ch == 1 ? v[e] * cs[e] + pv * sn[e] : v[e]); o[e] *= C2; }
            u32x4 r; r.x = pk2(o[0], o[1]); r.y = pk2(o[2], o[3]); r.z = pk2(o[4], o[5]); r.w = pk2(o[6], o[7]); *ptr = r;
        }
        {
            bf16* base = lane < 16 ? s5 + (size_t)m * 512 + 256 + 8 * lane : s6 + (size_t)m * 512 + 8 * (lane - 16);
            u32x4* ptr = (u32x4*)base; u32x4 w = (u32x4){0u, 0u, 0u, 0u}; if (lane < 32) w = *ptr; float v[8], o[8];
#pragma unroll
            for (int e = 0; e < 4; ++e) { v[2 * e] = lo16(w[e]); v[2 * e + 1] = hi16(w[e]); }
#pragma unroll
            for (int e = 0; e < 8; ++e) { const float pv = __shfl_xor(v[e], 1); o[e] = ch == 0 ? v[e] * cs[e] - pv * sn[e] : (ch == 1 ? v[e] * cs[e] + pv * sn[e] : v[e]); }
            u32x4 r; r.x = pk2(o[0], o[1]); r.y = pk2(o[2], o[3]); r.z = pk2(o[4], o[5]); r.w = pk2(o[6], o[7]); if (lane < 32) *ptr = r;
        }
    }
}

__device__ __forceinline__ float gelu_tanh(float x) { const float u = 0.7978845608028654f * (x + 0.044715f * x * x * x); const float e = __expf(2.f * u); const float th = 1.f - 2.f / (e + 1.f); return 0.5f * x * (1.f + th); }
__device__ __forceinline__ void compress_task(const Params& p, int layer, int task, char* lds) {
    const int tid = fresh_tid(), lane = tid & 63, w = __builtin_amdgcn_readfirstlane(tid >> 6), r32 = lane & 31, hi = lane >> 5;
    const int kind = task >> 7, rg = task & 127;
    const bf16* s5 = (const bf16*)(p.ws + WS_Z) + 5 * (SLAB / 2);
    const unsigned char* wb = p.ws + WS_W + (size_t)layer * W_LAYER;
    const bf16* w1T = (const bf16*)(wb + (kind ? OW_C1V : OW_C1K)); const bf16* w2T = (const bf16*)(wb + (kind ? OW_C2V : OW_C2K));
    const float* pos = p.in[kind ? 9 : 8] + (size_t)layer * 32 * 64;
    bf16* dst = (bf16*)(p.ws + (kind ? WS_VC : WS_KC));
    float* red = (float*)lds;
    bf16* hid = (bf16*)(lds + 131072);
    const int id = 32 * rg + r32; const bool valid = id < 4080; const int bg = valid ? id / 255 : 0, n = valid ? id % 255 : 0;
    const int b = bg >> 1, g = bg & 1;
    f32x16 acc[4];
#pragma unroll
    for (int i = 0; i < 4; ++i) acc[i] = (f32x16){};
    for (int s = 16 * w; s < 16 * w + 16; ++s) {
        const int j = s >> 2, d0 = 16 * (s & 3) + 8 * hi, tpos = 16 * n + j;
        const u32x4 wz = *(const u32x4*)(s5 + (size_t)(b * T + tpos) * 512 + kind * 128 + g * 64 + d0);
        float v[8];
#pragma unroll
        for (int e = 0; e < 4; ++e) { v[2 * e] = lo16(wz[e]); v[2 * e + 1] = hi16(wz[e]); }
        if (kind == 0 && (s & 3) == 0) {
#pragma unroll
            for (int e = 0; e < 8; ++e) { float c, sn; rope_cs(tpos, e, c, sn); const float pv = __shfl_xor(v[e], 32); v[e] = hi == 0 ? v[e] * c - pv * sn : v[e] * c + pv * sn; }
        }
        const f32x4 p0 = *(const f32x4*)(pos + j * 64 + d0), p1 = *(const f32x4*)(pos + j * 64 + d0 + 4);
        v[0] += p0.x; v[1] += p0.y; v[2] += p0.z; v[3] += p0.w; v[4] += p1.x; v[5] += p1.y; v[6] += p1.z; v[7] += p1.w;
        u32x4 aw; aw.x = pk2(v[0], v[1]); aw.y = pk2(v[2], v[3]); aw.z = pk2(v[4], v[5]); aw.w = pk2(v[6], v[7]);
        if (!valid) aw = (u32x4){0u, 0u, 0u, 0u};
        const bf16x8 a = __builtin_bit_cast(bf16x8, aw);
#pragma unroll
        for (int nb = 0; nb < 4; ++nb) { const bf16x8 bb = *(const bf16x8*)(w1T + (size_t)(32 * nb + r32) * 2048 + 16 * s + 8 * hi); acc[nb] = mfma32(a, bb, acc[nb]); }
    }
#pragma unroll
    for (int nb = 0; nb < 4; ++nb)
#pragma unroll
        for (int r = 0; r < 16; ++r) red[(w * 32 + crow(r, hi)) * 128 + 32 * nb + r32] = acc[nb][r];
    __syncthreads();
    for (int e = tid; e < 4096; e += 512) { float s = 0.f;
#pragma unroll
        for (int ww = 0; ww < 8; ++ww) s += red[ww * 4096 + e];
        hid[(e >> 7) * 136 + (e & 127)] = (bf16)f2bf(gelu_tanh(s)); }
    __syncthreads();
    if (w < 2) {
        f32x16 o = (f32x16){};
#pragma unroll
        for (int s = 0; s < 8; ++s) { const bf16x8 a = *(const bf16x8*)(hid + r32 * 136 + 16 * s + 8 * hi); const bf16x8 bb = *(const bf16x8*)(w2T + (size_t)(32 * w + r32) * 128 + 16 * s + 8 * hi); o = mfma32(a, bb, o); }
#pragma unroll
        for (int r = 0; r < 16; ++r) { const int id2 = 32 * rg + crow(r, hi); if (id2 < 4080) { const int bg2 = id2 / 255, n2 = id2 % 255; dst[((size_t)bg2 * 256 + n2) * 64 + 32 * w + r32] = (bf16)f2bf(o[r]); } }
    }
    __syncthreads();
}

constexpr size_t WS_PB = WS_END, WS_DEC = WS_END + 32 * MiB, WS_NEED = WS_END + 34 * MiB;
template <int DK, bool HG>
__device__ __forceinline__ void scan_prep(const Params& p, int layer, int b, int h, int c, char* lds) {
    constexpr int PARTS = 512 / DK, TP = 64 / PARTS, QS = DK + 8;
    const int tid = fresh_tid(), lane = tid & 63, w = __builtin_amdgcn_readfirstlane(tid >> 6), r32 = lane & 31, hi = lane >> 5;
    bf16* qe = (bf16*)lds; bf16* ke = qe + 64 * QS; bf16* keT = ke + 64 * QS; bf16* P = keT + DK * 72; float* tot = (float*)(P + 64 * 72);
    bf16* Z = (bf16*)(p.ws + WS_Z);
    const int d = tid % DK, part = tid / DK;
    bf16 *qsrc, *ksrc; const bf16* glr = Z + 6 * (SLAB / 2) + 256;
    float lb = 0.f, bias = 0.f, w2c[16];
    if (HG) {
        qsrc = Z + 0 * (SLAB / 2) + h * 128; ksrc = Z + 1 * (SLAB / 2) + h * 128;
        if (layer == 1) { const float l0 = p.in[3][h * 128 + d], l1 = p.in[3][512 + h * 128 + d]; lb = 1.f / (1.f + __expf(l0 - l1)); }
#pragma unroll
        for (int j = 0; j < 16; ++j) w2c[j] = 0.f;
    } else {
        qsrc = Z + 3 * (SLAB / 2) + h * 64; ksrc = Z + 3 * (SLAB / 2) + 256 + h * 64;
        bias = p.in[6][layer * 256 + h * 64 + d];
#pragma unroll
        for (int j = 0; j < 16; ++j) w2c[j] = p.in[5][(size_t)layer * 16 * 256 + j * 256 + h * 64 + d];
    }
    const size_t m0 = (size_t)b * T + 64 * c;
    float gl[TP], qv[TP], kv[TP]; float run = 0.f;
#pragma unroll
    for (int ii = 0; ii < TP; ++ii) {
        const size_t row = m0 + part * TP + ii;
        const float xq = bf2f(qsrc[row * 512 + d]), xk = bf2f(ksrc[row * 512 + d]);
        float g;
        if (HG) { const float ex = __expf(-xk); const float sg = 1.f / (1.f + ex); const float f = lb + (1.f - lb) * sg; g = __logf(f); kv[ii] = (1.f - lb) * ex * sg; qv[ii] = siluf_(xq); }
        else { float u = bias; const u32x4 g0 = *(const u32x4*)(glr + row * 512), g1 = *(const u32x4*)(glr + row * 512 + 8);
#pragma unroll
            for (int e = 0; e < 4; ++e) { u += lo16(g0[e]) * w2c[2 * e] + hi16(g0[e]) * w2c[2 * e + 1]; u += lo16(g1[e]) * w2c[8 + 2 * e] + hi16(g1[e]) * w2c[8 + 2 * e + 1]; }
            g = (fminf(u, 0.f) - __logf(1.f + __expf(-fabsf(u)))) * (1.f / 16.f); kv[ii] = xk; qv[ii] = xq * 0.125f; }
        run += g; gl[ii] = run;
    }
    tot[part * DK + d] = run;
    __syncthreads();
    float off = 0.f, total = 0.f;
#pragma unroll
    for (int pp = 0; pp < PARTS; ++pp) { const float tv = tot[pp * DK + d]; total += tv; if (pp < part) off += tv; }
    if (part == 0) ((float*)(p.ws + WS_DEC + (HG ? 0 : MiB)))[(size_t)((b * 4 + h) * 64 + c) * DK + d] = __expf(total);
#pragma unroll
    for (int ii = 0; ii < TP; ++ii) {
        const int i = part * TP + ii; const float bb = off + gl[ii];
        const float eq = __expf(fminf(bb - total, 80.f)), ek = __expf(total - bb);
        const bf16 qb16 = (bf16)f2bf(qv[ii] * eq), kb16 = (bf16)f2bf(kv[ii] * ek);
        qe[i * QS + d] = qb16; ke[i * QS + d] = kb16; keT[d * 72 + i] = kb16;
    }
    __syncthreads();
    if (w >= 4 && w < 7) {
        const int ti = w == 4 ? 0 : 1, si = w == 6 ? 1 : 0;
        f32x16 sc = (f32x16){};
#pragma unroll
        for (int ks = 0; ks < DK / 16; ++ks) { const bf16x8 a = *(const bf16x8*)(qe + (32 * ti + r32) * QS + 16 * ks + 8 * hi); const bf16x8 bb = *(const bf16x8*)(ke + (32 * si + r32) * QS + 16 * ks + 8 * hi); sc = mfma32(a, bb, sc); }
#pragma unroll
        for (int r = 0; r < 16; ++r) { const int tt = 32 * ti + crow(r, hi), ss = 32 * si + r32; P[tt * 72 + ss] = (ss <= tt) ? (bf16)f2bf(sc[r]) : (bf16)0; }
    } else if (w == 7) {
#pragma unroll
        for (int r = 0; r < 16; ++r) P[crow(r, hi) * 72 + 32 + r32] = (bf16)0;
    } else {
        const int t4 = tid;
        for (int q = t4; q < 64 * (DK / 8); q += 256) { const int row = q / (DK / 8), ch = q % (DK / 8); *(u32x4*)(qsrc + (m0 + row) * 512 + 8 * ch) = *(const u32x4*)(qe + row * QS + 8 * ch); }
        for (int q = t4; q < DK * 8; q += 256) { const int dd = q >> 3, ch = q & 7;
            bf16* dst = HG ? ksrc + (m0 + (dd >> 1)) * 512 + (dd & 1) * 64 + 8 * ch : ksrc + (m0 + dd) * 512 + 8 * ch;
            *(u32x4*)dst = *(const u32x4*)(keT + dd * 72 + 8 * ch); }
    }
    __syncthreads();
    { bf16* PB = (bf16*)(p.ws + WS_PB) + (HG ? 0 : (size_t)M * 256); const int t = tid >> 3, ch = tid & 7; *(u32x4*)(PB + (m0 + t) * 256 + h * 64 + 8 * ch) = *(const u32x4*)(P + t * 72 + 8 * ch); }
    __syncthreads();
}

template <int DK, bool HG>
__device__ __forceinline__ void scan_unit(const Params& p, int layer, int b, int h, int slice, char* lds, size_t dst_off) {
    constexpr int QS = DK + 8, NTS = DK / 32, NQ = (64 * DK / 8) / 512;
    constexpr int BUF = 64 * QS * 2 + DK * 72 * 2 + 64 * 72 * 2 + 32 * 72 * 2 + DK * 4;
    const int tid = fresh_tid(), lane = tid & 63, w = __builtin_amdgcn_readfirstlane(tid >> 6), r32 = lane & 31, hi = lane >> 5;
    bf16* ST = (bf16*)(lds + 2 * BUF);
    bf16* Z = (bf16*)(p.ws + WS_Z);
    const bf16* qsrc = HG ? Z + 0 * (SLAB / 2) + h * 128 : Z + 3 * (SLAB / 2) + h * 64;
    const bf16* ksrc = HG ? Z + 1 * (SLAB / 2) + h * 128 : Z + 3 * (SLAB / 2) + 256 + h * 64;
    bf16* vsrc = HG ? Z + 7 * (SLAB / 2) + h * 128 + 32 * slice : Z + 8 * (SLAB / 2) + h * 128 + 32 * slice;
    const bf16* PB = (const bf16*)(p.ws + WS_PB) + (HG ? 0 : (size_t)M * 256) + h * 64;
    const float* decg = (const float*)(p.ws + WS_DEC + (HG ? 0 : MiB)) + (size_t)((b * 4 + h) * 64) * DK;
    u32x4 rq[NQ], rk[NQ], rp; u32x2 rv; float rd = 0.f;
    auto gload = [&](int c) {
        const size_t m0 = (size_t)b * T + 64 * c;
#pragma unroll
        for (int k = 0; k < NQ; ++k) { const int q = tid + 512 * k; const int row = q / (DK / 8), ch = q % (DK / 8); rq[k] = *(const u32x4*)(qsrc + (m0 + row) * 512 + 8 * ch);
            const int dd = q >> 3, c8 = q & 7; rk[k] = *(const u32x4*)(HG ? ksrc + (m0 + (dd >> 1)) * 512 + (dd & 1) * 64 + 8 * c8 : ksrc + (m0 + dd) * 512 + 8 * c8); }
        rp = *(const u32x4*)(PB + (m0 + (tid >> 3)) * 256 + 8 * (tid & 7));
        rv = *(const u32x2*)(vsrc + (m0 + (tid >> 3)) * 512 + (tid & 7) * 4);
        if (tid < DK) rd = decg[c * DK + tid];
    };
    auto stage = [&](int x) {
        bf16* qe = (bf16*)(lds + x * BUF); bf16* keT = qe + 64 * QS; bf16* P = keT + DK * 72; bf16* VT = P + 64 * 72; float* dec = (float*)(VT + 32 * 72);
#pragma unroll
        for (int k = 0; k < NQ; ++k) { const int q = tid + 512 * k; const int row = q / (DK / 8), ch = q % (DK / 8); *(u32x4*)(qe + row * QS + 8 * ch) = rq[k]; *(u32x4*)(keT + (q >> 3) * 72 + 8 * (q & 7)) = rk[k]; }
        *(u32x4*)(P + (tid >> 3) * 72 + 8 * (tid & 7)) = rp;
        { const int s = tid >> 3, v4 = (tid & 7) * 4; VT[(v4 + 0) * 72 + s] = (bf16)(rv.x & 0xffffu); VT[(v4 + 1) * 72 + s] = (bf16)(rv.x >> 16); VT[(v4 + 2) * 72 + s] = (bf16)(rv.y & 0xffffu); VT[(v4 + 3) * 72 + s] = (bf16)(rv.y >> 16); }
        if (tid < DK) dec[tid] = rd;
    };
    f32x16 S = (f32x16){};
    gload(0); stage(0); gload(1);
    __syncthreads();
    for (int c = 0; c < T / 64; ++c) {
        const int x = c & 1; const size_t m0 = (size_t)b * T + 64 * c;
        const bf16* qe = (const bf16*)(lds + x * BUF); const bf16* keT = qe + 64 * QS; const bf16* P = keT + DK * 72; const bf16* VT = P + 64 * 72; const float* dec = (const float*)(VT + 32 * 72);
        if (c + 1 < T / 64) { stage(x ^ 1); if (c + 2 < T / 64) gload(c + 2); }
        f32x16 o = (f32x16){};
        if (w < NTS) {
            const float dc = dec[32 * w + r32];
#pragma unroll
            for (int r = 0; r < 16; ++r) { S[r] *= dc; ST[crow(r, hi) * QS + 32 * w + r32] = (bf16)f2bf(S[r]); }
#pragma unroll
            for (int ks = 0; ks < 4; ++ks) { const bf16x8 a = *(const bf16x8*)(VT + r32 * 72 + 16 * ks + 8 * hi); const bf16x8 bb = *(const bf16x8*)(keT + (32 * w + r32) * 72 + 16 * ks + 8 * hi); S = mfma32(a, bb, S); }
        } else if (w < 6) {
#pragma unroll
            for (int ks = 0; ks < 4; ++ks) { const bf16x8 a = *(const bf16x8*)(P + (32 * (w - 4) + r32) * 72 + 16 * ks + 8 * hi); const bf16x8 bb = *(const bf16x8*)(VT + r32 * 72 + 16 * ks + 8 * hi); o = mfma32(a, bb, o); }
        }
        __syncthreads();
        if (w >= 4 && w < 6) {
#pragma unroll
            for (int ks = 0; ks < DK / 16; ++ks) { const bf16x8 a = *(const bf16x8*)(qe + (32 * (w - 4) + r32) * QS + 16 * ks + 8 * hi); const bf16x8 bb = *(const bf16x8*)(ST + r32 * QS + 16 * ks + 8 * hi); o = mfma32(a, bb, o); }
#pragma unroll
            for (int r = 0; r < 16; ++r) vsrc[dst_off + (m0 + 32 * (w - 4) + crow(r, hi)) * 512 + r32] = (bf16)f2bf(o[r]);
        }
        __syncthreads();
    }
}

__device__ __forceinline__ void finish_pass(const Params& p, int layer, int gw, int NGW, int lane) {
    bf16* Z = (bf16*)(p.ws + WS_Z);
    for (int it = gw; it < 2 * M; it += NGW) {
        const int mix = it & 1, m = it >> 1;
        bf16* o = Z + (mix ? 8 : 7) * (SLAB / 2) + (size_t)m * 512 + 8 * lane; const bf16* og = Z + (mix ? 4 : 2) * (SLAB / 2) + (size_t)m * 512 + 8 * lane;
        const float* g = p.in[mix ? 7 : 4] + layer * 512 + 8 * lane;
        const u32x4 wo = *(const u32x4*)o, wg = *(const u32x4*)og; float v[8], gt[8]; float s = 0.f;
#pragma unroll
        for (int e = 0; e < 4; ++e) { v[2 * e] = lo16(wo[e]); v[2 * e + 1] = hi16(wo[e]); gt[2 * e] = lo16(wg[e]); gt[2 * e + 1] = hi16(wg[e]); }
#pragma unroll
        for (int e = 0; e < 8; ++e) s += v[e] * v[e];
        s += __shfl_xor(s, 1); s += __shfl_xor(s, 2); s += __shfl_xor(s, 4); s += __shfl_xor(s, 8);
        const float r = rsqrtf(s * (1.f / 128.f) + 1e-6f);
        const f32x4 g0 = *(const f32x4*)g, g1 = *(const f32x4*)(g + 4); const float gg[8] = {g0.x, g0.y, g0.z, g0.w, g1.x, g1.y, g1.z, g1.w};
        float y[8];
#pragma unroll
        for (int e = 0; e < 8; ++e) y[e] = v[e] * r * gg[e] * siluf_(gt[e]);
        u32x4 w; w.x = pk2(y[0], y[1]); w.y = pk2(y[2], y[3]); w.z = pk2(y[4], y[5]); w.w = pk2(y[6], y[7]); *(u32x4*)o = w;
    }
}

__device__ __forceinline__ void qk_tile(const bf16* Kt, const bf16x8* qr, f32x16& p0, f32x16& p1, int r32, int hi) {
    p0 = (f32x16){}; p1 = (f32x16){};
#pragma unroll
    for (int s = 0; s < 4; ++s) { const bf16x8 a0 = *(const bf16x8*)(Kt + r32 * 72 + 16 * s + 8 * hi), a1 = *(const bf16x8*)(Kt + (32 + r32) * 72 + 16 * s + 8 * hi); p0 = mfma32(a0, qr[s], p0); p1 = mfma32(a1, qr[s], p1); }
}
__device__ __forceinline__ void pv_tile(const bf16* Vt, const f32x16& p0, const f32x16& p1, f32x16* o, int r32, int hi) {
#pragma unroll
    for (int s = 0; s < 4; ++s) {
        u32x4 pw;
#pragma unroll
        for (int i = 0; i < 4; ++i) { const float a = (s < 2) ? p0[8 * (s & 1) + 2 * i] : p1[8 * (s & 1) + 2 * i], bq = (s < 2) ? p0[8 * (s & 1) + 2 * i + 1] : p1[8 * (s & 1) + 2 * i + 1]; pw[i] = pk2(a, bq); }
        const bf16x8 pb = __builtin_bit_cast(bf16x8, pw);
#pragma unroll
        for (int db = 0; db < 2; ++db) { const bf16* vp = Vt + (32 * db + r32) * 72 + 16 * s + 4 * hi; const u32x2 lo = *(const u32x2*)vp, hi8 = *(const u32x2*)(vp + 8);
            u32x4 aw; aw.x = lo.x; aw.y = lo.y; aw.z = hi8.x; aw.w = hi8.y; o[db] = mfma32(__builtin_bit_cast(bf16x8, aw), pb, o[db]); }
    }
}
template <int MODE>
__device__ __forceinline__ void run_tiles(const bf16* Kb, const bf16* Vb, int pitch, int j0, int j1, bf16* Kt, bf16* Vt, const bf16x8* qr, int t, unsigned long long sel,
                                          float& m, float& l, f32x16* o, float mc, float invlc, float* impme, int tid, int r32, int hi) {
    const int key = tid >> 3, ch = tid & 7;
    u32x4 kreg, vreg = (u32x4){0u, 0u, 0u, 0u};
    kreg = *(const u32x4*)(Kb + (size_t)(64 * j0 + key) * pitch + 8 * ch); if (MODE != 0) vreg = *(const u32x4*)(Vb + (size_t)(64 * j0 + key) * pitch + 8 * ch);
    for (int j = j0; j <= j1; ++j) {
        __syncthreads();
        *(u32x4*)(Kt + key * 72 + 8 * ch) = kreg;
        if (MODE != 0) {
#pragma unroll
            for (int e = 0; e < 4; ++e) { Vt[(8 * ch + 2 * e) * 72 + key] = (bf16)(vreg[e] & 0xffffu); Vt[(8 * ch + 2 * e + 1) * 72 + key] = (bf16)(vreg[e] >> 16); }
        }
        if (j < j1) { kreg = *(const u32x4*)(Kb + (size_t)(64 * (j + 1) + key) * pitch + 8 * ch); if (MODE != 0) vreg = *(const u32x4*)(Vb + (size_t)(64 * (j + 1) + key) * pitch + 8 * ch); }
        __syncthreads();
        f32x16 p0, p1; qk_tile(Kt, qr, p0, p1, r32, hi);
        const float NEG = -INFINITY;
        const bool selbit = (sel >> j) & 1ull;
#pragma unroll
        for (int r = 0; r < 16; ++r) {
            const int k0 = 64 * j + crow(r, hi), k1 = k0 + 32; bool ok0, ok1;
            if (MODE <= 1) { ok0 = 16 * k0 + 31 <= t; ok1 = 16 * k1 + 31 <= t; }
            else if (MODE == 2) { ok0 = selbit && k0 <= t; ok1 = selbit && k1 <= t; }
            else { ok0 = k0 <= t && k0 > t - 512; ok1 = k1 <= t && k1 > t - 512; }
            p0[r] = ok0 ? p0[r] : NEG; p1[r] = ok1 ? p1[r] : NEG;
        }
        if (MODE == 1) {
#pragma unroll
            for (int r = 0; r < 16; ++r) { p0[r] = __builtin_amdgcn_exp2f(p0[r] - mc) * invlc; p1[r] = __builtin_amdgcn_exp2f(p1[r] - mc) * invlc; }
#pragma unroll
            for (int half = 0; half < 2; ++half)
#pragma unroll
                for (int g4 = 0; g4 < 4; ++g4) {
                    const float c3 = half ? p1[4 * g4 + 3] : p0[4 * g4 + 3];
                    const float a = half ? (p1[4 * g4] + p1[4 * g4 + 1]) + (p1[4 * g4 + 2] + c3) : (p0[4 * g4] + p0[4 * g4 + 1]) + (p0[4 * g4 + 2] + c3);
                    const float cp = __shfl_xor(c3, 32); const int jj = 16 * j + 8 * half + 2 * g4 + hi;
                    if (hi) impme[jj] += a + cp; else { impme[jj] += a; impme[jj + 2] += cp; }
                }
            pv_tile(Vt, p0, p1, o, r32, hi);
        } else {
            float mx = p0[0];
#pragma unroll
            for (int r = 0; r < 16; ++r) { mx = fmaxf(mx, p0[r]); mx = fmaxf(mx, p1[r]); }
            mx = fmaxf(mx, __shfl_xor(mx, 32));
            const float mn = fmaxf(m, mx), alpha = __builtin_amdgcn_exp2f(m - mn); m = mn;
            float ls = 0.f;
#pragma unroll
            for (int r = 0; r < 16; ++r) { p0[r] = __builtin_amdgcn_exp2f(p0[r] - mn); p1[r] = __builtin_amdgcn_exp2f(p1[r] - mn); ls += p0[r] + p1[r]; }
            l = l * alpha + ls;
            if (MODE != 0) { o[0] *= alpha; o[1] *= alpha; pv_tile(Vt, p0, p1, o, r32, hi); }
        }
    }
}

__device__ __forceinline__ void nsa_unit(const Params& p, int bg, int qb, char* lds, size_t dst_off) {
    const int tid = fresh_tid(), lane = tid & 63, w = __builtin_amdgcn_readfirstlane(tid >> 6), r32 = lane & 31, hi = lane >> 5;
    const int b = bg >> 1, g = bg & 1;
    bf16* Kt = (bf16*)lds; bf16* Vt = Kt + 64 * 72; float* impw = (float*)(Vt + 64 * 72); unsigned long long* selm = (unsigned long long*)(impw + 8 * 32 * 65);
    bf16* Z = (bf16*)(p.ws + WS_Z);
    bf16* s5 = Z + 5 * (SLAB / 2); bf16* s6 = Z + 6 * (SLAB / 2); bf16* s9 = Z + 9 * (SLAB / 2);
    const bf16* KC = (const bf16*)(p.ws + WS_KC) + (size_t)bg * 256 * 64; const bf16* VC = (const bf16*)(p.ws + WS_VC) + (size_t)bg * 256 * 64;
    const size_t rowb = (size_t)b * T;
    const int hh = g * 4 + (w >> 1), tokl = 32 * (w & 1) + r32, t = 64 * qb + tokl; const size_t mrow = rowb + t;
    bf16x8 qr[4];
#pragma unroll
    for (int s = 0; s < 4; ++s) qr[s] = *(const bf16x8*)(s9 + mrow * 512 + hh * 64 + 16 * s + 8 * hi);
    for (int e = tid; e < 8 * 32 * 65; e += 512) impw[e] = 0.f;
    const bf16* gp = s6 + mrow * 512 + 272 + hh * 3;
    const float gc = sigmoidf_(bf2f(gp[0])), gs = sigmoidf_(bf2f(gp[1])), gwn = sigmoidf_(bf2f(gp[2]));
    f32x16 oacc[2]; oacc[0] = (f32x16){}; oacc[1] = (f32x16){};
    f32x16 o[2];
    float* impme = impw + (w * 32 + r32) * 65;
    const int ntc = (qb >> 4) + 1;
    float mc = -1e30f, lc = 0.f;
    run_tiles<0>(KC, VC, 64, 0, ntc - 1, Kt, Vt, qr, t, 0ull, mc, lc, o, 0.f, 0.f, impme, tid, r32, hi);
    lc += __shfl_xor(lc, 32);
    const float invlc = lc > 0.f ? 1.f / lc : 0.f;
    o[0] = (f32x16){}; o[1] = (f32x16){};
    { float dm = 0.f, dl = 0.f; run_tiles<1>(KC, VC, 64, 0, ntc - 1, Kt, Vt, qr, t, 0ull, dm, dl, o, mc, invlc, impme, tid, r32, hi); }
    oacc[0] += o[0] * gc; oacc[1] += o[1] * gc;
    __syncthreads();
    for (int tk = w; tk < 64; tk += 8) {
        float v = 0.f;
#pragma unroll
        for (int r = 0; r < 4; ++r) v += impw[((2 * r + (tk >> 5)) * 32 + (tk & 31)) * 65 + lane];
        const int cur = qb; const bool valid = lane <= cur, forced = lane == 0 || lane == cur || lane == cur - 1;
        const float sc = valid ? (forced ? 1e9f : v) : -1e9f;
        int rank = 0;
#pragma unroll 4
        for (int i = 0; i < 64; ++i) { const float si = __shfl(sc, i); rank += (si > sc || (si == sc && i < lane)) ? 1 : 0; }
        const unsigned long long mk = __ballot(rank < 16 && sc > -1e8f);
        if (lane == 0) selm[tk] = mk;
    }
    __syncthreads();
    const unsigned long long sel = selm[tokl];
    {
        float ms = -1e30f, ls = 0.f; o[0] = (f32x16){}; o[1] = (f32x16){};
        run_tiles<2>(s5 + rowb * 512 + 256 + g * 64, s5 + rowb * 512 + 384 + g * 64, 512, 0, qb, Kt, Vt, qr, t, sel, ms, ls, o, 0.f, 0.f, impme, tid, r32, hi);
        ls += __shfl_xor(ls, 32); const float sc = gs / ls; oacc[0] += o[0] * sc; oacc[1] += o[1] * sc;
    }
    {
        float ms = -1e30f, ls = 0.f; o[0] = (f32x16){}; o[1] = (f32x16){};
        run_tiles<3>(s6 + rowb * 512 + g * 64, s6 + rowb * 512 + 128 + g * 64, 512, qb > 8 ? qb - 8 : 0, qb, Kt, Vt, qr, t, 0ull, ms, ls, o, 0.f, 0.f, impme, tid, r32, hi);
        ls += __shfl_xor(ls, 32); const float sc = gwn / ls; oacc[0] += o[0] * sc; oacc[1] += o[1] * sc;
    }
#pragma unroll
    for (int db = 0; db < 2; ++db)
#pragma unroll
        for (int rg = 0; rg < 4; ++rg) { u32x2 wv; wv.x = pk2(oacc[db][4 * rg], oacc[db][4 * rg + 1]); wv.y = pk2(oacc[db][4 * rg + 2], oacc[db][4 * rg + 3]);
            *(u32x2*)(s9 + dst_off + mrow * 512 + hh * 64 + 32 * db + 8 * rg + 4 * hi) = wv; }
    __syncthreads();
}
}

namespace pg8 {
template <int ACT  > struct EpiStore {
    static constexpr bool PERM = true, AFTER_DRAIN = false;
    bf16_t* O; int ldc; int split_cols; size_t split_stride;
    __device__ __forceinline__ void operator()(const f32x4 (&acc)[2][2][4][2], const Unit& u, int wr, int wc, int fr, int fq) const {
        const int row0 = u.pm * BM + wr * 64 + fr; int colt = u.pn * BM; bf16_t* base = O;
        { const int t = colt / split_cols; base += (size_t)t * split_stride; colt -= t * split_cols; }
        const int col0 = colt + wc * 32 + 8 * fq;
#pragma unroll
        for (int ai = 0; ai < 2; ++ai)
#pragma unroll
            for (int m = 0; m < 4; ++m) { bf16_t* rowp = base + (size_t)(row0 + ai * HALF + m * 16) * ldc + col0;
#pragma unroll
                for (int bj = 0; bj < 2; ++bj) { f32x4 v0 = acc[ai][bj][m][0], v1 = acc[ai][bj][m][1];
                    if (ACT == 2) {
#pragma unroll
                        for (int e = 0; e < 4; ++e) { v0[e] = 1.f / (1.f + __expf(-v0[e])); v1[e] = 1.f / (1.f + __expf(-v1[e])); } }
                    u32x4 w; w.x = cvt_pk_bf16(v0[0], v0[1]); w.y = cvt_pk_bf16(v0[2], v0[3]); w.z = cvt_pk_bf16(v1[0], v1[1]); w.w = cvt_pk_bf16(v1[2], v1[3]);
                    *(u32x4*)(rowp + bj * HALF) = w; } }
    }
};
__device__ __forceinline__ float bflo(unsigned w) { return __uint_as_float(w << 16); }
__device__ __forceinline__ float bfhi(unsigned w) { return __uint_as_float(w & 0xffff0000u); }
template <bool FIRST> struct EpiBranch {
    static constexpr bool PERM = true, AFTER_DRAIN = false;
    bf16_t* Mo; const bf16_t* G;
    __device__ __forceinline__ void operator()(const f32x4 (&acc)[2][2][4][2], const Unit& u, int wr, int wc, int fr, int fq) const {
        const int row0 = u.pm * BM + wr * 64 + fr, col0 = u.pn * BM + wc * 32 + 8 * fq;
#pragma unroll
        for (int ai = 0; ai < 2; ++ai)
#pragma unroll
            for (int m = 0; m < 4; ++m) { const size_t off = (size_t)(row0 + ai * HALF + m * 16) * 1024 + col0;
#pragma unroll
                for (int bj = 0; bj < 2; ++bj) { const f32x4 v0 = acc[ai][bj][m][0], v1 = acc[ai][bj][m][1];
                    const u32x4 g = *(const u32x4*)(G + off + bj * HALF);
                    float r[8] = {bflo(g.x) * v0[0], bfhi(g.x) * v0[1], bflo(g.y) * v0[2], bfhi(g.y) * v0[3], bflo(g.z) * v1[0], bfhi(g.z) * v1[1], bflo(g.w) * v1[2], bfhi(g.w) * v1[3]};
                    if (!FIRST) { const u32x4 o = *(const u32x4*)(Mo + off + bj * HALF);
                        r[0] += bflo(o.x); r[1] += bfhi(o.x); r[2] += bflo(o.y); r[3] += bfhi(o.y); r[4] += bflo(o.z); r[5] += bfhi(o.z); r[6] += bflo(o.w); r[7] += bfhi(o.w); }
                    u32x4 w; w.x = cvt_pk_bf16(r[0], r[1]); w.y = cvt_pk_bf16(r[2], r[3]); w.z = cvt_pk_bf16(r[4], r[5]); w.w = cvt_pk_bf16(r[6], r[7]);
                    *(u32x4*)(Mo + off + bj * HALF) = w; } }
    }
};
struct EpiResid {
    static constexpr bool PERM = false, AFTER_DRAIN = false;
    const float* base; float* out;
    __device__ __forceinline__ void operator()(const f32x4 (&acc)[2][2][4][2], const Unit& u, int wr, int wc, int fr, int fq) const {
        const int row0 = u.pm * BM + wr * 64 + fr, col0 = u.pn * BM + wc * 32 + 4 * fq;
#pragma unroll
        for (int ai = 0; ai < 2; ++ai)
#pragma unroll
            for (int m = 0; m < 4; ++m) { const size_t off = (size_t)(row0 + ai * HALF + m * 16) * 1024 + col0;
#pragma unroll
                for (int bj = 0; bj < 2; ++bj)
#pragma unroll
                    for (int n = 0; n < 2; ++n) { const f32x4 bs = *(const f32x4*)(base + off + bj * HALF + n * 16); *(f32x4*)(out + off + bj * HALF + n * 16) = bs + acc[ai][bj][m][n]; } }
    }
};
struct EpiSwiGLU {
    static constexpr bool PERM = true, AFTER_DRAIN = false;
    bf16_t* Hd;
    __device__ __forceinline__ void operator()(const f32x4 (&acc)[2][2][4][2], const Unit& u, int wr, int wc, int fr, int fq) const {
        const int row0 = u.pm * BM + wr * 64 + fr, col0 = u.pn * 128 + wc * 32 + 8 * fq;
#pragma unroll
        for (int ai = 0; ai < 2; ++ai)
#pragma unroll
            for (int m = 0; m < 4; ++m) { float r[8];
#pragma unroll
                for (int n = 0; n < 2; ++n)
#pragma unroll
                    for (int e = 0; e < 4; ++e) { const float gt = acc[ai][0][m][n][e], up = acc[ai][1][m][n][e]; r[4 * n + e] = gt / (1.f + __expf(-gt)) * up; }
                u32x4 w; w.x = cvt_pk_bf16(r[0], r[1]); w.y = cvt_pk_bf16(r[2], r[3]); w.z = cvt_pk_bf16(r[4], r[5]); w.w = cvt_pk_bf16(r[6], r[7]);
                *(u32x4*)(Hd + (size_t)(row0 + ai * HALF + m * 16) * 2816 + col0) = w; }
    }
};
}

#define LAS __attribute__((address_space(3)))
#define XB_TMO      128
#define XB_XCNT(j)  (256  + 64 * (j))
#define XB_XSUB(j)  (1280 + 64 * (j))
#define XB_XGEN(j)  (2304 + 64 * (j))
#define XB_TOP      3328
#define XB_TOPGEN   3392
#define XCD_BAR_WORDS 3456
#define XB_SPIN_CAP (1u << 18)

__device__ __forceinline__ unsigned xb_ld(unsigned* p)              { return __hip_atomic_load(p, __ATOMIC_RELAXED, __HIP_MEMORY_SCOPE_AGENT); }
__device__ __forceinline__ unsigned xb_add(unsigned* p, unsigned v) { return __hip_atomic_fetch_add(p, v, __ATOMIC_RELAXED, __HIP_MEMORY_SCOPE_AGENT); }
__device__ __forceinline__ unsigned xb_xcc_id() { return (unsigned)__builtin_amdgcn_s_getreg((3 << 11) | 20) & 0xFu; }
#define XB_SPIN(cond, bar) do { unsigned _sp = 0; while (cond) { __builtin_amdgcn_s_sleep(1); \
    if ((++_sp & 255u) == 0u) { if (xb_ld(&(bar)[XB_TMO])) break; if (_sp > XB_SPIN_CAP) { atomicAdd(&(bar)[XB_TMO], 1u); break; } } } } while (0)

struct XcdBarrier {
    unsigned* bar; unsigned x;
    volatile LAS unsigned* st;
};

__device__ __forceinline__ XcdBarrier xcd_barrier_post(unsigned* bar, volatile LAS unsigned* st) {
    XcdBarrier b; b.bar = bar; b.x = xb_xcc_id(); b.st = st;
    if (threadIdx.x == 0) (void)xb_add(&bar[XB_XCNT(b.x)], 1u);
    return b;
}
__device__ __forceinline__ void xcd_barrier_complete(unsigned* bar, unsigned x, unsigned& nloc, unsigned& nx) {
    const unsigned G = gridDim.x * gridDim.y * gridDim.z;
    unsigned sum, cnt, mine, sp = 0u;
    for (;;) {
        sum = 0u; cnt = 0u; mine = 0u;
#pragma unroll
        for (unsigned j = 0; j < 16; ++j) { const unsigned c = xb_ld(&bar[XB_XCNT(j)]); sum += c; cnt += (c > 0u) ? 1u : 0u; mine = (j == x) ? c : mine; }
        if (sum == G) break;
        __builtin_amdgcn_s_sleep(1);
        if ((++sp & 255u) == 0u) { if (xb_ld(&bar[XB_TMO])) break; if (sp > XB_SPIN_CAP) { atomicAdd(&bar[XB_TMO], 1u); break; } }
    }
    nloc = mine > 0u ? mine : 1u; nx = cnt > 0u ? cnt : 1u;
}

__device__ __forceinline__ void xcd_barrier(const XcdBarrier& b) {
    asm volatile("s_waitcnt vmcnt(0)" ::: "memory");
    __syncthreads();
    if (threadIdx.x == 0) {
        unsigned* bar = b.bar;
        __builtin_amdgcn_s_waitcnt(0);
        unsigned nloc = b.st[0], nx = b.st[1];
        if (nloc == 0u) { xcd_barrier_complete(bar, b.x, nloc, nx); b.st[0] = nloc; b.st[1] = nx; }
        const unsigned old = xb_add(&bar[XB_XSUB(b.x)], 1u);
        const unsigned gen = old / nloc;
        if (old + 1u == (gen + 1u) * nloc) {
            __builtin_amdgcn_fence(__ATOMIC_RELEASE, "agent");
            asm volatile("s_waitcnt vmcnt(0)" ::: "memory");
            const unsigned og = xb_add(&bar[XB_TOP], 1u);
            const unsigned tg = og / nx;
            if (og + 1u == (tg + 1u) * nx) xb_add(&bar[XB_TOPGEN], 1u);
            else XB_SPIN(xb_ld(&bar[XB_TOPGEN]) == tg, bar);
            __builtin_amdgcn_fence(__ATOMIC_ACQUIRE, "agent");
            xb_add(&bar[XB_XGEN(b.x)], 1u);
            asm volatile("s_waitcnt vmcnt(0)" ::: "memory");
        } else {
            XB_SPIN(xb_ld(&bar[XB_XGEN(b.x)]) == gen, bar);
            __builtin_amdgcn_fence(__ATOMIC_ACQUIRE, "agent");
            asm volatile("s_waitcnt vmcnt(0)" ::: "memory");
        }
    }
    __syncthreads();
}

#ifndef PROBE_SCAN
#define PROBE_SCAN 0
#endif
#ifndef PROBE_NSA
#define PROBE_NSA 0
#endif
#ifndef PROBE_GEMM
#define PROBE_GEMM 0
#endif
#ifndef PROBE_SYNC
#define PROBE_SYNC 0
#endif
#ifndef PROBE_EW
#define PROBE_EW 0
#endif
#ifndef MK_ONE_LAUNCH
#define MK_ONE_LAUNCH 1
#endif
constexpr int N_PHASES = 1 + 11 * 2;

using namespace mk;
__global__ void __launch_bounds__(512, 2) mk_fwd(Params p, int ph_lo, int ph_hi) {
    extern __shared__ __attribute__((aligned(16))) unsigned char lds_raw[];
    char* lds = (char*)lds_raw;
    PG8_LAS unsigned char* lds3 = (PG8_LAS unsigned char*)lds_raw;
    const int G = gridDim.x, NGW = G * 8;
#define FRESH() const int tid = fresh_tid(), lane = tid & 63, wave = __builtin_amdgcn_readfirstlane(tid >> 6), bid = fresh_bid(), gw = bid * 8 + wave; (void)lane; (void)gw; (void)bid
    unsigned char* ws = p.ws;
    bf16* H = (bf16*)(ws + WS_H); bf16* Z = (bf16*)(ws + WS_Z);
    int ph = 0;
#if MK_ONE_LAUNCH
    cg::grid_group grid = cg::this_grid();
    { volatile LAS unsigned* st0 = (volatile LAS unsigned*)(lds3 + LDS_BYTES - 64); if (threadIdx.x < 2) st0[threadIdx.x] = 0u; __syncthreads(); }
    XcdBarrier xbar = xcd_barrier_post((unsigned*)ws, (volatile LAS unsigned*)(lds3 + LDS_BYTES - 64));
#define SEAM() do { if (ph == 0) grid.sync(); else xcd_barrier(xbar); for (int q_ = 0; q_ < PROBE_SYNC; ++q_) xcd_barrier(xbar); ++ph; } while (0)
#else
#define SEAM() do { ++ph; } while (0)
#endif
#define RUN (ph >= ph_lo && ph < ph_hi)
    if (RUN) { FRESH();
_Pragma("nounroll") for (int rep = 0; rep < 1 + PROBE_EW; ++rep) {
#ifndef NO_CONV
 convert_weights(p, lds, gw, NGW, wave, lane);
#endif
 rms_to_bf16(p.in[0], p.in[1], H, gw, NGW, lane); } }
    SEAM();
    for (int l = 0; l < DEPTH; ++l) {
        const unsigned char* wb = ws + WS_W + (size_t)l * W_LAYER;
        const float* xin = l == 0 ? p.in[0] : p.out;
        if (RUN) { FRESH(); pg8::Gemm g{H, (const bf16*)(wb + OW_IN), M, NZ, D}; pg8::StaticOrder S; S.init(M, NZ, G, bid);
            pg8::EpiStore<0> E{Z, 512, 512, (size_t)M * 512};
_Pragma("nounroll") for (int rep = 0; rep < 1 + PROBE_GEMM; ++rep)
#ifndef NO_G1
pg8::gemm_phase<pg8::EpiStore<0>, pg8::StaticOrder, true, true>(lds3, g, S, E);
#endif
 }
        SEAM();
        if (RUN) { FRESH();
#ifndef NO_CMP
 for (int task = bid; task < 256; task += G) compress_task(p, l, task, lds);
#endif
#ifndef NO_ROPE
 rope_pass(p, gw, NGW, lane);
#endif
#ifndef NO_SCAN
 __syncthreads();
 for (int u = bid; u < 4096; u += G) { const int cc = u & 63, hh = (u >> 6) & 3, bb = (u >> 8) & 7; if (u < 2048) scan_prep<128, true>(p, l, bb, hh, cc, lds); else scan_prep<64, false>(p, l, bb, hh, cc, lds); }
#endif
 }
        SEAM();
        if (RUN) { FRESH();
_Pragma("nounroll")          for (int rep = 0; rep < 1 + PROBE_SCAN; ++rep) { const size_t sc_off7 = 0, sc_off8 = 0;
#ifndef NO_SCAN
            for (int u = bid; u < 256; u += G) { const int bb = (u & 127) >> 4, hh = (u & 15) >> 2, sl = u & 3; if (u < 128) scan_unit<128, true>(p, l, bb, hh, sl, lds, sc_off7); else scan_unit<64, false>(p, l, bb, hh, sl, lds, sc_off8); }
#endif
          }
_Pragma("nounroll")          for (int rep = 0; rep < 1 + PROBE_NSA; ++rep) { const size_t ns_off = 0;
#ifndef NO_NSA
            for (int vc = bid; vc < 256; vc += G) { const int bg = vc >> 4, s = vc & 15;
                for (int i = 0; i < 4; ++i) { const int qb = i == 0 ? 63 - s : (i == 1 ? 32 + s : (i == 2 ? 31 - s : s)); nsa_unit(p, bg, qb, lds, ns_off); } }
#endif
          }
        }
        SEAM();
        if (RUN) { FRESH(); finish_pass(p, l, gw, NGW, lane); }
        SEAM();
        if (RUN) { FRESH(); pg8::Gemm g{H, (const bf16*)(wb + OW_G), M, 3072, D}; pg8::StaticOrder S; S.init(M, 3072, G, bid);
            pg8::EpiStore<2> E{Z, 1024, 1024, (size_t)M * 1024};
_Pragma("nounroll") for (int rep = 0; rep < 1 + PROBE_GEMM; ++rep)
#ifndef NO_G2
pg8::gemm_phase<pg8::EpiStore<2>, pg8::StaticOrder, true, true>(lds3, g, S, E);
#endif
 }
        SEAM();
        if (RUN) { FRESH();
            pg8::StaticOrder S; S.init(M, D, G, bid);
_Pragma("nounroll") for (int rep = 0; rep < 1 + PROBE_GEMM; ++rep) {
            { pg8::Gemm g{Z + 7 * (SLAB / 2), (const bf16*)(wb + OW_BR), M, D, 512}; pg8::EpiBranch<true> E{H, Z};
#ifndef NO_G3
pg8::gemm_phase<pg8::EpiBranch<true>, pg8::StaticOrder, true, true>(lds3, g, S, E);
#endif
 }
            asm volatile("s_waitcnt vmcnt(0)" ::: "memory"); __syncthreads();
            { pg8::Gemm g{Z + 8 * (SLAB / 2), (const bf16*)(wb + OW_BR) + (size_t)D * 512, M, D, 512}; pg8::EpiBranch<false> E{H, Z + (size_t)M * 1024};
#ifndef NO_G4
pg8::gemm_phase<pg8::EpiBranch<false>, pg8::StaticOrder, true, true>(lds3, g, S, E);
#endif
 }
            asm volatile("s_waitcnt vmcnt(0)" ::: "memory"); __syncthreads();
            { pg8::Gemm g{Z + 9 * (SLAB / 2), (const bf16*)(wb + OW_BR) + (size_t)2 * D * 512, M, D, 512}; pg8::EpiBranch<false> E{H, Z + (size_t)2 * M * 1024};
#ifndef NO_G5
pg8::gemm_phase<pg8::EpiBranch<false>, pg8::StaticOrder, true, true>(lds3, g, S, E);
#endif
 }
            if (rep < PROBE_GEMM) { asm volatile("s_waitcnt vmcnt(0)" ::: "memory"); __syncthreads(); } }
        }
        SEAM();
        if (RUN) { FRESH(); pg8::Gemm g{H, (const bf16*)(wb + OW_OUT), M, D, D}; pg8::StaticOrder S; S.init(M, D, G, bid);
            pg8::EpiResid E{xin, p.out};
#ifndef NO_G6
pg8::gemm_phase<pg8::EpiResid, pg8::StaticOrder, true, true>(lds3, g, S, E);
#endif
 }
        SEAM();
        if (RUN) { FRESH(); _Pragma("nounroll") for (int rep = 0; rep < 1 + PROBE_EW; ++rep) rms_to_bf16(p.out, p.in[18] + l * D, H, gw, NGW, lane); }
        SEAM();
        if (RUN) { FRESH(); pg8::Gemm g{H, (const bf16*)(wb + OW_GU), M, 2 * FF, D}; pg8::StaticOrder S; S.init(M, 2 * FF, G, bid);
            pg8::EpiSwiGLU E{Z};
_Pragma("nounroll") for (int rep = 0; rep < 1 + PROBE_GEMM; ++rep)
#ifndef NO_G7
pg8::gemm_phase<pg8::EpiSwiGLU, pg8::StaticOrder, true, true>(lds3, g, S, E);
#endif
 }
        SEAM();
        if (RUN) { FRESH(); pg8::Gemm g{Z, (const bf16*)(wb + OW_D), M, D, FF}; pg8::StaticOrder S; S.init(M, D, G, bid);
            pg8::EpiResid E{p.out, p.out};
#ifndef NO_G8
pg8::gemm_phase<pg8::EpiResid, pg8::StaticOrder, true, true>(lds3, g, S, E);
#endif
 }
        SEAM();
        if (RUN) { FRESH(); if (l + 1 < DEPTH) rms_to_bf16(p.out, p.in[1] + (l + 1) * D, H, gw, NGW, lane); else rms_final(p.out, p.in[22], gw, NGW, lane); }
        if (l + 1 < DEPTH) SEAM();
    }
}

extern "C" void kernel_launch(void* const* d_in, const int* in_sizes, int n_in, void* d_out, int out_size, void* d_ws, size_t ws_size, hipStream_t stream) {
    static int grid = 0;
    if (grid == 0) {
        if (n_in != 23 || in_sizes[0] != M * D || out_size != M * D || ws_size < WS_NEED) { fprintf(stderr, "kernel_launch: unexpected shapes (n_in %d, in0 %d, out %d, ws %zu)\n", n_in, n_in > 0 ? in_sizes[0] : -1, out_size, ws_size); grid = -1; return; }
        int dev = 0, cus = 0, per_cu = 0;
        hipGetDevice(&dev); hipDeviceGetAttribute(&cus, hipDeviceAttributeMultiprocessorCount, dev);
        hipFuncSetAttribute((const void*)mk_fwd, hipFuncAttributeMaxDynamicSharedMemorySize, LDS_BYTES);
        hipOccupancyMaxActiveBlocksPerMultiprocessor(&per_cu, (const void*)mk_fwd, 512, LDS_BYTES);
        (void)hipGetLastError();
        if (per_cu < 1) per_cu = 1;
        grid = cus;
    }
    if (grid < 0) return;
    Params p{};
    for (int i = 0; i < 23; ++i) p.in[i] = (const float*)d_in[i];
    p.out = (float*)d_out; p.ws = (unsigned char*)d_ws;
#if MK_ONE_LAUNCH
    int lo = 0, hi = 1000;
    void* args[] = {&p, &lo, &hi};
    if (hipMemsetAsync(d_ws, 0, 65536, stream) != hipSuccess) { fprintf(stderr, "memset failed\n"); return; }
    hipError_t e = hipLaunchCooperativeKernel((const void*)mk_fwd, dim3(grid), dim3(512), args, LDS_BYTES, stream);
    if (e != hipSuccess) fprintf(stderr, "cooperative launch failed: %s (grid %d)\n", hipGetErrorString(e), grid);
#else
    for (int ph = 0; ph < N_PHASES; ++ph) hipLaunchKernelGGL(mk_fwd, dim3(grid), dim3(512), LDS_BYTES, stream, p, ph, ph + 1);
#endif
}
```

```cpp
#include <hip/hip_runtime.h>
#include <hip/hip_cooperative_groups.h>
#include <cstdio>
#include <cstdint>
namespace cg = cooperative_groups;
namespace pg8 {
#define PG8_LAS __attribute__((address_space(3)))
typedef unsigned short bf16_t;
typedef short bf16x8 __attribute__((ext_vector_type(8)));
typedef float f32x4 __attribute__((ext_vector_type(4)));
typedef unsigned u32x4 __attribute__((ext_vector_type(4)));
constexpr int BM = 256, BK = 64, HALF = 128, HTB = HALF * BK * 2  , STAGE_BYTES = 8 * HTB, NXCD = 8, WGM = 8;

__host__ __device__ __forceinline__ int lds_byte(int r, int c) { const int st = (r >> 4) * 2 + (c >> 5), rr = r & 15, cc = c & 31, ob = rr * 64 + cc * 2; return st * 1024 + (ob ^ (((ob >> 9) & 1) << 5)); }
__host__ __device__ __forceinline__ void stage_rc(int b, int& R, int& C) { const int st = b / 1024, sb = b % 1024, swz = sb ^ (((sb >> 9) & 1) << 5); R = (st >> 1) * 16 + swz / 64; C = (st & 1) * 32 + (swz % 64) / 2; }
__host__ __device__ __forceinline__ int perm32(int rho) { const int n = rho >> 4, i = rho & 15; return 8 * (i >> 2) + 4 * n + (i & 3); }

struct Unit { int pm, pn; };
struct Gemm { const bf16_t* A; const bf16_t* Bt; int M, N, K; };

struct StaticOrder {
    int nM, nN, nwg, G, c;
    __host__ __device__ void init(int M, int N, int G_, int c_) { nM = M / BM; nN = N / BM; nwg = nM * nN; G = G_; c = c_; }
    __host__ __device__ bool next(int i, Unit& u) const {
        const long L = (long)i * G + c; if (L >= nwg) return false;
        int wgid = (int)L; { const int q = nwg / NXCD, r = nwg % NXCD, xcd = wgid % NXCD, off = wgid / NXCD; wgid = (xcd < r ? xcd * (q + 1) : r * (q + 1) + (xcd - r) * q) + off; }
        const int nig = WGM * nN, gid = wgid / nig, fm = gid * WGM, gsz = (nM - fm) < WGM ? (nM - fm) : WGM;
        u.pm = fm + ((wgid % nig) % gsz); u.pn = (wgid % nig) / gsz; return true;
    }
    __device__ __forceinline__ void a_ready(const Unit&) const {}
    __device__ __forceinline__ void done(const Unit&) const {}
};

__device__ __forceinline__ unsigned cvt_pk_bf16(float lo, float hi) { unsigned r; asm volatile("v_cvt_pk_bf16_f32 %0, %1, %2" : "=v"(r) : "v"(lo), "v"(hi)); return r; }
typedef float f32x2 __attribute__((ext_vector_type(2)));
__device__ __forceinline__ f32x2 gelu_pk(f32x2 v) {
    const f32x2 av = __builtin_elementwise_abs(v), d = av * 0.2316418882f + 1.0f;
    f32x2 t; t.x = __builtin_amdgcn_rcpf(d.x); t.y = __builtin_amdgcn_rcpf(d.y);
    f32x2 q = t * 0.5307027145f + (-0.7265760135f); q = q * t + 0.7107068705f; q = q * t + (-0.142248368f); q = q * t + 0.127414796f; q = q * t;
    const f32x2 s = (v * v) * (-0.72134752044f);
    f32x2 e; e.x = __builtin_amdgcn_exp2f(s.x); e.y = __builtin_amdgcn_exp2f(s.y);
    const f32x2 m = v * (q * e), r = v - m;
    f32x2 o; o.x = v.x < 0.f ? m.x : r.x; o.y = v.y < 0.f ? m.y : r.y; return o;
}

template <int ACT  > struct EpiBf16 {
    static constexpr bool PERM = true, AFTER_DRAIN = false; static_assert(ACT == 0 || ACT == 1, "EpiBf16: ACT is 0 (none) or 1 (gelu_pk)");
    bf16_t* O; int ldc; const float* bias; int split_cols; size_t split_stride; float scale0;
    __device__ __forceinline__ void operator()(const f32x4 (&acc)[2][2][4][2], const Unit& u, int wr, int wc, int fr, int fq) const {
        const int row0 = u.pm * BM + wr * 64 + fr; int colt = u.pn * BM; bf16_t* base = O;
        float sc = 1.f; if (split_cols) { const int t = colt / split_cols; base += (size_t)t * split_stride; colt -= t * split_cols; if (t == 0) sc = scale0; }
        const int col0 = colt + wc * 32 + 8 * fq, bcol0 = u.pn * BM + wc * 32 + 8 * fq;
        f32x4 bv[2][2];
#pragma unroll
        for (int bj = 0; bj < 2; ++bj)
#pragma unroll
            for (int n = 0; n < 2; ++n) bv[bj][n] = bias ? *(const f32x4*)(bias + bcol0 + bj * HALF + 4 * n) : (f32x4){0.f, 0.f, 0.f, 0.f};
#pragma unroll
        for (int ai = 0; ai < 2; ++ai)
#pragma unroll
            for (int m = 0; m < 4; ++m) { bf16_t* rowp = base + (size_t)(row0 + ai * HALF + m * 16) * ldc + col0;
#pragma unroll
                for (int bj = 0; bj < 2; ++bj) { f32x4 v0 = acc[ai][bj][m][0] + bv[bj][0], v1 = acc[ai][bj][m][1] + bv[bj][1];
                    if (ACT == 1) { f32x2 a = gelu_pk((f32x2){v0[0], v0[1]}), b = gelu_pk((f32x2){v0[2], v0[3]}), c = gelu_pk((f32x2){v1[0], v1[1]}), d = gelu_pk((f32x2){v1[2], v1[3]});
                        v0 = (f32x4){a.x, a.y, b.x, b.y}; v1 = (f32x4){c.x, c.y, d.x, d.y}; }
                    v0 = v0 * sc; v1 = v1 * sc; u32x4 w; w.x = cvt_pk_bf16(v0[0], v0[1]); w.y = cvt_pk_bf16(v0[2], v0[3]); w.z = cvt_pk_bf16(v1[0], v1[1]); w.w = cvt_pk_bf16(v1[2], v1[3]);
                    *(u32x4*)(rowp + bj * HALF) = w; } }
    }
};
template <class Epi, class Sched, bool ALIGN_EPI = false, bool SP2 = false>
__device__ __forceinline__ void gemm_phase(PG8_LAS unsigned char* lds, const Gemm g, const Sched& S, const Epi& E) {
    int tid = threadIdx.x; asm volatile("" : "+v"(tid));
    const int wid = __builtin_amdgcn_readfirstlane(tid >> 6), lane = tid & 63, wr = wid >> 2, wc = wid & 3, fr = lane & 15, fq = lane >> 4;
    const int K = g.K, nt = K / BK;
    unsigned voffA[2], voffB[2];
#pragma unroll
    for (int i = 0; i < 2; ++i) { int R, C; stage_rc(tid * 16 + i * 8192, R, C); const int Rb = Epi::PERM ? ((R & ~31) + perm32(R & 31)) : R;
        voffA[i] = (unsigned)(R * K + C) * 2u; voffB[i] = (unsigned)(Rb * K + C) * 2u; }
    const size_t kstep = (size_t)(BK * 2);
    const size_t hstep = (size_t)HALF * K * 2;
    const size_t tstep = 2 * hstep;
    const unsigned ldsw = (unsigned)wid * 1024u;
    const int aoff = lds_byte(wr * 64 + fr, fq * 8), boff = lds_byte(wc * 32 + fr, fq * 8);
#define PG8_SA(b, h) (((b) * 2 + (h)) * HTB)
#define PG8_SB(b, h) ((4 + (b) * 2 + (h)) * HTB)
#define PG8_STAGE(bufoff, gbase, voff) do { _Pragma("unroll") for (int _i = 0; _i < 2; ++_i) \
        __builtin_amdgcn_global_load_lds((const unsigned*)((const char*)(gbase) + (voff)[_i]), (PG8_LAS unsigned*)(lds + (bufoff) + ldsw + _i * 8192), 16, 0, 0); } while (0)
#define PG8_LDA(dst, b, h) do { _Pragma("unroll") for (int m = 0; m < 4; ++m) _Pragma("unroll") for (int k = 0; k < 2; ++k) dst[m][k] = *(const PG8_LAS bf16x8*)(lds + PG8_SA(b, h) + aoff + m * 2048 + k * 1024); } while (0)
#define PG8_LDB(dst, b, h) do { _Pragma("unroll") for (int n = 0; n < 2; ++n) _Pragma("unroll") for (int k = 0; k < 2; ++k) dst[n][k] = *(const PG8_LAS bf16x8*)(lds + PG8_SB(b, h) + boff + n * 2048 + k * 1024); } while (0)
#define PG8_MMA(ai, bj, At, Bt) do { __builtin_amdgcn_s_setprio(1); _Pragma("unroll") for (int m = 0; m < 4; ++m) _Pragma("unroll") for (int n = 0; n < 2; ++n) _Pragma("unroll") for (int k = 0; k < 2; ++k) \
        acc[ai][bj][m][n] = __builtin_amdgcn_mfma_f32_16x16x32_bf16(Bt[n][k], At[m][k], acc[ai][bj][m][n], 0, 0, 0); __builtin_amdgcn_s_setprio(0); } while (0)
#define PG8_WAIT_V(n) asm volatile("s_waitcnt vmcnt(" #n ")" ::: "memory")
#define PG8_WAIT_L(n) asm volatile("s_waitcnt lgkmcnt(" #n ")" ::: "memory")
#define PG8_BAR __builtin_amdgcn_s_barrier()
#define PG8_SCHED __builtin_amdgcn_sched_barrier(0)
    Unit cur, nxt; int ui = 0;
    if (!S.next(0, cur)) return;
    f32x4 acc[2][2][4][2];
#pragma unroll
    for (int a = 0; a < 2; ++a)
#pragma unroll
        for (int b = 0; b < 2; ++b)
#pragma unroll
            for (int m = 0; m < 4; ++m)
#pragma unroll
                for (int n = 0; n < 2; ++n) acc[a][b][m][n] = (f32x4){0.f, 0.f, 0.f, 0.f};
    bf16x8 At[4][2], B0[2][2], B1[2][2];
    const char* cA = (const char*)g.A + (size_t)cur.pm * tstep; const char* cB = (const char*)g.Bt + (size_t)cur.pn * tstep;
    S.a_ready(cur);
    if constexpr (SP2) {
        PG8_STAGE(PG8_SB(0, 0), cB, voffB); PG8_STAGE(PG8_SB(0, 1), cB + hstep, voffB); PG8_STAGE(PG8_SA(0, 0), cA, voffA); PG8_STAGE(PG8_SA(0, 1), cA + hstep, voffA);
        if (wr == 1) PG8_BAR;
        PG8_WAIT_V(2); PG8_BAR;
        PG8_STAGE(PG8_SB(1, 0), cB + kstep, voffB); PG8_STAGE(PG8_SA(1, 0), cA + kstep, voffA); PG8_STAGE(PG8_SB(1, 1), cB + hstep + kstep, voffB);
        PG8_WAIT_V(6); PG8_BAR;
    } else {
        PG8_STAGE(PG8_SB(0, 0), cB, voffB); PG8_STAGE(PG8_SA(0, 0), cA, voffA); PG8_STAGE(PG8_SB(0, 1), cB + hstep, voffB); PG8_STAGE(PG8_SA(0, 1), cA + hstep, voffA);
        if (wr == 1) PG8_BAR;
        PG8_WAIT_V(4); PG8_BAR;
        PG8_STAGE(PG8_SB(1, 0), cB + kstep, voffB); PG8_STAGE(PG8_SA(1, 0), cA + kstep, voffA); PG8_STAGE(PG8_SB(1, 1), cB + hstep + kstep, voffB);
        PG8_WAIT_V(6); PG8_BAR;
    }
    for (;;) {
        const bool has_next = S.next(ui + 1, nxt);
        const char* nA = has_next ? (const char*)g.A + (size_t)nxt.pm * tstep : cA; const char* nB = has_next ? (const char*)g.Bt + (size_t)nxt.pn * tstep : cB;
        for (int t = 0; t < nt; t += 2) {
            const bool last = (t == nt - 2);
            const char* a1 = cA + (size_t)(t + 1) * kstep;
            const char* a2 = last ? nA : cA + (size_t)(t + 2) * kstep; const char* b2 = last ? nB : cB + (size_t)(t + 2) * kstep;
            const char* a3 = a2 + kstep; const char* b3 = b2 + kstep;
            if (last && has_next) S.a_ready(nxt);
            if constexpr (SP2) {
            PG8_LDB(B0, 0, 0); PG8_LDB(B1, 0, 1); PG8_SCHED; PG8_LDA(At, 0, 0); PG8_STAGE(PG8_SA(1, 1), a1 + hstep, voffA);
            PG8_WAIT_V(8); PG8_WAIT_L(0); PG8_BAR; PG8_MMA(0, 0, At, B0); PG8_MMA(0, 1, At, B1); PG8_BAR; PG8_SCHED;
            PG8_LDA(At, 0, 1); PG8_STAGE(PG8_SB(0, 0), b2, voffB); PG8_STAGE(PG8_SB(0, 1), b2 + hstep, voffB); PG8_STAGE(PG8_SA(0, 0), a2, voffA);
            PG8_WAIT_V(8); PG8_WAIT_L(0); PG8_BAR; PG8_MMA(1, 0, At, B0); PG8_MMA(1, 1, At, B1); PG8_BAR; PG8_SCHED;
            PG8_LDB(B0, 1, 0); PG8_LDB(B1, 1, 1); PG8_SCHED; PG8_LDA(At, 1, 0); PG8_STAGE(PG8_SA(0, 1), a2 + hstep, voffA);
            PG8_WAIT_V(8); PG8_WAIT_L(0); PG8_BAR; PG8_MMA(0, 0, At, B0); PG8_MMA(0, 1, At, B1); PG8_BAR; PG8_SCHED;
            PG8_LDA(At, 1, 1); PG8_STAGE(PG8_SB(1, 0), b3, voffB); PG8_STAGE(PG8_SB(1, 1), b3 + hstep, voffB); PG8_STAGE(PG8_SA(1, 0), a3, voffA);
            PG8_WAIT_V(8); PG8_WAIT_L(0); PG8_BAR; PG8_MMA(1, 0, At, B0); PG8_MMA(1, 1, At, B1); PG8_BAR; PG8_SCHED;
            } else {
            PG8_LDB(B0, 0, 0); PG8_SCHED; PG8_LDA(At, 0, 0); PG8_STAGE(PG8_SA(1, 1), a1 + hstep, voffA);
            PG8_WAIT_L(8); PG8_BAR; PG8_WAIT_L(0); PG8_MMA(0, 0, At, B0); PG8_BAR; PG8_SCHED;
            PG8_LDB(B1, 0, 1); PG8_STAGE(PG8_SB(0, 0), b2, voffB);
            PG8_BAR; PG8_WAIT_L(0); PG8_MMA(0, 1, At, B1); PG8_BAR;
            PG8_LDA(At, 0, 1); PG8_STAGE(PG8_SA(0, 0), a2, voffA);
            PG8_BAR; PG8_WAIT_L(0); PG8_MMA(1, 0, At, B0); PG8_BAR; PG8_SCHED;
            PG8_STAGE(PG8_SB(0, 1), b2 + hstep, voffB);
            PG8_WAIT_V(6); PG8_BAR; PG8_MMA(1, 1, At, B1); PG8_BAR;
            PG8_LDB(B0, 1, 0); PG8_SCHED; PG8_LDA(At, 1, 0); PG8_STAGE(PG8_SA(0, 1), a2 + hstep, voffA);
            PG8_WAIT_L(8); PG8_BAR; PG8_WAIT_L(0); PG8_MMA(0, 0, At, B0); PG8_BAR; PG8_SCHED;
            PG8_LDB(B1, 1, 1); PG8_STAGE(PG8_SB(1, 0), b3, voffB);
            PG8_BAR; PG8_WAIT_L(0); PG8_MMA(0, 1, At, B1); PG8_BAR;
            PG8_LDA(At, 1, 1); PG8_STAGE(PG8_SA(1, 0), a3, voffA);
            PG8_BAR; PG8_WAIT_L(0); PG8_MMA(1, 0, At, B0); PG8_BAR; PG8_SCHED;
            PG8_STAGE(PG8_SB(1, 1), b3 + hstep, voffB);
            PG8_WAIT_V(6); PG8_BAR; PG8_MMA(1, 1, At, B1); PG8_BAR;
            }
        }
        if constexpr (ALIGN_EPI) { if (wr == 0) PG8_BAR; }
        if constexpr (!Epi::AFTER_DRAIN) { E(acc, cur, wr, wc, fr, fq); S.done(cur); }
        if (!has_next) break;
#pragma unroll
        for (int a = 0; a < 2; ++a)
#pragma unroll
            for (int b = 0; b < 2; ++b)
#pragma unroll
                for (int m = 0; m < 4; ++m)
#pragma unroll
                    for (int n = 0; n < 2; ++n) acc[a][b][m][n] = (f32x4){0.f, 0.f, 0.f, 0.f};
        cur = nxt; cA = nA; cB = nB; ++ui;
        if constexpr (ALIGN_EPI) { if (wr == 1) PG8_BAR; }
    }
    PG8_WAIT_V(0);
    if constexpr (!ALIGN_EPI) { if (wr == 0) PG8_BAR; }
    PG8_BAR;
    if constexpr (Epi::AFTER_DRAIN) { E.fused(acc, cur, wr, wc, fr, fq, lds, wid, lane); S.done(cur); }
#undef PG8_SA
#undef PG8_SB
#undef PG8_STAGE
#undef PG8_LDA
#undef PG8_LDB
#undef PG8_MMA
#undef PG8_WAIT_V
#undef PG8_WAIT_L
#undef PG8_BAR
#undef PG8_SCHED
}
}

namespace mk {
typedef unsigned short bf16;
typedef short bf16x8 __attribute__((ext_vector_type(8)));
typedef float f32x16 __attribute__((ext_vector_type(16)));
typedef float f32x4 __attribute__((ext_vector_type(4)));
typedef unsigned u32x4 __attribute__((ext_vector_type(4)));
typedef unsigned u32x2 __attribute__((ext_vector_type(2)));

constexpr int BATCH = 8, T = 4096, D = 1024, M = BATCH * T, DEPTH = 2, INC = 7976, FF = 2816, NZ = 5120;
constexpr size_t MiB = 1u << 20;
constexpr size_t WS_W = 1 * MiB, W_LAYER = 40 * MiB;
constexpr size_t OW_IN = 0, OW_G = 10 * MiB, OW_BR = 16 * MiB, OW_OUT = 19 * MiB, OW_GU = 21 * MiB, OW_D = 32 * MiB,
                 OW_C1K = 38 * MiB, OW_C1V = 38 * MiB + 512 * 1024, OW_C2K = 39 * MiB, OW_C2V = 39 * MiB + 256 * 1024;
constexpr size_t WS_KC = 81 * MiB, WS_VC = WS_KC + 512 * 1024;
constexpr size_t WS_H = 82 * MiB, WS_Z = 146 * MiB, SLAB = 32 * MiB, WS_END = WS_Z + 10 * SLAB;
constexpr int LDS_BYTES = 147456;
constexpr float C2 = 0.18033688011112042f;

struct Params { const float* in[23]; float* out; unsigned char* ws; };

__device__ __forceinline__ float bf2f(bf16 v) { return __uint_as_float(((unsigned)v) << 16); }
__device__ __forceinline__ unsigned f2bf(float f) { unsigned u = __float_as_uint(f); return (u + 0x7fffu + ((u >> 16) & 1u)) >> 16; }
__device__ __forceinline__ unsigned pk2(float lo, float hi) { return f2bf(lo) | (f2bf(hi) << 16); }
__device__ __forceinline__ float lo16(unsigned w) { return __uint_as_float(w << 16); }
__device__ __forceinline__ float hi16(unsigned w) { return __uint_as_float(w & 0xffff0000u); }
__device__ __forceinline__ f32x16 mfma32(bf16x8 a, bf16x8 b, f32x16 c) { return __builtin_amdgcn_mfma_f32_32x32x16_bf16(a, b, c, 0, 0, 0); }
__device__ __forceinline__ int crow(int r, int hi) { return (r & 3) + 8 * (r >> 2) + 4 * hi; }
__device__ __forceinline__ float wave_sum(float v) {
#pragma unroll
    for (int o = 1; o < 64; o <<= 1) v += __shfl_xor(v, o);
    return v;
}
__device__ __forceinline__ float sigmoidf_(float x) { return 1.f / (1.f + __expf(-x)); }
__device__ __forceinline__ float siluf_(float x) { return x / (1.f + __expf(-x)); }
#define LDS_WAIT() asm volatile("s_waitcnt lgkmcnt(0)" ::: "memory")
__device__ __forceinline__ int fresh_tid() { int t = threadIdx.x; asm volatile("" : "+v"(t)); return t; }
__device__ __forceinline__ int fresh_bid() { int t = blockIdx.x; asm volatile("" : "+s"(t)); return t; }

template <class F>
__device__ __forceinline__ void wt_convert(F colptr, int ld, int K, int N, bf16* WT, float* scr, int gw, int NGW, int lane) {
    const int nblk = N / 32, nitems = (K / 64) * nblk;
    for (int it = gw; it < nitems; it += NGW) {
        const int kb = it / nblk, nb = it % nblk, k0 = 64 * kb, n0 = 32 * nb;
        const float* cp = colptr(n0 + (lane & 31));
#pragma unroll 8
        for (int i = 0; i < 32; ++i) { const int kk = 2 * i + (lane >> 5); scr[kk * 33 + (lane & 31)] = cp ? cp[(size_t)(k0 + kk) * ld] : 0.f; }
        LDS_WAIT();
        const int c = lane & 7;
#pragma unroll
        for (int j = 0; j < 4; ++j) {
            const int n = (lane >> 3) + 8 * j; const float* s = scr + (8 * c) * 33 + n;
            u32x4 o; o.x = pk2(s[0 * 33], s[1 * 33]); o.y = pk2(s[2 * 33], s[3 * 33]); o.z = pk2(s[4 * 33], s[5 * 33]); o.w = pk2(s[6 * 33], s[7 * 33]);
            *(u32x4*)(WT + (size_t)(n0 + n) * K + k0 + 8 * c) = o;
        }
        LDS_WAIT();
    }
}

__device__ __forceinline__ void convert_weights(const Params& p, char* lds, int gw, int NGW, int wave, int lane) {
    float* scr = (float*)(lds + wave * 8448);
    for (int l = 0; l < DEPTH; ++l) {
        unsigned char* wb = p.ws + WS_W + (size_t)l * W_LAYER;
        const float* win = p.in[2] + (size_t)l * D * INC;
        wt_convert([=](int n) -> const float* {
            const int s = n >> 9, c = n & 511; int src;
            switch (s) { case 0: src = c; break; case 1: src = 512 + c; break; case 2: src = 1536 + c; break; case 3: src = 2048 + c; break; case 4: src = 3088 + c; break;
                         case 5: src = 4112 + c; break; case 6: src = c < 256 ? 4624 + c : (c < 272 ? 3072 + (c - 256) : (c < 296 ? 4880 + (c - 272) : -1)); break;
                         case 7: src = 1024 + c; break; case 8: src = 2560 + c; break; default: src = 3600 + c; break; }
            return src < 0 ? nullptr : win + src; }, INC, D, NZ, (bf16*)(wb + OW_IN), scr, gw, NGW, lane);
        wt_convert([=](int n) -> const float* { return win + 4904 + n; }, INC, D, 3072, (bf16*)(wb + OW_G), scr, gw, NGW, lane);
        for (int b = 0; b < 3; ++b) { const float* w = p.in[14 + b] + (size_t)l * 512 * D;
            wt_convert([=](int n) -> const float* { return w + n; }, D, 512, D, (bf16*)(wb + OW_BR) + (size_t)b * D * 512, scr, gw, NGW, lane); }
        { const float* w = p.in[17] + (size_t)l * D * D; wt_convert([=](int n) -> const float* { return w + n; }, D, D, D, (bf16*)(wb + OW_OUT), scr, gw, NGW, lane); }
        { const float* wg = p.in[19] + (size_t)l * D * FF; const float* wu = p.in[20] + (size_t)l * D * FF;
          wt_convert([=](int n) -> const float* { const int j = n >> 8, i = n & 255; return i < 128 ? wg + 128 * j + i : wu + 128 * j + (i - 128); }, FF, D, 2 * FF, (bf16*)(wb + OW_GU), scr, gw, NGW, lane); }
        { const float* w = p.in[21] + (size_t)l * FF * D; wt_convert([=](int n) -> const float* { return w + n; }, D, FF, D, (bf16*)(wb + OW_D), scr, gw, NGW, lane); }
        { const float* w = p.in[10] + (size_t)l * 2048 * 128; wt_convert([=](int n) -> const float* { return w + n; }, 128, 2048, 128, (bf16*)(wb + OW_C1K), scr, gw, NGW, lane); }
        { const float* w = p.in[12] + (size_t)l * 2048 * 128; wt_convert([=](int n) -> const float* { return w + n; }, 128, 2048, 128, (bf16*)(wb + OW_C1V), scr, gw, NGW, lane); }
        { const float* w = p.in[11] + (size_t)l * 128 * 64; wt_convert([=](int n) -> const float* { return w + n; }, 64, 128, 64, (bf16*)(wb + OW_C2K), scr, gw, NGW, lane); }
        { const float* w = p.in[13] + (size_t)l * 128 * 64; wt_convert([=](int n) -> const float* { return w + n; }, 64, 128, 64, (bf16*)(wb + OW_C2V), scr, gw, NGW, lane); }
    }
}

__device__ __forceinline__ void rms_to_bf16(const float* x, const float* g, bf16* out, int gw, int NGW, int lane) {
    for (int m = gw; m < M; m += NGW) {
        const f32x4* xr = (const f32x4*)(x + (size_t)m * D) + lane; f32x4 v[4]; float s = 0.f;
#pragma unroll
        for (int j = 0; j < 4; ++j) { v[j] = xr[64 * j]; s += (v[j].x * v[j].x + v[j].y * v[j].y) + (v[j].z * v[j].z + v[j].w * v[j].w); }
        const float r = rsqrtf(wave_sum(s) * (1.f / D) + 1e-6f);
        u32x2* o = (u32x2*)(out + (size_t)m * D) + lane;
#pragma unroll
        for (int j = 0; j < 4; ++j) { const f32x4 gg = ((const f32x4*)g)[lane + 64 * j]; u32x2 w; w.x = pk2(v[j].x * r * gg.x, v[j].y * r * gg.y); w.y = pk2(v[j].z * r * gg.z, v[j].w * r * gg.w); o[64 * j] = w; }
    }
}
__device__ __forceinline__ void rms_final(float* x, const float* g, int gw, int NGW, int lane) {
    for (int m = gw; m < M; m += NGW) {
        f32x4* xr = (f32x4*)(x + (size_t)m * D) + lane; f32x4 v[4]; float s = 0.f;
#pragma unroll
        for (int j = 0; j < 4; ++j) { v[j] = xr[64 * j]; s += (v[j].x * v[j].x + v[j].y * v[j].y) + (v[j].z * v[j].z + v[j].w * v[j].w); }
        const float r = rsqrtf(wave_sum(s) * (1.f / D) + 1e-6f);
#pragma unroll
        for (int j = 0; j < 4; ++j) { const f32x4 gg = ((const f32x4*)g)[lane + 64 * j]; xr[64 * j] = v[j] * r * gg; }
    }
}

__device__ __forceinline__ float inv_freq(int i) {
    switch (i) { case 0: return 1.0f; case 1: return 0.19392274474868576f; case 2: return 0.03760603093086393f; case 3: return 0.007292664737217109f;
                 case 4: return 0.001414213562373095f; case 5: return 0.0002742481756762073f; case 6: return 5.318295896944988e-05f; default: return 1.031338537721246e-05f; }
}
__device__ __forceinline__ void rope_cs(int t, int i, float& c, float& s) {
    const float ang = (float)t * inv_freq(i);
    const double rev = (double)ang * 0.15915494309189535; const float fr = (float)(rev - floor(rev));
    s = __builtin_amdgcn_sinf(fr); c = __builtin_amdgcn_cosf(fr);
}

__device__ __forceinline__ void rope_pass(const Params& p, int gw, int NGW, int lane) {
    bf16* Z = (bf16*)(p.ws + WS_Z);
    bf16* q = Z + 9 * (SLAB / 2); bf16* s5 = Z + 5 * (SLAB / 2); bf16* s6 = Z + 6 * (SLAB / 2);
    for (int m = gw; m < M; m += NGW) {
        const int t = m & (T - 1);
        float cl, sl; rope_cs(t, lane & 7, cl, sl);
        float cs[8], sn[8];
#pragma unroll
        for (int i = 0; i < 8; ++i) { cs[i] = __shfl(cl, i); sn[i] = __shfl(sl, i); }
        const int ch = lane & 7;
        {
            u32x4* ptr = (u32x4*)(q + (size_t)m * 512 + 8 * lane); const u32x4 w = *ptr; float v[8], o[8];
#pragma unroll
            for (int e = 0; e < 4; ++e) { v[2 * e] = lo16(w[e]); v[2 * e + 1] = hi16(w[e]); }
#pragma unroll
            for (int e = 0; e < 8; ++e) { const float pv = __shfl_xor(v[e], 1); o[e] = ch == 0 ? v[e] * cs[e] - pv * sn[e] : (ch == 1 ? v[e] * cs[e] + pv * sn[e] : v[e]); o[e] *= C2; }
            u32x4 r; r.x = pk2(o[0], o[1]); r.y = pk2(o[2], o[3]); r.z = pk2(o[4], o[5]); r.w = pk2(o[6], o[7]); *ptr = r;
        }
        {
            bf16* base = lane < 16 ? s5 + (size_t)m * 512 + 256 + 8 * lane : s6 + (size_t)m * 512 + 8 * (lane - 16);
            u32x4* ptr = (u32x4*)base; u32x4 w = (u32x4){0u, 0u, 0u, 0u}; if (lane < 32) w = *ptr; float v[8], o[8];
#pragma unroll
            for (int e = 0; e < 4; ++e) { v[2 * e] = lo16(w[e]); v[2 * e + 1] = hi16(w[e]); }
#pragma unroll
            for (int e = 0; e < 8; ++e) { const float pv = __shfl_xor(v[e], 1); o[e] = ch == 0 ? v[e] * cs[e] - pv * sn[e] : (ch == 1 ? v[e] * cs[e] + pv * sn[e] : v[e]); }
            u32x4 r; r.x = pk2(o[0], o[1]); r.y = pk2(o[2], o[3]); r.z = pk2(o[4], o[5]); r.w = pk2(o[6], o[7]); if (lane < 32) *ptr = r;
        }
    }
}

__device__ __forceinline__ float gelu_tanh(float x) { const float u = 0.7978845608028654f * (x + 0.044715f * x * x * x); const float e = __expf(2.f * u); const float th = 1.f - 2.f / (e + 1.f); return 0.5f * x * (1.f + th); }
__device__ __forceinline__ void compress_task(const Params& p, int layer, int task, char* lds) {
    const int tid = fresh_tid(), lane = tid & 63, w = __builtin_amdgcn_readfirstlane(tid >> 6), r32 = lane & 31, hi = lane >> 5;
    const int kind = task >> 7, rg = task & 127;
    const bf16* s5 = (const bf16*)(p.ws + WS_Z) + 5 * (SLAB / 2);
    const unsigned char* wb = p.ws + WS_W + (size_t)layer * W_LAYER;
    const bf16* w1T = (const bf16*)(wb + (kind ? OW_C1V : OW_C1K)); const bf16* w2T = (const bf16*)(wb + (kind ? OW_C2V : OW_C2K));
    const float* pos = p.in[kind ? 9 : 8] + (size_t)layer * 32 * 64;
    bf16* dst = (bf16*)(p.ws + (kind ? WS_VC : WS_KC));
    float* red = (float*)lds;
    bf16* hid = (bf16*)(lds + 131072);
    const int id = 32 * rg + r32; const bool valid = id < 4080; const int bg = valid ? id / 255 : 0, n = valid ? id % 255 : 0;
    const int b = bg >> 1, g = bg & 1;
    f32x16 acc[4];
#pragma unroll
    for (int i = 0; i < 4; ++i) acc[i] = (f32x16){};
    for (int s = 16 * w; s < 16 * w + 16; ++s) {
        const int j = s >> 2, d0 = 16 * (s & 3) + 8 * hi, tpos = 16 * n + j;
        const u32x4 wz = *(const u32x4*)(s5 + (size_t)(b * T + tpos) * 512 + kind * 128 + g * 64 + d0);
        float v[8];
#pragma unroll
        for (int e = 0; e < 4; ++e) { v[2 * e] = lo16(wz[e]); v[2 * e + 1] = hi16(wz[e]); }
        if (kind == 0 && (s & 3) == 0) {
#pragma unroll
            for (int e = 0; e < 8; ++e) { float c, sn; rope_cs(tpos, e, c, sn); const float pv = __shfl_xor(v[e], 32); v[e] = hi == 0 ? v[e] * c - pv * sn : v[e] * c + pv * sn; }
        }
        const f32x4 p0 = *(const f32x4*)(pos + j * 64 + d0), p1 = *(const f32x4*)(pos + j * 64 + d0 + 4);
        v[0] += p0.x; v[1] += p0.y; v[2] += p0.z; v[3] += p0.w; v[4] += p1.x; v[5] += p1.y; v[6] += p1.z; v[7] += p1.w;
        u32x4 aw; aw.x = pk2(v[0], v[1]); aw.y = pk2(v[2], v[3]); aw.z = pk2(v[4], v[5]); aw.w = pk2(v[6], v[7]);
        if (!valid) aw = (u32x4){0u, 0u, 0u, 0u};
        const bf16x8 a = __builtin_bit_cast(bf16x8, aw);
#pragma unroll
        for (int nb = 0; nb < 4; ++nb) { const bf16x8 bb = *(const bf16x8*)(w1T + (size_t)(32 * nb + r32) * 2048 + 16 * s + 8 * hi); acc[nb] = mfma32(a, bb, acc[nb]); }
    }
#pragma unroll
    for (int nb = 0; nb < 4; ++nb)
#pragma unroll
        for (int r = 0; r < 16; ++r) red[(w * 32 + crow(r, hi)) * 128 + 32 * nb + r32] = acc[nb][r];
    __syncthreads();
    for (int e = tid; e < 4096; e += 512) { float s = 0.f;
#pragma unroll
        for (int ww = 0; ww < 8; ++ww) s += red[ww * 4096 + e];
        hid[(e >> 7) * 136 + (e & 127)] = (bf16)f2bf(gelu_tanh(s)); }
    __syncthreads();
    if (w < 2) {
        f32x16 o = (f32x16){};
#pragma unroll
        for (int s = 0; s < 8; ++s) { const bf16x8 a = *(const bf16x8*)(hid + r32 * 136 + 16 * s + 8 * hi); const bf16x8 bb = *(const bf16x8*)(w2T + (size_t)(32 * w + r32) * 128 + 16 * s + 8 * hi); o = mfma32(a, bb, o); }
#pragma unroll
        for (int r = 0; r < 16; ++r) { const int id2 = 32 * rg + crow(r, hi); if (id2 < 4080) { const int bg2 = id2 / 255, n2 = id2 % 255; dst[((size_t)bg2 * 256 + n2) * 64 + 32 * w + r32] = (bf16)f2bf(o[r]); } }
    }
    __syncthreads();
}

constexpr size_t WS_PB = WS_END, WS_DEC = WS_END + 32 * MiB, WS_NEED = WS_END + 34 * MiB;
template <int DK, bool HG>
__device__ __forceinline__ void scan_prep(const Params& p, int layer, int b, int h, int c, char* lds) {
    constexpr int PARTS = 512 / DK, TP = 64 / PARTS, QS = DK + 8;
    const int tid = fresh_tid(), lane = tid & 63, w = __builtin_amdgcn_readfirstlane(tid >> 6), r32 = lane & 31, hi = lane >> 5;
    bf16* qe = (bf16*)lds; bf16* ke = qe + 64 * QS; bf16* keT = ke + 64 * QS; bf16* P = keT + DK * 72; float* tot = (float*)(P + 64 * 72);
    bf16* Z = (bf16*)(p.ws + WS_Z);
    const int d = tid % DK, part = tid / DK;
    bf16 *qsrc, *ksrc; const bf16* glr = Z + 6 * (SLAB / 2) + 256;
    float lb = 0.f, bias = 0.f, w2c[16];
    if (HG) {
        qsrc = Z + 0 * (SLAB / 2) + h * 128; ksrc = Z + 1 * (SLAB / 2) + h * 128;
        if (layer == 1) { const float l0 = p.in[3][h * 128 + d], l1 = p.in[3][512 + h * 128 + d]; lb = 1.f / (1.f + __expf(l0 - l1)); }
#pragma unroll
        for (int j = 0; j < 16; ++j) w2c[j] = 0.f;
    } else {
        qsrc = Z + 3 * (SLAB / 2) + h * 64; ksrc = Z + 3 * (SLAB / 2) + 256 + h * 64;
        bias = p.in[6][layer * 256 + h * 64 + d];
#pragma unroll
        for (int j = 0; j < 16; ++j) w2c[j] = p.in[5][(size_t)layer * 16 * 256 + j * 256 + h * 64 + d];
    }
    const size_t m0 = (size_t)b * T + 64 * c;
    float gl[TP], qv[TP], kv[TP]; float run = 0.f;
#pragma unroll
    for (int ii = 0; ii < TP; ++ii) {
        const size_t row = m0 + part * TP + ii;
        const float xq = bf2f(qsrc[row * 512 + d]), xk = bf2f(ksrc[row * 512 + d]);
        float g;
        if (HG) { const float ex = __expf(-xk); const float sg = 1.f / (1.f + ex); const float f = lb + (1.f - lb) * sg; g = __logf(f); kv[ii] = (1.f - lb) * ex * sg; qv[ii] = siluf_(xq); }
        else { float u = bias; const u32x4 g0 = *(const u32x4*)(glr + row * 512), g1 = *(const u32x4*)(glr + row * 512 + 8);
#pragma unroll
            for (int e = 0; e < 4; ++e) { u += lo16(g0[e]) * w2c[2 * e] + hi16(g0[e]) * w2c[2 * e + 1]; u += lo16(g1[e]) * w2c[8 + 2 * e] + hi16(g1[e]) * w2c[8 + 2 * e + 1]; }
            g = (fminf(u, 0.f) - __logf(1.f + __expf(-fabsf(u)))) * (1.f / 16.f); kv[ii] = xk; qv[ii] = xq * 0.125f; }
        run += g; gl[ii] = run;
    }
    tot[part * DK + d] = run;
    __syncthreads();
    float off = 0.f, total = 0.f;
#pragma unroll
    for (int pp = 0; pp < PARTS; ++pp) { const float tv = tot[pp * DK + d]; total += tv; if (pp < part) off += tv; }
    if (part == 0) ((float*)(p.ws + WS_DEC + (HG ? 0 : MiB)))[(size_t)((b * 4 + h) * 64 + c) * DK + d] = __expf(total);
#pragma unroll
    for (int ii = 0; ii < TP; ++ii) {
        const int i = part * TP + ii; const float bb = off + gl[ii];
        const float eq = __expf(fminf(bb - total, 80.f)), ek = __expf(total - bb);
        const bf16 qb16 = (bf16)f2bf(qv[ii] * eq), kb16 = (bf16)f2bf(kv[ii] * ek);
        qe[i * QS + d] = qb16; ke[i * QS + d] = kb16; keT[d * 72 + i] = kb16;
    }
    __syncthreads();
    if (w >= 4 && w < 7) {
        const int ti = w == 4 ? 0 : 1, si = w == 6 ? 1 : 0;
        f32x16 sc = (f32x16){};
#pragma unroll
        for (int ks = 0; ks < DK / 16; ++ks) { const bf16x8 a = *(const bf16x8*)(qe + (32 * ti + r32) * QS + 16 * ks + 8 * hi); const bf16x8 bb = *(const bf16x8*)(ke + (32 * si + r32) * QS + 16 * ks + 8 * hi); sc = mfma32(a, bb, sc); }
#pragma unroll
        for (int r = 0; r < 16; ++r) { const int tt = 32 * ti + crow(r, hi), ss = 32 * si + r32; P[tt * 72 + ss] = (ss <= tt) ? (bf16)f2bf(sc[r]) : (bf16)0; }
    } else if (w == 7) {
#pragma unroll
        for (int r = 0; r < 16; ++r) P[crow(r, hi) * 72 + 32 + r32] = (bf16)0;
    } else {
        const int t4 = tid;
        for (int q = t4; q < 64 * (DK / 8); q += 256) { const int row = q / (DK / 8), ch = q % (DK / 8); *(u32x4*)(qsrc + (m0 + row) * 512 + 8 * ch) = *(const u32x4*)(qe + row * QS + 8 * ch); }
        for (int q = t4; q < DK * 8; q += 256) { const int dd = q >> 3, ch = q & 7;
            bf16* dst = HG ? ksrc + (m0 + (dd >> 1)) * 512 + (dd & 1) * 64 + 8 * ch : ksrc + (m0 + dd) * 512 + 8 * ch;
            *(u32x4*)dst = *(const u32x4*)(keT + dd * 72 + 8 * ch); }
    }
    __syncthreads();
    { bf16* PB = (bf16*)(p.ws + WS_PB) + (HG ? 0 : (size_t)M * 256); const int t = tid >> 3, ch = tid & 7; *(u32x4*)(PB + (m0 + t) * 256 + h * 64 + 8 * ch) = *(const u32x4*)(P + t * 72 + 8 * ch); }
    __syncthreads();
}

template <int DK, bool HG>
__device__ __forceinline__ void scan_unit(const Params& p, int layer, int b, int h, int slice, char* lds, size_t dst_off) {
    constexpr int QS = DK + 8, NTS = DK / 32, NQ = (64 * DK / 8) / 512;
    constexpr int BUF = 64 * QS * 2 + DK * 72 * 2 + 64 * 72 * 2 + 32 * 72 * 2 + DK * 4;
    const int tid = fresh_tid(), lane = tid & 63, w = __builtin_amdgcn_readfirstlane(tid >> 6), r32 = lane & 31, hi = lane >> 5;
    bf16* ST = (bf16*)(lds + 2 * BUF);
    bf16* Z = (bf16*)(p.ws + WS_Z);
    const bf16* qsrc = HG ? Z + 0 * (SLAB / 2) + h * 128 : Z + 3 * (SLAB / 2) + h * 64;
    const bf16* ksrc = HG ? Z + 1 * (SLAB / 2) + h * 128 : Z + 3 * (SLAB / 2) + 256 + h * 64;
    bf16* vsrc = HG ? Z + 7 * (SLAB / 2) + h * 128 + 32 * slice : Z + 8 * (SLAB / 2) + h * 128 + 32 * slice;
    const bf16* PB = (const bf16*)(p.ws + WS_PB) + (HG ? 0 : (size_t)M * 256) + h * 64;
    const float* decg = (const float*)(p.ws + WS_DEC + (HG ? 0 : MiB)) + (size_t)((b * 4 + h) * 64) * DK;
    u32x4 rq[NQ], rk[NQ], rp; u32x2 rv; float rd = 0.f;
    auto gload = [&](int c) {
        const size_t m0 = (size_t)b * T + 64 * c;
#pragma unroll
        for (int k = 0; k < NQ; ++k) { const int q = tid + 512 * k; const int row = q / (DK / 8), ch = q % (DK / 8); rq[k] = *(const u32x4*)(qsrc + (m0 + row) * 512 + 8 * ch);
            const int dd = q >> 3, c8 = q & 7; rk[k] = *(const u32x4*)(HG ? ksrc + (m0 + (dd >> 1)) * 512 + (dd & 1) * 64 + 8 * c8 : ksrc + (m0 + dd) * 512 + 8 * c8); }
        rp = *(const u32x4*)(PB + (m0 + (tid >> 3)) * 256 + 8 * (tid & 7));
        rv = *(const u32x2*)(vsrc + (m0 + (tid >> 3)) * 512 + (tid & 7) * 4);
        if (tid < DK) rd = decg[c * DK + tid];
    };
    auto stage = [&](int x) {
        bf16* qe = (bf16*)(lds + x * BUF); bf16* keT = qe + 64 * QS; bf16* P = keT + DK * 72; bf16* VT = P + 64 * 72; float* dec = (float*)(VT + 32 * 72);
#pragma unroll
        for (int k = 0; k < NQ; ++k) { const int q = tid + 512 * k; const int row = q / (DK / 8), ch = q % (DK / 8); *(u32x4*)(qe + row * QS + 8 * ch) = rq[k]; *(u32x4*)(keT + (q >> 3) * 72 + 8 * (q & 7)) = rk[k]; }
        *(u32x4*)(P + (tid >> 3) * 72 + 8 * (tid & 7)) = rp;
        { const int s = tid >> 3, v4 = (tid & 7) * 4; VT[(v4 + 0) * 72 + s] = (bf16)(rv.x & 0xffffu); VT[(v4 + 1) * 72 + s] = (bf16)(rv.x >> 16); VT[(v4 + 2) * 72 + s] = (bf16)(rv.y & 0xffffu); VT[(v4 + 3) * 72 + s] = (bf16)(rv.y >> 16); }
        if (tid < DK) dec[tid] = rd;
    };
    f32x16 S = (f32x16){};
    gload(0); stage(0); gload(1);
    __syncthreads();
    for (int c = 0; c < T / 64; ++c) {
        const int x = c & 1; const size_t m0 = (size_t)b * T + 64 * c;
        const bf16* qe = (const bf16*)(lds + x * BUF); const bf16* keT = qe + 64 * QS; const bf16* P = keT + DK * 72; const bf16* VT = P + 64 * 72; const float* dec = (const float*)(VT + 32 * 72);
        if (c + 1 < T / 64) { stage(x ^ 1); if (c + 2 < T / 64) gload(c + 2); }
        f32x16 o = (f32x16){};
        if (w < NTS) {
            const float dc = dec[32 * w + r32];
#pragma unroll
            for (int r = 0; r < 16; ++r) { S[r] *= dc; ST[crow(r, hi) * QS + 32 * w + r32] = (bf16)f2bf(S[r]); }
#pragma unroll
            for (int ks = 0; ks < 4; ++ks) { const bf16x8 a = *(const bf16x8*)(VT + r32 * 72 + 16 * ks + 8 * hi); const bf16x8 bb = *(const bf16x8*)(keT + (32 * w + r32) * 72 + 16 * ks + 8 * hi); S = mfma32(a, bb, S); }
        } else if (w < 6) {
#pragma unroll
            for (int ks = 0; ks < 4; ++ks) { const bf16x8 a = *(const bf16x8*)(P + (32 * (w - 4) + r32) * 72 + 16 * ks + 8 * hi); const bf16x8 bb = *(const bf16x8*)(VT + r32 * 72 + 16 * ks + 8 * hi); o = mfma32(a, bb, o); }
        }
        __syncthreads();
        if (w >= 4 && w < 6) {
#pragma unroll
            for (int ks = 0; ks < DK / 16; ++ks) { const bf16x8 a = *(const bf16x8*)(qe + (32 * (w - 4) + r32) * QS + 16 * ks + 8 * hi); const bf16x8 bb = *(const bf16x8*)(ST + r32 * QS + 16 * ks + 8 * hi); o = mfma32(a, bb, o); }
#pragma unroll
            for (int r = 0; r < 16; ++r) vsrc[dst_off + (m0 + 32 * (w - 4) + crow(r, hi)) * 512 + r32] = (bf16)f2bf(o[r]);
        }
        __syncthreads();
    }
}

__device__ __forceinline__ void finish_pass(const Params& p, int layer, int gw, int NGW, int lane) {
    bf16* Z = (bf16*)(p.ws + WS_Z);
    for (int it = gw; it < 2 * M; it += NGW) {
        const int mix = it & 1, m = it >> 1;
        bf16* o = Z + (mix ? 8 : 7) * (SLAB / 2) + (size_t)m * 512 + 8 * lane; const bf16* og = Z + (mix ? 4 : 2) * (SLAB / 2) + (size_t)m * 512 + 8 * lane;
        const float* g = p.in[mix ? 7 : 4] + layer * 512 + 8 * lane;
        const u32x4 wo = *(const u32x4*)o, wg = *(const u32x4*)og; float v[8], gt[8]; float s = 0.f;
#pragma unroll
        for (int e = 0; e < 4; ++e) { v[2 * e] = lo16(wo[e]); v[2 * e + 1] = hi16(wo[e]); gt[2 * e] = lo16(wg[e]); gt[2 * e + 1] = hi16(wg[e]); }
#pragma unroll
        for (int e = 0; e < 8; ++e) s += v[e] * v[e];
        s += __shfl_xor(s, 1); s += __shfl_xor(s, 2); s += __shfl_xor(s, 4); s += __shfl_xor(s, 8);
        const float r = rsqrtf(s * (1.f / 128.f) + 1e-6f);
        const f32x4 g0 = *(const f32x4*)g, g1 = *(const f32x4*)(g + 4); const float gg[8] = {g0.x, g0.y, g0.z, g0.w, g1.x, g1.y, g1.z, g1.w};
        float y[8];
#pragma unroll
        for (int e = 0; e < 8; ++e) y[e] = v[e] * r * gg[e] * siluf_(gt[e]);
        u32x4 w; w.x = pk2(y[0], y[1]); w.y = pk2(y[2], y[3]); w.z = pk2(y[4], y[5]); w.w = pk2(y[6], y[7]); *(u32x4*)o = w;
    }
}

__device__ __forceinline__ void qk_tile(const bf16* Kt, const bf16x8* qr, f32x16& p0, f32x16& p1, int r32, int hi) {
    p0 = (f32x16){}; p1 = (f32x16){};
#pragma unroll
    for (int s = 0; s < 4; ++s) { const bf16x8 a0 = *(const bf16x8*)(Kt + r32 * 72 + 16 * s + 8 * hi), a1 = *(const bf16x8*)(Kt + (32 + r32) * 72 + 16 * s + 8 * hi); p0 = mfma32(a0, qr[s], p0); p1 = mfma32(a1, qr[s], p1); }
}
__device__ __forceinline__ unsigned cvtpk(float lo, float hi) { typedef float f2_t __attribute__((ext_vector_type(2))); typedef __bf16 b2_t __attribute__((ext_vector_type(2))); f2_t v = {lo, hi}; b2_t r = __builtin_convertvector(v, b2_t); return __builtin_bit_cast(unsigned, r); }
__device__ __forceinline__ void pv_tile(const bf16* Vt, const f32x16& p0, const f32x16& p1, f32x16* o, int r32, int hi) {
#pragma unroll
    for (int s = 0; s < 4; ++s) {
        u32x4 pw;
#pragma unroll
        for (int i = 0; i < 4; ++i) { const float a = (s < 2) ? p0[8 * (s & 1) + 2 * i] : p1[8 * (s & 1) + 2 * i], bq = (s < 2) ? p0[8 * (s & 1) + 2 * i + 1] : p1[8 * (s & 1) + 2 * i + 1]; pw[i] = cvtpk(a, bq); }
        const bf16x8 pb = __builtin_bit_cast(bf16x8, pw);
#pragma unroll
        for (int db = 0; db < 2; ++db) { const bf16* vp = Vt + (32 * db + r32) * 72 + 16 * s + 4 * hi; const u32x2 lo = *(const u32x2*)vp, hi8 = *(const u32x2*)(vp + 8);
            u32x4 aw; aw.x = lo.x; aw.y = lo.y; aw.z = hi8.x; aw.w = hi8.y; o[db] = mfma32(__builtin_bit_cast(bf16x8, aw), pb, o[db]); }
    }
}
struct TileRegs { u32x4 k; u32x2 va, vb; };
template <bool WITHV> __device__ __forceinline__ void tile_load(TileRegs& R, const bf16* Kb, const bf16* Vb, int pitch, int j, int tid) {
    R.k = *(const u32x4*)(Kb + (size_t)(64 * j + (tid >> 3)) * pitch + 8 * (tid & 7));
    if (WITHV) { const int pair = tid & 31, dq = tid >> 5; const bf16* vp = Vb + (size_t)(64 * j + 2 * pair) * pitch + 4 * dq; R.va = *(const u32x2*)vp; R.vb = *(const u32x2*)(vp + pitch); }
}
template <bool WITHV> __device__ __forceinline__ void tile_stage(const TileRegs& R, bf16* Kt, bf16* Vt, int tid) {
    *(u32x4*)(Kt + (tid >> 3) * 72 + 8 * (tid & 7)) = R.k;
    if (WITHV) { const int pair = tid & 31, dq = tid >> 5; unsigned* v32 = (unsigned*)Vt + (4 * dq) * 36 + pair;
        v32[0] = (R.va.x & 0xffffu) | (R.vb.x << 16); v32[36] = (R.va.x >> 16) | (R.vb.x & 0xffff0000u); v32[72] = (R.va.y & 0xffffu) | (R.vb.y << 16); v32[108] = (R.va.y >> 16) | (R.vb.y & 0xffff0000u); }
}
template <int MODE>
__device__ __forceinline__ void run_tiles(const bf16* Kb, const bf16* Vb, int pitch, int j0, int j1, bf16* Kt, bf16* Vt, const bf16x8* qr, int t,
                                          float& m, float& l, f32x16* o, float mc, float invlc, float* impme, int tid, int r32, int hi) {
    TileRegs R; tile_load<MODE != 0>(R, Kb, Vb, pitch, j0, tid);
    for (int j = j0; j <= j1; ++j) {
        __syncthreads();
        tile_stage<MODE != 0>(R, Kt, Vt, tid);
        if (j < j1) tile_load<MODE != 0>(R, Kb, Vb, pitch, j + 1, tid);
        __syncthreads();
        f32x16 p0, p1; qk_tile(Kt, qr, p0, p1, r32, hi);
        const float NEG = -INFINITY;
#pragma unroll
        for (int r = 0; r < 16; ++r) { const int k0 = 64 * j + crow(r, hi), k1 = k0 + 32; p0[r] = (16 * k0 + 31 <= t) ? p0[r] : NEG; p1[r] = (16 * k1 + 31 <= t) ? p1[r] : NEG; }
        if (MODE == 1) {
#pragma unroll
            for (int r = 0; r < 16; ++r) { p0[r] = __builtin_amdgcn_exp2f(p0[r] - mc) * invlc; p1[r] = __builtin_amdgcn_exp2f(p1[r] - mc) * invlc; }
#pragma unroll
            for (int half = 0; half < 2; ++half)
#pragma unroll
                for (int g4 = 0; g4 < 4; ++g4) {
                    const float c3 = half ? p1[4 * g4 + 3] : p0[4 * g4 + 3];
                    const float a = half ? (p1[4 * g4] + p1[4 * g4 + 1]) + (p1[4 * g4 + 2] + c3) : (p0[4 * g4] + p0[4 * g4 + 1]) + (p0[4 * g4 + 2] + c3);
                    const float cp = __shfl_xor(c3, 32); const int jj = 16 * j + 8 * half + 2 * g4 + hi;
                    if (hi) impme[jj] += a + cp; else { impme[jj] += a; impme[jj + 2] += cp; }
                }
            pv_tile(Vt, p0, p1, o, r32, hi);
        } else {
            float mx = p0[0];
#pragma unroll
            for (int r = 0; r < 16; ++r) { mx = fmaxf(mx, p0[r]); mx = fmaxf(mx, p1[r]); }
            mx = fmaxf(mx, __shfl_xor(mx, 32));
            const float mn = fmaxf(m, mx), alpha = __builtin_amdgcn_exp2f(m - mn); m = mn;
            float ls = 0.f;
#pragma unroll
            for (int r = 0; r < 16; ++r) { ls += __builtin_amdgcn_exp2f(p0[r] - mn) + __builtin_amdgcn_exp2f(p1[r] - mn); }
            l = l * alpha + ls;
        }
    }
}
template <int MODE>
__device__ __forceinline__ void run_tiles_fast(const bf16* Kb, const bf16* Vb, int pitch, int j0, int j1, int qb, bf16* Kt, bf16* Vt, const bf16x8* qr, int t, unsigned long long sel,
                                               float& mref, float& l, f32x16* o, int tid, int r32, int hi) {
    TileRegs R; tile_load<true>(R, Kb, Vb, pitch, j0, tid);
    const float NEG = -INFINITY;
    mref = 0.f;
    for (int j = j0; j <= j1; ++j) {
        __syncthreads();
        tile_stage<true>(R, Kt, Vt, tid);
        if (j < j1) tile_load<true>(R, Kb, Vb, pitch, j + 1, tid);
        __syncthreads();
        const float init = ((MODE == 2 && !((sel >> j) & 1ull)) ? NEG : 0.f) - mref;
        f32x16 p0, p1;
#pragma unroll
        for (int r = 0; r < 16; ++r) { p0[r] = init; p1[r] = init; }
#pragma unroll
        for (int s = 0; s < 4; ++s) { const bf16x8 a0 = *(const bf16x8*)(Kt + r32 * 72 + 16 * s + 8 * hi), a1 = *(const bf16x8*)(Kt + (32 + r32) * 72 + 16 * s + 8 * hi); p0 = mfma32(a0, qr[s], p0); p1 = mfma32(a1, qr[s], p1); }
        if (j == qb || (MODE == 3 && j == qb - 8)) {
#pragma unroll
            for (int r = 0; r < 16; ++r) { const int k0 = 64 * j + crow(r, hi), k1 = k0 + 32;
                const bool ok0 = k0 <= t && (MODE == 2 || k0 > t - 512), ok1 = k1 <= t && (MODE == 2 || k1 > t - 512);
                p0[r] = ok0 ? p0[r] : NEG; p1[r] = ok1 ? p1[r] : NEG; }
        }
        float mx = fmaxf(p0[0], p1[0]);
#pragma unroll
        for (int r = 1; r < 16; ++r) mx = fmaxf(fmaxf(mx, p0[r]), p1[r]);
        mx = fmaxf(mx, __shfl_xor(mx, 32));
        if (j == j0) { const float mr = (mx == NEG) ? 0.f : mx; mref = mr;
#pragma unroll
            for (int r = 0; r < 16; ++r) { p0[r] -= mr; p1[r] -= mr; } }
        else if (__any(mx > 8.f)) { const float dl = fmaxf(mx, 0.f), f = __builtin_amdgcn_exp2f(-dl); mref += dl; l *= f; o[0] *= f; o[1] *= f;
#pragma unroll
            for (int r = 0; r < 16; ++r) { p0[r] -= dl; p1[r] -= dl; } }
        float ls = 0.f;
#pragma unroll
        for (int r = 0; r < 16; ++r) { p0[r] = __builtin_amdgcn_exp2f(p0[r]); p1[r] = __builtin_amdgcn_exp2f(p1[r]); ls += p0[r] + p1[r]; }
        l += ls;
        pv_tile(Vt, p0, p1, o, r32, hi);
    }
}

__device__ __forceinline__ void nsa_unit(const Params& p, int bg, int qb, char* lds, size_t dst_off) {
    const int tid = fresh_tid(), lane = tid & 63, w = __builtin_amdgcn_readfirstlane(tid >> 6), r32 = lane & 31, hi = lane >> 5;
    const int b = bg >> 1, g = bg & 1;
    bf16* Kt = (bf16*)lds; bf16* Vt = Kt + 64 * 72; float* impw = (float*)(Vt + 64 * 72); unsigned long long* selm = (unsigned long long*)(impw + 8 * 32 * 65);
    bf16* Z = (bf16*)(p.ws + WS_Z);
    bf16* s5 = Z + 5 * (SLAB / 2); bf16* s6 = Z + 6 * (SLAB / 2); bf16* s9 = Z + 9 * (SLAB / 2);
    const bf16* KC = (const bf16*)(p.ws + WS_KC) + (size_t)bg * 256 * 64; const bf16* VC = (const bf16*)(p.ws + WS_VC) + (size_t)bg * 256 * 64;
    const size_t rowb = (size_t)b * T;
    const int hh = g * 4 + (w >> 1), tokl = 32 * (w & 1) + r32, t = 64 * qb + tokl; const size_t mrow = rowb + t;
    bf16x8 qr[4];
#pragma unroll
    for (int s = 0; s < 4; ++s) qr[s] = *(const bf16x8*)(s9 + mrow * 512 + hh * 64 + 16 * s + 8 * hi);
    for (int e = tid; e < 8 * 32 * 65; e += 512) impw[e] = 0.f;
    const bf16* gp = s6 + mrow * 512 + 272 + hh * 3;
    const float gc = sigmoidf_(bf2f(gp[0])), gs = sigmoidf_(bf2f(gp[1])), gwn = sigmoidf_(bf2f(gp[2]));
    f32x16 oacc[2]; oacc[0] = (f32x16){}; oacc[1] = (f32x16){};
    f32x16 o[2];
    float* impme = impw + (w * 32 + r32) * 65;
    const int ntc = (qb >> 4) + 1;
    float mc = -1e30f, lc = 0.f;
    run_tiles<0>(KC, VC, 64, 0, ntc - 1, Kt, Vt, qr, t, mc, lc, o, 0.f, 0.f, impme, tid, r32, hi);
    lc += __shfl_xor(lc, 32);
    const float invlc = lc > 0.f ? 1.f / lc : 0.f;
    o[0] = (f32x16){}; o[1] = (f32x16){};
    { float dm = 0.f, dl = 0.f; run_tiles<1>(KC, VC, 64, 0, ntc - 1, Kt, Vt, qr, t, dm, dl, o, mc, invlc, impme, tid, r32, hi); }
    oacc[0] += o[0] * gc; oacc[1] += o[1] * gc;
    __syncthreads();
    for (int tk = w; tk < 64; tk += 8) {
        float v = 0.f;
#pragma unroll
        for (int r = 0; r < 4; ++r) v += impw[((2 * r + (tk >> 5)) * 32 + (tk & 31)) * 65 + lane];
        const int cur = qb; const bool valid = lane <= cur, forced = lane == 0 || lane == cur || lane == cur - 1;
        const float sc = valid ? (forced ? 1e9f : v) : -1e9f;
        int rank = 0;
#pragma unroll 4
        for (int i = 0; i < 64; ++i) { const float si = __shfl(sc, i); rank += (si > sc || (si == sc && i < lane)) ? 1 : 0; }
        const unsigned long long mk = __ballot(rank < 16 && sc > -1e8f);
        if (lane == 0) selm[tk] = mk;
    }
    __syncthreads();
    const unsigned long long sel = selm[tokl];
    {
        float ms = -1e30f, ls = 0.f; o[0] = (f32x16){}; o[1] = (f32x16){};
        run_tiles_fast<2>(s5 + rowb * 512 + 256 + g * 64, s5 + rowb * 512 + 384 + g * 64, 512, 0, qb, qb, Kt, Vt, qr, t, sel, ms, ls, o, tid, r32, hi);
        ls += __shfl_xor(ls, 32); const float sc = gs / ls; oacc[0] += o[0] * sc; oacc[1] += o[1] * sc;
    }
    {
        float ms = -1e30f, ls = 0.f; o[0] = (f32x16){}; o[1] = (f32x16){};
        run_tiles_fast<3>(s6 + rowb * 512 + g * 64, s6 + rowb * 512 + 128 + g * 64, 512, qb > 8 ? qb - 8 : 0, qb, qb, Kt, Vt, qr, t, 0ull, ms, ls, o, tid, r32, hi);
        ls += __shfl_xor(ls, 32); const float sc = gwn / ls; oacc[0] += o[0] * sc; oacc[1] += o[1] * sc;
    }
#pragma unroll
    for (int db = 0; db < 2; ++db)
#pragma unroll
        for (int rg = 0; rg < 4; ++rg) { u32x2 wv; wv.x = pk2(oacc[db][4 * rg], oacc[db][4 * rg + 1]); wv.y = pk2(oacc[db][4 * rg + 2], oacc[db][4 * rg + 3]);
            *(u32x2*)(s9 + dst_off + mrow * 512 + hh * 64 + 32 * db + 8 * rg + 4 * hi) = wv; }
    __syncthreads();
}
}

namespace pg8 {
template <int ACT  > struct EpiStore {
    static constexpr bool PERM = true, AFTER_DRAIN = false;
    bf16_t* O; int ldc; int split_cols; size_t split_stride;
    __device__ __forceinline__ void operator()(const f32x4 (&acc)[2][2][4][2], const Unit& u, int wr, int wc, int fr, int fq) const {
        const int row0 = u.pm * BM + wr * 64 + fr; int colt = u.pn * BM; bf16_t* base = O;
        { const int t = colt / split_cols; base += (size_t)t * split_stride; colt -= t * split_cols; }
        const int col0 = colt + wc * 32 + 8 * fq;
#pragma unroll
        for (int ai = 0; ai < 2; ++ai)
#pragma unroll
            for (int m = 0; m < 4; ++m) { bf16_t* rowp = base + (size_t)(row0 + ai * HALF + m * 16) * ldc + col0;
#pragma unroll
                for (int bj = 0; bj < 2; ++bj) { f32x4 v0 = acc[ai][bj][m][0], v1 = acc[ai][bj][m][1];
                    if (ACT == 2) {
#pragma unroll
                        for (int e = 0; e < 4; ++e) { v0[e] = 1.f / (1.f + __expf(-v0[e])); v1[e] = 1.f / (1.f + __expf(-v1[e])); } }
                    u32x4 w; w.x = cvt_pk_bf16(v0[0], v0[1]); w.y = cvt_pk_bf16(v0[2], v0[3]); w.z = cvt_pk_bf16(v1[0], v1[1]); w.w = cvt_pk_bf16(v1[2], v1[3]);
                    *(u32x4*)(rowp + bj * HALF) = w; } }
    }
};
__device__ __forceinline__ float bflo(unsigned w) { return __uint_as_float(w << 16); }
__device__ __forceinline__ float bfhi(unsigned w) { return __uint_as_float(w & 0xffff0000u); }
template <bool FIRST> struct EpiBranch {
    static constexpr bool PERM = true, AFTER_DRAIN = false;
    bf16_t* Mo; const bf16_t* G;
    __device__ __forceinline__ void operator()(const f32x4 (&acc)[2][2][4][2], const Unit& u, int wr, int wc, int fr, int fq) const {
        const int row0 = u.pm * BM + wr * 64 + fr, col0 = u.pn * BM + wc * 32 + 8 * fq;
#pragma unroll
        for (int ai = 0; ai < 2; ++ai)
#pragma unroll
            for (int m = 0; m < 4; ++m) { const size_t off = (size_t)(row0 + ai * HALF + m * 16) * 1024 + col0;
#pragma unroll
                for (int bj = 0; bj < 2; ++bj) { const f32x4 v0 = acc[ai][bj][m][0], v1 = acc[ai][bj][m][1];
                    const u32x4 g = *(const u32x4*)(G + off + bj * HALF);
                    float r[8] = {bflo(g.x) * v0[0], bfhi(g.x) * v0[1], bflo(g.y) * v0[2], bfhi(g.y) * v0[3], bflo(g.z) * v1[0], bfhi(g.z) * v1[1], bflo(g.w) * v1[2], bfhi(g.w) * v1[3]};
                    if (!FIRST) { const u32x4 o = *(const u32x4*)(Mo + off + bj * HALF);
                        r[0] += bflo(o.x); r[1] += bfhi(o.x); r[2] += bflo(o.y); r[3] += bfhi(o.y); r[4] += bflo(o.z); r[5] += bfhi(o.z); r[6] += bflo(o.w); r[7] += bfhi(o.w); }
                    u32x4 w; w.x = cvt_pk_bf16(r[0], r[1]); w.y = cvt_pk_bf16(r[2], r[3]); w.z = cvt_pk_bf16(r[4], r[5]); w.w = cvt_pk_bf16(r[6], r[7]);
                    *(u32x4*)(Mo + off + bj * HALF) = w; } }
    }
};
struct EpiResid {
    static constexpr bool PERM = false, AFTER_DRAIN = false;
    const float* base; float* out;
    __device__ __forceinline__ void operator()(const f32x4 (&acc)[2][2][4][2], const Unit& u, int wr, int wc, int fr, int fq) const {
        const int row0 = u.pm * BM + wr * 64 + fr, col0 = u.pn * BM + wc * 32 + 4 * fq;
#pragma unroll
        for (int ai = 0; ai < 2; ++ai)
#pragma unroll
            for (int m = 0; m < 4; ++m) { const size_t off = (size_t)(row0 + ai * HALF + m * 16) * 1024 + col0;
#pragma unroll
                for (int bj = 0; bj < 2; ++bj)
#pragma unroll
                    for (int n = 0; n < 2; ++n) { const f32x4 bs = *(const f32x4*)(base + off + bj * HALF + n * 16); *(f32x4*)(out + off + bj * HALF + n * 16) = bs + acc[ai][bj][m][n]; } }
    }
};
struct EpiSwiGLU {
    static constexpr bool PERM = true, AFTER_DRAIN = false;
    bf16_t* Hd;
    __device__ __forceinline__ void operator()(const f32x4 (&acc)[2][2][4][2], const Unit& u, int wr, int wc, int fr, int fq) const {
        const int row0 = u.pm * BM + wr * 64 + fr, col0 = u.pn * 128 + wc * 32 + 8 * fq;
#pragma unroll
        for (int ai = 0; ai < 2; ++ai)
#pragma unroll
            for (int m = 0; m < 4; ++m) { float r[8];
#pragma unroll
                for (int n = 0; n < 2; ++n)
#pragma unroll
                    for (int e = 0; e < 4; ++e) { const float gt = acc[ai][0][m][n][e], up = acc[ai][1][m][n][e]; r[4 * n + e] = gt / (1.f + __expf(-gt)) * up; }
                u32x4 w; w.x = cvt_pk_bf16(r[0], r[1]); w.y = cvt_pk_bf16(r[2], r[3]); w.z = cvt_pk_bf16(r[4], r[5]); w.w = cvt_pk_bf16(r[6], r[7]);
                *(u32x4*)(Hd + (size_t)(row0 + ai * HALF + m * 16) * 2816 + col0) = w; }
    }
};
}

#define LAS __attribute__((address_space(3)))
#define XB_TMO      128
#define XB_XCNT(j)  (256  + 64 * (j))
#define XB_XSUB(j)  (1280 + 64 * (j))
#define XB_XGEN(j)  (2304 + 64 * (j))
#define XB_TOP      3328
#define XB_TOPGEN   3392
#define XCD_BAR_WORDS 3456
#define XB_SPIN_CAP (1u << 18)

__device__ __forceinline__ unsigned xb_ld(unsigned* p)              { return __hip_atomic_load(p, __ATOMIC_RELAXED, __HIP_MEMORY_SCOPE_AGENT); }
__device__ __forceinline__ unsigned xb_add(unsigned* p, unsigned v) { return __hip_atomic_fetch_add(p, v, __ATOMIC_RELAXED, __HIP_MEMORY_SCOPE_AGENT); }
__device__ __forceinline__ unsigned xb_xcc_id() { return (unsigned)__builtin_amdgcn_s_getreg((3 << 11) | 20) & 0xFu; }
#define XB_SPIN(cond, bar) do { unsigned _sp = 0; while (cond) { __builtin_amdgcn_s_sleep(1); \
    if ((++_sp & 255u) == 0u) { if (xb_ld(&(bar)[XB_TMO])) break; if (_sp > XB_SPIN_CAP) { atomicAdd(&(bar)[XB_TMO], 1u); break; } } } } while (0)

struct XcdBarrier {
    unsigned* bar; unsigned x;
    volatile LAS unsigned* st;
};

__device__ __forceinline__ XcdBarrier xcd_barrier_post(unsigned* bar, volatile LAS unsigned* st) {
    XcdBarrier b; b.bar = bar; b.x = xb_xcc_id(); b.st = st;
    if (threadIdx.x == 0) (void)xb_add(&bar[XB_XCNT(b.x)], 1u);
    return b;
}
__device__ __forceinline__ void xcd_barrier_complete(unsigned* bar, unsigned x, unsigned& nloc, unsigned& nx) {
    const unsigned G = gridDim.x * gridDim.y * gridDim.z;
    unsigned sum, cnt, mine, sp = 0u;
    for (;;) {
        sum = 0u; cnt = 0u; mine = 0u;
#pragma unroll
        for (unsigned j = 0; j < 16; ++j) { const unsigned c = xb_ld(&bar[XB_XCNT(j)]); sum += c; cnt += (c > 0u) ? 1u : 0u; mine = (j == x) ? c : mine; }
        if (sum == G) break;
        __builtin_amdgcn_s_sleep(1);
        if ((++sp & 255u) == 0u) { if (xb_ld(&bar[XB_TMO])) break; if (sp > XB_SPIN_CAP) { atomicAdd(&bar[XB_TMO], 1u); break; } }
    }
    nloc = mine > 0u ? mine : 1u; nx = cnt > 0u ? cnt : 1u;
}

__device__ __forceinline__ void xcd_barrier(const XcdBarrier& b) {
    asm volatile("s_waitcnt vmcnt(0)" ::: "memory");
    __syncthreads();
    if (threadIdx.x == 0) {
        unsigned* bar = b.bar;
        __builtin_amdgcn_s_waitcnt(0);
        unsigned nloc = b.st[0], nx = b.st[1];
        if (nloc == 0u) { xcd_barrier_complete(bar, b.x, nloc, nx); b.st[0] = nloc; b.st[1] = nx; }
        const unsigned old = xb_add(&bar[XB_XSUB(b.x)], 1u);
        const unsigned gen = old / nloc;
        if (old + 1u == (gen + 1u) * nloc) {
            __builtin_amdgcn_fence(__ATOMIC_RELEASE, "agent");
            asm volatile("s_waitcnt vmcnt(0)" ::: "memory");
            const unsigned og = xb_add(&bar[XB_TOP], 1u);
            const unsigned tg = og / nx;
            if (og + 1u == (tg + 1u) * nx) xb_add(&bar[XB_TOPGEN], 1u);
            else XB_SPIN(xb_ld(&bar[XB_TOPGEN]) == tg, bar);
            __builtin_amdgcn_fence(__ATOMIC_ACQUIRE, "agent");
            xb_add(&bar[XB_XGEN(b.x)], 1u);
            asm volatile("s_waitcnt vmcnt(0)" ::: "memory");
        } else {
            XB_SPIN(xb_ld(&bar[XB_XGEN(b.x)]) == gen, bar);
            __builtin_amdgcn_fence(__ATOMIC_ACQUIRE, "agent");
            asm volatile("s_waitcnt vmcnt(0)" ::: "memory");
        }
    }
    __syncthreads();
}

#ifndef PROBE_SCAN
#define PROBE_SCAN 0
#endif
#ifndef PROBE_NSA
#define PROBE_NSA 0
#endif
#ifndef PROBE_GEMM
#define PROBE_GEMM 0
#endif
#ifndef PROBE_SYNC
#define PROBE_SYNC 0
#endif
#ifndef PROBE_EW
#define PROBE_EW 0
#endif
#ifndef MK_ONE_LAUNCH
#define MK_ONE_LAUNCH 1
#endif
constexpr int N_PHASES = 1 + 11 * 2;

using namespace mk;
__global__ void __launch_bounds__(512, 2) mk_fwd(Params p, int ph_lo, int ph_hi) {
    extern __shared__ __attribute__((aligned(16))) unsigned char lds_raw[];
    char* lds = (char*)lds_raw;
    PG8_LAS unsigned char* lds3 = (PG8_LAS unsigned char*)lds_raw;
    const int G = gridDim.x, NGW = G * 8;
#define FRESH() const int tid = fresh_tid(), lane = tid & 63, wave = __builtin_amdgcn_readfirstlane(tid >> 6), bid = fresh_bid(), gw = bid * 8 + wave; (void)lane; (void)gw; (void)bid
    unsigned char* ws = p.ws;
    bf16* H = (bf16*)(ws + WS_H); bf16* Z = (bf16*)(ws + WS_Z);
    int ph = 0;
#if MK_ONE_LAUNCH
    cg::grid_group grid = cg::this_grid();
    { volatile LAS unsigned* st0 = (volatile LAS unsigned*)(lds3 + LDS_BYTES - 64); if (threadIdx.x < 2) st0[threadIdx.x] = 0u; __syncthreads(); }
    XcdBarrier xbar = xcd_barrier_post((unsigned*)ws, (volatile LAS unsigned*)(lds3 + LDS_BYTES - 64));
#define SEAM() do { if (ph == 0) grid.sync(); else xcd_barrier(xbar); for (int q_ = 0; q_ < PROBE_SYNC; ++q_) xcd_barrier(xbar); ++ph; } while (0)
#else
#define SEAM() do { ++ph; } while (0)
#endif
#define RUN (ph >= ph_lo && ph < ph_hi)
    if (RUN) { FRESH();
_Pragma("nounroll") for (int rep = 0; rep < 1 + PROBE_EW; ++rep) {
#ifndef NO_CONV
 convert_weights(p, lds, gw, NGW, wave, lane);
#endif
 rms_to_bf16(p.in[0], p.in[1], H, gw, NGW, lane); } }
    SEAM();
    for (int l = 0; l < DEPTH; ++l) {
        const unsigned char* wb = ws + WS_W + (size_t)l * W_LAYER;
        const float* xin = l == 0 ? p.in[0] : p.out;
        if (RUN) { FRESH(); pg8::Gemm g{H, (const bf16*)(wb + OW_IN), M, NZ, D}; pg8::StaticOrder S; S.init(M, NZ, G, bid);
            pg8::EpiStore<0> E{Z, 512, 512, (size_t)M * 512};
_Pragma("nounroll") for (int rep = 0; rep < 1 + PROBE_GEMM; ++rep)
#ifndef NO_G1
pg8::gemm_phase<pg8::EpiStore<0>, pg8::StaticOrder, true, true>(lds3, g, S, E);
#endif
 }
        SEAM();
        if (RUN) { FRESH();
#ifndef NO_CMP
 for (int task = bid; task < 256; task += G) compress_task(p, l, task, lds);
#endif
#ifndef NO_ROPE
 rope_pass(p, gw, NGW, lane);
#endif
#ifndef NO_SCAN
 __syncthreads();
 for (int u = bid; u < 4096; u += G) { const int cc = u & 63, hh = (u >> 6) & 3, bb = (u >> 8) & 7; if (u < 2048) scan_prep<128, true>(p, l, bb, hh, cc, lds); else scan_prep<64, false>(p, l, bb, hh, cc, lds); }
#endif
 }
        SEAM();
        if (RUN) { FRESH();
_Pragma("nounroll")          for (int rep = 0; rep < 1 + PROBE_SCAN; ++rep) { const size_t sc_off7 = 0, sc_off8 = 0;
#ifndef NO_SCAN
            for (int u = bid; u < 256; u += G) { const int bb = (u & 127) >> 4, hh = (u & 15) >> 2, sl = u & 3; if (u < 128) scan_unit<128, true>(p, l, bb, hh, sl, lds, sc_off7); else scan_unit<64, false>(p, l, bb, hh, sl, lds, sc_off8); }
#endif
          }
_Pragma("nounroll")          for (int rep = 0; rep < 1 + PROBE_NSA; ++rep) { const size_t ns_off = 0;
#ifndef NO_NSA
            for (int vc = bid; vc < 256; vc += G) { const int bg = vc >> 4, s = vc & 15;
                for (int i = 0; i < 4; ++i) { const int qb = i == 0 ? 63 - s : (i == 1 ? 32 + s : (i == 2 ? 31 - s : s)); nsa_unit(p, bg, qb, lds, ns_off); } }
#endif
          }
        }
        SEAM();
        if (RUN) { FRESH(); finish_pass(p, l, gw, NGW, lane); }
        SEAM();
        if (RUN) { FRESH(); pg8::Gemm g{H, (const bf16*)(wb + OW_G), M, 3072, D}; pg8::StaticOrder S; S.init(M, 3072, G, bid);
            pg8::EpiStore<2> E{Z, 1024, 1024, (size_t)M * 1024};
_Pragma("nounroll") for (int rep = 0; rep < 1 + PROBE_GEMM; ++rep)
#ifndef NO_G2
pg8::gemm_phase<pg8::EpiStore<2>, pg8::StaticOrder, true, true>(lds3, g, S, E);
#endif
 }
        SEAM();
        if (RUN) { FRESH();
            pg8::StaticOrder S; S.init(M, D, G, bid);
_Pragma("nounroll") for (int rep = 0; rep < 1 + PROBE_GEMM; ++rep) {
            { pg8::Gemm g{Z + 7 * (SLAB / 2), (const bf16*)(wb + OW_BR), M, D, 512}; pg8::EpiBranch<true> E{H, Z};
#ifndef NO_G3
pg8::gemm_phase<pg8::EpiBranch<true>, pg8::StaticOrder, true, true>(lds3, g, S, E);
#endif
 }
            asm volatile("s_waitcnt vmcnt(0)" ::: "memory"); __syncthreads();
            { pg8::Gemm g{Z + 8 * (SLAB / 2), (const bf16*)(wb + OW_BR) + (size_t)D * 512, M, D, 512}; pg8::EpiBranch<false> E{H, Z + (size_t)M * 1024};
#ifndef NO_G4
pg8::gemm_phase<pg8::EpiBranch<false>, pg8::StaticOrder, true, true>(lds3, g, S, E);
#endif
 }
            asm volatile("s_waitcnt vmcnt(0)" ::: "memory"); __syncthreads();
            { pg8::Gemm g{Z + 9 * (SLAB / 2), (const bf16*)(wb + OW_BR) + (size_t)2 * D * 512, M, D, 512}; pg8::EpiBranch<false> E{H, Z + (size_t)2 * M * 1024};
#ifndef NO_G5
pg8::gemm_phase<pg8::EpiBranch<false>, pg8::StaticOrder, true, true>(lds3, g, S, E);
#endif
 }
            if (rep < PROBE_GEMM) { asm volatile("s_waitcnt vmcnt(0)" ::: "memory"); __syncthreads(); } }
        }
        SEAM();
        if (RUN) { FRESH(); pg8::Gemm g{H, (const bf16*)(wb + OW_OUT), M, D, D}; pg8::StaticOrder S; S.init(M, D, G, bid);
            pg8::EpiResid E{xin, p.out};
#ifndef NO_G6
pg8::gemm_phase<pg8::EpiResid, pg8::StaticOrder, true, true>(lds3, g, S, E);
#endif
 }
        SEAM();
        if (RUN) { FRESH(); _Pragma("nounroll") for (int rep = 0; rep < 1 + PROBE_EW; ++rep) rms_to_bf16(p.out, p.in[18] + l * D, H, gw, NGW, lane); }
        SEAM();
        if (RUN) { FRESH(); pg8::Gemm g{H, (const bf16*)(wb + OW_GU), M, 2 * FF, D}; pg8::StaticOrder S; S.init(M, 2 * FF, G, bid);
            pg8::EpiSwiGLU E{Z};
_Pragma("nounroll") for (int rep = 0; rep < 1 + PROBE_GEMM; ++rep)
#ifndef NO_G7
pg8::gemm_phase<pg8::EpiSwiGLU, pg8::StaticOrder, true, true>(lds3, g, S, E);
#endif
 }
        SEAM();
        if (RUN) { FRESH(); pg8::Gemm g{Z, (const bf16*)(wb + OW_D), M, D, FF}; pg8::StaticOrder S; S.init(M, D, G, bid);
            pg8::EpiResid E{p.out, p.out};
#ifndef NO_G8
pg8::gemm_phase<pg8::EpiResid, pg8::StaticOrder, true, true>(lds3, g, S, E);
#endif
 }
        SEAM();
        if (RUN) { FRESH(); if (l + 1 < DEPTH) rms_to_bf16(p.out, p.in[1] + (l + 1) * D, H, gw, NGW, lane); else rms_final(p.out, p.in[22], gw, NGW, lane); }
        if (l + 1 < DEPTH) SEAM();
    }
}

extern "C" void kernel_launch(void* const* d_in, const int* in_sizes, int n_in, void* d_out, int out_size, void* d_ws, size_t ws_size, hipStream_t stream) {
    static int grid = 0;
    if (grid == 0) {
        if (n_in != 23 || in_sizes[0] != M * D || out_size != M * D || ws_size < WS_NEED) { fprintf(stderr, "kernel_launch: unexpected shapes (n_in %d, in0 %d, out %d, ws %zu)\n", n_in, n_in > 0 ? in_sizes[0] : -1, out_size, ws_size); grid = -1; return; }
        int dev = 0, cus = 0, per_cu = 0;
        hipGetDevice(&dev); hipDeviceGetAttribute(&cus, hipDeviceAttributeMultiprocessorCount, dev);
        hipFuncSetAttribute((const void*)mk_fwd, hipFuncAttributeMaxDynamicSharedMemorySize, LDS_BYTES);
        hipOccupancyMaxActiveBlocksPerMultiprocessor(&per_cu, (const void*)mk_fwd, 512, LDS_BYTES);
        (void)hipGetLastError();
        if (per_cu < 1) per_cu = 1;
        grid = cus;
    }
    if (grid < 0) return;
    Params p{};
    for (int i = 0; i < 23; ++i) p.in[i] = (const float*)d_in[i];
    p.out = (float*)d_out; p.ws = (unsigned char*)d_ws;
#if MK_ONE_LAUNCH
    int lo = 0, hi = 1000;
    void* args[] = {&p, &lo, &hi};
    if (hipMemsetAsync(d_ws, 0, 65536, stream) != hipSuccess) { fprintf(stderr, "memset failed\n"); return; }
    hipError_t e = hipLaunchCooperativeKernel((const void*)mk_fwd, dim3(grid), dim3(512), args, LDS_BYTES, stream);
    if (e != hipSuccess) fprintf(stderr, "cooperative launch failed: %s (grid %d)\n", hipGetErrorString(e), grid);
#else
    for (int ph = 0; ph < N_PHASES; ++ph) hipLaunchKernelGGL(mk_fwd, dim3(grid), dim3(512), LDS_BYTES, stream, p, ph, ph + 1);
#endif
}
```

```cpp
#include <hip/hip_runtime.h>
#include <hip/hip_cooperative_groups.h>
#include <cstdio>
#include <cstdint>
namespace cg = cooperative_groups;
namespace pg8 {
#define PG8_LAS __attribute__((address_space(3)))
typedef unsigned short bf16_t;
typedef short bf16x8 __attribute__((ext_vector_type(8)));
typedef float f32x4 __attribute__((ext_vector_type(4)));
typedef unsigned u32x4 __attribute__((ext_vector_type(4)));
constexpr int BM = 256, BK = 64, HALF = 128, HTB = HALF * BK * 2  , STAGE_BYTES = 8 * HTB, NXCD = 8, WGM = 8;

__host__ __device__ __forceinline__ int lds_byte(int r, int c) { const int st = (r >> 4) * 2 + (c >> 5), rr = r & 15, cc = c & 31, ob = rr * 64 + cc * 2; return st * 1024 + (ob ^ (((ob >> 9) & 1) << 5)); }
__host__ __device__ __forceinline__ void stage_rc(int b, int& R, int& C) { const int st = b / 1024, sb = b % 1024, swz = sb ^ (((sb >> 9) & 1) << 5); R = (st >> 1) * 16 + swz / 64; C = (st & 1) * 32 + (swz % 64) / 2; }
__host__ __device__ __forceinline__ int perm32(int rho) { const int n = rho >> 4, i = rho & 15; return 8 * (i >> 2) + 4 * n + (i & 3); }

struct Unit { int pm, pn; };
struct Gemm { const bf16_t* A; const bf16_t* Bt; int M, N, K; };

struct StaticOrder {
    int nM, nN, nwg, G, c;
    __host__ __device__ void init(int M, int N, int G_, int c_) { nM = M / BM; nN = N / BM; nwg = nM * nN; G = G_; c = c_; }
    __host__ __device__ bool next(int i, Unit& u) const {
        const long L = (long)i * G + c; if (L >= nwg) return false;
        int wgid = (int)L; { const int q = nwg / NXCD, r = nwg % NXCD, xcd = wgid % NXCD, off = wgid / NXCD; wgid = (xcd < r ? xcd * (q + 1) : r * (q + 1) + (xcd - r) * q) + off; }
        const int nig = WGM * nN, gid = wgid / nig, fm = gid * WGM, gsz = (nM - fm) < WGM ? (nM - fm) : WGM;
        u.pm = fm + ((wgid % nig) % gsz); u.pn = (wgid % nig) / gsz; return true;
    }
    __device__ __forceinline__ void a_ready(const Unit&) const {}
    __device__ __forceinline__ void done(const Unit&) const {}
};

__device__ __forceinline__ unsigned cvt_pk_bf16(float lo, float hi) { unsigned r; asm volatile("v_cvt_pk_bf16_f32 %0, %1, %2" : "=v"(r) : "v"(lo), "v"(hi)); return r; }
typedef float f32x2 __attribute__((ext_vector_type(2)));
__device__ __forceinline__ f32x2 gelu_pk(f32x2 v) {
    const f32x2 av = __builtin_elementwise_abs(v), d = av * 0.2316418882f + 1.0f;
    f32x2 t; t.x = __builtin_amdgcn_rcpf(d.x); t.y = __builtin_amdgcn_rcpf(d.y);
    f32x2 q = t * 0.5307027145f + (-0.7265760135f); q = q * t + 0.7107068705f; q = q * t + (-0.142248368f); q = q * t + 0.127414796f; q = q * t;
    const f32x2 s = (v * v) * (-0.72134752044f);
    f32x2 e; e.x = __builtin_amdgcn_exp2f(s.x); e.y = __builtin_amdgcn_exp2f(s.y);
    const f32x2 m = v * (q * e), r = v - m;
    f32x2 o; o.x = v.x < 0.f ? m.x : r.x; o.y = v.y < 0.f ? m.y : r.y; return o;
}

template <int ACT  > struct EpiBf16 {
    static constexpr bool PERM = true, AFTER_DRAIN = false; static_assert(ACT == 0 || ACT == 1, "EpiBf16: ACT is 0 (none) or 1 (gelu_pk)");
    bf16_t* O; int ldc; const float* bias; int split_cols; size_t split_stride; float scale0;
    __device__ __forceinline__ void operator()(const f32x4 (&acc)[2][2][4][2], const Unit& u, int wr, int wc, int fr, int fq) const {
        const int row0 = u.pm * BM + wr * 64 + fr; int colt = u.pn * BM; bf16_t* base = O;
        float sc = 1.f; if (split_cols) { const int t = colt / split_cols; base += (size_t)t * split_stride; colt -= t * split_cols; if (t == 0) sc = scale0; }
        const int col0 = colt + wc * 32 + 8 * fq, bcol0 = u.pn * BM + wc * 32 + 8 * fq;
        f32x4 bv[2][2];
#pragma unroll
        for (int bj = 0; bj < 2; ++bj)
#pragma unroll
            for (int n = 0; n < 2; ++n) bv[bj][n] = bias ? *(const f32x4*)(bias + bcol0 + bj * HALF + 4 * n) : (f32x4){0.f, 0.f, 0.f, 0.f};
#pragma unroll
        for (int ai = 0; ai < 2; ++ai)
#pragma unroll
            for (int m = 0; m < 4; ++m) { bf16_t* rowp = base + (size_t)(row0 + ai * HALF + m * 16) * ldc + col0;
#pragma unroll
                for (int bj = 0; bj < 2; ++bj) { f32x4 v0 = acc[ai][bj][m][0] + bv[bj][0], v1 = acc[ai][bj][m][1] + bv[bj][1];
                    if (ACT == 1) { f32x2 a = gelu_pk((f32x2){v0[0], v0[1]}), b = gelu_pk((f32x2){v0[2], v0[3]}), c = gelu_pk((f32x2){v1[0], v1[1]}), d = gelu_pk((f32x2){v1[2], v1[3]});
                        v0 = (f32x4){a.x, a.y, b.x, b.y}; v1 = (f32x4){c.x, c.y, d.x, d.y}; }
                    v0 = v0 * sc; v1 = v1 * sc; u32x4 w; w.x = cvt_pk_bf16(v0[0], v0[1]); w.y = cvt_pk_bf16(v0[2], v0[3]); w.z = cvt_pk_bf16(v1[0], v1[1]); w.w = cvt_pk_bf16(v1[2], v1[3]);
                    *(u32x4*)(rowp + bj * HALF) = w; } }
    }
};
template <class Epi, class Sched, bool ALIGN_EPI = false, bool SP2 = false>
__device__ __forceinline__ void gemm_phase(PG8_LAS unsigned char* lds, const Gemm g, const Sched& S, const Epi& E) {
    int tid = threadIdx.x; asm volatile("" : "+v"(tid));
    const int wid = __builtin_amdgcn_readfirstlane(tid >> 6), lane = tid & 63, wr = wid >> 2, wc = wid & 3, fr = lane & 15, fq = lane >> 4;
    const int K = g.K, nt = K / BK;
    unsigned voffA[2], voffB[2];
#pragma unroll
    for (int i = 0; i < 2; ++i) { int R, C; stage_rc(tid * 16 + i * 8192, R, C); const int Rb = Epi::PERM ? ((R & ~31) + perm32(R & 31)) : R;
        voffA[i] = (unsigned)(R * K + C) * 2u; voffB[i] = (unsigned)(Rb * K + C) * 2u; }
    const size_t kstep = (size_t)(BK * 2);
    const size_t hstep = (size_t)HALF * K * 2;
    const size_t tstep = 2 * hstep;
    const unsigned ldsw = (unsigned)wid * 1024u;
    const int aoff = lds_byte(wr * 64 + fr, fq * 8), boff = lds_byte(wc * 32 + fr, fq * 8);
#define PG8_SA(b, h) (((b) * 2 + (h)) * HTB)
#define PG8_SB(b, h) ((4 + (b) * 2 + (h)) * HTB)
#define PG8_STAGE(bufoff, gbase, voff) do { _Pragma("unroll") for (int _i = 0; _i < 2; ++_i) \
        __builtin_amdgcn_global_load_lds((const unsigned*)((const char*)(gbase) + (voff)[_i]), (PG8_LAS unsigned*)(lds + (bufoff) + ldsw + _i * 8192), 16, 0, 0); } while (0)
#define PG8_LDA(dst, b, h) do { _Pragma("unroll") for (int m = 0; m < 4; ++m) _Pragma("unroll") for (int k = 0; k < 2; ++k) dst[m][k] = *(const PG8_LAS bf16x8*)(lds + PG8_SA(b, h) + aoff + m * 2048 + k * 1024); } while (0)
#define PG8_LDB(dst, b, h) do { _Pragma("unroll") for (int n = 0; n < 2; ++n) _Pragma("unroll") for (int k = 0; k < 2; ++k) dst[n][k] = *(const PG8_LAS bf16x8*)(lds + PG8_SB(b, h) + boff + n * 2048 + k * 1024); } while (0)
#define PG8_MMA(ai, bj, At, Bt) do { __builtin_amdgcn_s_setprio(1); _Pragma("unroll") for (int m = 0; m < 4; ++m) _Pragma("unroll") for (int n = 0; n < 2; ++n) _Pragma("unroll") for (int k = 0; k < 2; ++k) \
        acc[ai][bj][m][n] = __builtin_amdgcn_mfma_f32_16x16x32_bf16(Bt[n][k], At[m][k], acc[ai][bj][m][n], 0, 0, 0); __builtin_amdgcn_s_setprio(0); } while (0)
#define PG8_WAIT_V(n) asm volatile("s_waitcnt vmcnt(" #n ")" ::: "memory")
#define PG8_WAIT_L(n) asm volatile("s_waitcnt lgkmcnt(" #n ")" ::: "memory")
#define PG8_BAR __builtin_amdgcn_s_barrier()
#define PG8_SCHED __builtin_amdgcn_sched_barrier(0)
    Unit cur, nxt; int ui = 0;
    if (!S.next(0, cur)) return;
    f32x4 acc[2][2][4][2];
#pragma unroll
    for (int a = 0; a < 2; ++a)
#pragma unroll
        for (int b = 0; b < 2; ++b)
#pragma unroll
            for (int m = 0; m < 4; ++m)
#pragma unroll
                for (int n = 0; n < 2; ++n) acc[a][b][m][n] = (f32x4){0.f, 0.f, 0.f, 0.f};
    bf16x8 At[4][2], B0[2][2], B1[2][2];
    const char* cA = (const char*)g.A + (size_t)cur.pm * tstep; const char* cB = (const char*)g.Bt + (size_t)cur.pn * tstep;
    S.a_ready(cur);
    if constexpr (SP2) {
        PG8_STAGE(PG8_SB(0, 0), cB, voffB); PG8_STAGE(PG8_SB(0, 1), cB + hstep, voffB); PG8_STAGE(PG8_SA(0, 0), cA, voffA); PG8_STAGE(PG8_SA(0, 1), cA + hstep, voffA);
        if (wr == 1) PG8_BAR;
        PG8_WAIT_V(2); PG8_BAR;
        PG8_STAGE(PG8_SB(1, 0), cB + kstep, voffB); PG8_STAGE(PG8_SA(1, 0), cA + kstep, voffA); PG8_STAGE(PG8_SB(1, 1), cB + hstep + kstep, voffB);
        PG8_WAIT_V(6); PG8_BAR;
    } else {
        PG8_STAGE(PG8_SB(0, 0), cB, voffB); PG8_STAGE(PG8_SA(0, 0), cA, voffA); PG8_STAGE(PG8_SB(0, 1), cB + hstep, voffB); PG8_STAGE(PG8_SA(0, 1), cA + hstep, voffA);
        if (wr == 1) PG8_BAR;
        PG8_WAIT_V(4); PG8_BAR;
        PG8_STAGE(PG8_SB(1, 0), cB + kstep, voffB); PG8_STAGE(PG8_SA(1, 0), cA + kstep, voffA); PG8_STAGE(PG8_SB(1, 1), cB + hstep + kstep, voffB);
        PG8_WAIT_V(6); PG8_BAR;
    }
    for (;;) {
        const bool has_next = S.next(ui + 1, nxt);
        const char* nA = has_next ? (const char*)g.A + (size_t)nxt.pm * tstep : cA; const char* nB = has_next ? (const char*)g.Bt + (size_t)nxt.pn * tstep : cB;
        for (int t = 0; t < nt; t += 2) {
            const bool last = (t == nt - 2);
            const char* a1 = cA + (size_t)(t + 1) * kstep;
            const char* a2 = last ? nA : cA + (size_t)(t + 2) * kstep; const char* b2 = last ? nB : cB + (size_t)(t + 2) * kstep;
            const char* a3 = a2 + kstep; const char* b3 = b2 + kstep;
            if (last && has_next) S.a_ready(nxt);
            if constexpr (SP2) {
            PG8_LDB(B0, 0, 0); PG8_LDB(B1, 0, 1); PG8_SCHED; PG8_LDA(At, 0, 0); PG8_STAGE(PG8_SA(1, 1), a1 + hstep, voffA);
            PG8_WAIT_V(8); PG8_WAIT_L(0); PG8_BAR; PG8_MMA(0, 0, At, B0); PG8_MMA(0, 1, At, B1); PG8_BAR; PG8_SCHED;
            PG8_LDA(At, 0, 1); PG8_STAGE(PG8_SB(0, 0), b2, voffB); PG8_STAGE(PG8_SB(0, 1), b2 + hstep, voffB); PG8_STAGE(PG8_SA(0, 0), a2, voffA);
            PG8_WAIT_V(8); PG8_WAIT_L(0); PG8_BAR; PG8_MMA(1, 0, At, B0); PG8_MMA(1, 1, At, B1); PG8_BAR; PG8_SCHED;
            PG8_LDB(B0, 1, 0); PG8_LDB(B1, 1, 1); PG8_SCHED; PG8_LDA(At, 1, 0); PG8_STAGE(PG8_SA(0, 1), a2 + hstep, voffA);
            PG8_WAIT_V(8); PG8_WAIT_L(0); PG8_BAR; PG8_MMA(0, 0, At, B0); PG8_MMA(0, 1, At, B1); PG8_BAR; PG8_SCHED;
            PG8_LDA(At, 1, 1); PG8_STAGE(PG8_SB(1, 0), b3, voffB); PG8_STAGE(PG8_SB(1, 1), b3 + hstep, voffB); PG8_STAGE(PG8_SA(1, 0), a3, voffA);
            PG8_WAIT_V(8); PG8_WAIT_L(0); PG8_BAR; PG8_MMA(1, 0, At, B0); PG8_MMA(1, 1, At, B1); PG8_BAR; PG8_SCHED;
            } else {
            PG8_LDB(B0, 0, 0); PG8_SCHED; PG8_LDA(At, 0, 0); PG8_STAGE(PG8_SA(1, 1), a1 + hstep, voffA);
            PG8_WAIT_L(8); PG8_BAR; PG8_WAIT_L(0); PG8_MMA(0, 0, At, B0); PG8_BAR; PG8_SCHED;
            PG8_LDB(B1, 0, 1); PG8_STAGE(PG8_SB(0, 0), b2, voffB);
            PG8_BAR; PG8_WAIT_L(0); PG8_MMA(0, 1, At, B1); PG8_BAR;
            PG8_LDA(At, 0, 1); PG8_STAGE(PG8_SA(0, 0), a2, voffA);
            PG8_BAR; PG8_WAIT_L(0); PG8_MMA(1, 0, At, B0); PG8_BAR; PG8_SCHED;
            PG8_STAGE(PG8_SB(0, 1), b2 + hstep, voffB);
            PG8_WAIT_V(6); PG8_BAR; PG8_MMA(1, 1, At, B1); PG8_BAR;
            PG8_LDB(B0, 1, 0); PG8_SCHED; PG8_LDA(At, 1, 0); PG8_STAGE(PG8_SA(0, 1), a2 + hstep, voffA);
            PG8_WAIT_L(8); PG8_BAR; PG8_WAIT_L(0); PG8_MMA(0, 0, At, B0); PG8_BAR; PG8_SCHED;
            PG8_LDB(B1, 1, 1); PG8_STAGE(PG8_SB(1, 0), b3, voffB);
            PG8_BAR; PG8_WAIT_L(0); PG8_MMA(0, 1, At, B1); PG8_BAR;
            PG8_LDA(At, 1, 1); PG8_STAGE(PG8_SA(1, 0), a3, voffA);
            PG8_BAR; PG8_WAIT_L(0); PG8_MMA(1, 0, At, B0); PG8_BAR; PG8_SCHED;
            PG8_STAGE(PG8_SB(1, 1), b3 + hstep, voffB);
            PG8_WAIT_V(6); PG8_BAR; PG8_MMA(1, 1, At, B1); PG8_BAR;
            }
        }
        if constexpr (ALIGN_EPI) { if (wr == 0) PG8_BAR; }
        if constexpr (!Epi::AFTER_DRAIN) { E(acc, cur, wr, wc, fr, fq); S.done(cur); }
        if (!has_next) break;
#pragma unroll
        for (int a = 0; a < 2; ++a)
#pragma unroll
            for (int b = 0; b < 2; ++b)
#pragma unroll
                for (int m = 0; m < 4; ++m)
#pragma unroll
                    for (int n = 0; n < 2; ++n) acc[a][b][m][n] = (f32x4){0.f, 0.f, 0.f, 0.f};
        cur = nxt; cA = nA; cB = nB; ++ui;
        if constexpr (ALIGN_EPI) { if (wr == 1) PG8_BAR; }
    }
    PG8_WAIT_V(0);
    if constexpr (!ALIGN_EPI) { if (wr == 0) PG8_BAR; }
    PG8_BAR;
    if constexpr (Epi::AFTER_DRAIN) { E.fused(acc, cur, wr, wc, fr, fq, lds, wid, lane); S.done(cur); }
#undef PG8_SA
#undef PG8_SB
#undef PG8_STAGE
#undef PG8_LDA
#undef PG8_LDB
#undef PG8_MMA
#undef PG8_WAIT_V
#undef PG8_WAIT_L
#undef PG8_BAR
#undef PG8_SCHED
}
}

namespace mk {
typedef unsigned short bf16;
typedef short bf16x8 __attribute__((ext_vector_type(8)));
typedef float f32x16 __attribute__((ext_vector_type(16)));
typedef float f32x4 __attribute__((ext_vector_type(4)));
typedef unsigned u32x4 __attribute__((ext_vector_type(4)));
typedef unsigned u32x2 __attribute__((ext_vector_type(2)));

constexpr int BATCH = 8, T = 4096, D = 1024, M = BATCH * T, DEPTH = 2, INC = 7976, FF = 2816, NZ = 5120;
constexpr size_t MiB = 1u << 20;
constexpr size_t WS_W = 1 * MiB, W_LAYER = 40 * MiB;
constexpr size_t OW_IN = 0, OW_G = 10 * MiB, OW_BR = 16 * MiB, OW_OUT = 19 * MiB, OW_GU = 21 * MiB, OW_D = 32 * MiB,
                 OW_C1K = 38 * MiB, OW_C1V = 38 * MiB + 512 * 1024, OW_C2K = 39 * MiB, OW_C2V = 39 * MiB + 256 * 1024;
constexpr size_t WS_KC = 81 * MiB, WS_VC = WS_KC + 512 * 1024;
constexpr size_t WS_H = 82 * MiB, WS_Z = 146 * MiB, SLAB = 32 * MiB, WS_END = WS_Z + 10 * SLAB;
constexpr int LDS_BYTES = 147456;
constexpr float C2 = 0.18033688011112042f;

struct Params { const float* in[23]; float* out; unsigned char* ws; };

__device__ __forceinline__ float bf2f(bf16 v) { return __uint_as_float(((unsigned)v) << 16); }
__device__ __forceinline__ unsigned f2bf(float f) { unsigned u = __float_as_uint(f); return (u + 0x7fffu + ((u >> 16) & 1u)) >> 16; }
__device__ __forceinline__ unsigned pk2(float lo, float hi) { return f2bf(lo) | (f2bf(hi) << 16); }
__device__ __forceinline__ float lo16(unsigned w) { return __uint_as_float(w << 16); }
__device__ __forceinline__ float hi16(unsigned w) { return __uint_as_float(w & 0xffff0000u); }
__device__ __forceinline__ f32x16 mfma32(bf16x8 a, bf16x8 b, f32x16 c) { return __builtin_amdgcn_mfma_f32_32x32x16_bf16(a, b, c, 0, 0, 0); }
__device__ __forceinline__ int crow(int r, int hi) { return (r & 3) + 8 * (r >> 2) + 4 * hi; }
__device__ __forceinline__ float wave_sum(float v) {
#pragma unroll
    for (int o = 1; o < 64; o <<= 1) v += __shfl_xor(v, o);
    return v;
}
__device__ __forceinline__ float sigmoidf_(float x) { return 1.f / (1.f + __expf(-x)); }
__device__ __forceinline__ float siluf_(float x) { return x / (1.f + __expf(-x)); }
#define LDS_WAIT() asm volatile("s_waitcnt lgkmcnt(0)" ::: "memory")
__device__ __forceinline__ int fresh_tid() { int t = threadIdx.x; asm volatile("" : "+v"(t)); return t; }
__device__ __forceinline__ int fresh_bid() { int t = blockIdx.x; asm volatile("" : "+s"(t)); return t; }

template <class F>
__device__ __forceinline__ void wt_convert(F colptr, int ld, int K, int N, bf16* WT, float* scr, int gw, int NGW, int lane) {
    const int nblk = N / 32, nitems = (K / 64) * nblk;
    for (int it = gw; it < nitems; it += NGW) {
        const int kb = it / nblk, nb = it % nblk, k0 = 64 * kb, n0 = 32 * nb;
        const float* cp = colptr(n0 + 4 * (lane & 7));
        f32x4 v[8];
#pragma unroll
        for (int i = 0; i < 8; ++i) { const int kk = (lane >> 3) + 8 * i; v[i] = cp ? *(const f32x4*)(cp + (size_t)(k0 + kk) * ld) : (f32x4){0.f, 0.f, 0.f, 0.f}; }
#pragma unroll
        for (int i = 0; i < 8; ++i) { const int kk = (lane >> 3) + 8 * i; float* s = scr + kk * 33 + 4 * (lane & 7); s[0] = v[i].x; s[1] = v[i].y; s[2] = v[i].z; s[3] = v[i].w; }
        LDS_WAIT();
        const int c = lane & 7;
#pragma unroll
        for (int j = 0; j < 4; ++j) {
            const int n = (lane >> 3) + 8 * j; const float* s = scr + (8 * c) * 33 + n;
            u32x4 o; o.x = pk2(s[0 * 33], s[1 * 33]); o.y = pk2(s[2 * 33], s[3 * 33]); o.z = pk2(s[4 * 33], s[5 * 33]); o.w = pk2(s[6 * 33], s[7 * 33]);
            *(u32x4*)(WT + (size_t)(n0 + n) * K + k0 + 8 * c) = o;
        }
        LDS_WAIT();
    }
}

__device__ __forceinline__ void convert_weights(const Params& p, char* lds, int gw, int NGW, int wave, int lane) {
    float* scr = (float*)(lds + wave * 8448);
    for (int l = 0; l < DEPTH; ++l) {
        unsigned char* wb = p.ws + WS_W + (size_t)l * W_LAYER;
        const float* win = p.in[2] + (size_t)l * D * INC;
        wt_convert([=](int n) -> const float* {
            const int s = n >> 9, c = n & 511; int src;
            switch (s) { case 0: src = c; break; case 1: src = 512 + c; break; case 2: src = 1536 + c; break; case 3: src = 2048 + c; break; case 4: src = 3088 + c; break;
                         case 5: src = 4112 + c; break; case 6: src = c < 256 ? 4624 + c : (c < 272 ? 3072 + (c - 256) : (c < 296 ? 4880 + (c - 272) : -1)); break;
                         case 7: src = 1024 + c; break; case 8: src = 2560 + c; break; default: src = 3600 + c; break; }
            return src < 0 ? nullptr : win + src; }, INC, D, NZ, (bf16*)(wb + OW_IN), scr, gw, NGW, lane);
        wt_convert([=](int n) -> const float* { return win + 4904 + n; }, INC, D, 3072, (bf16*)(wb + OW_G), scr, gw, NGW, lane);
        for (int b = 0; b < 3; ++b) { const float* w = p.in[14 + b] + (size_t)l * 512 * D;
            wt_convert([=](int n) -> const float* { return w + n; }, D, 512, D, (bf16*)(wb + OW_BR) + (size_t)b * D * 512, scr, gw, NGW, lane); }
        { const float* w = p.in[17] + (size_t)l * D * D; wt_convert([=](int n) -> const float* { return w + n; }, D, D, D, (bf16*)(wb + OW_OUT), scr, gw, NGW, lane); }
        { const float* wg = p.in[19] + (size_t)l * D * FF; const float* wu = p.in[20] + (size_t)l * D * FF;
          wt_convert([=](int n) -> const float* { const int j = n >> 8, i = n & 255; return i < 128 ? wg + 128 * j + i : wu + 128 * j + (i - 128); }, FF, D, 2 * FF, (bf16*)(wb + OW_GU), scr, gw, NGW, lane); }
        { const float* w = p.in[21] + (size_t)l * FF * D; wt_convert([=](int n) -> const float* { return w + n; }, D, FF, D, (bf16*)(wb + OW_D), scr, gw, NGW, lane); }
        { const float* w = p.in[10] + (size_t)l * 2048 * 128; wt_convert([=](int n) -> const float* { return w + n; }, 128, 2048, 128, (bf16*)(wb + OW_C1K), scr, gw, NGW, lane); }
        { const float* w = p.in[12] + (size_t)l * 2048 * 128; wt_convert([=](int n) -> const float* { return w + n; }, 128, 2048, 128, (bf16*)(wb + OW_C1V), scr, gw, NGW, lane); }
        { const float* w = p.in[11] + (size_t)l * 128 * 64; wt_convert([=](int n) -> const float* { return w + n; }, 64, 128, 64, (bf16*)(wb + OW_C2K), scr, gw, NGW, lane); }
        { const float* w = p.in[13] + (size_t)l * 128 * 64; wt_convert([=](int n) -> const float* { return w + n; }, 64, 128, 64, (bf16*)(wb + OW_C2V), scr, gw, NGW, lane); }
    }
}

__device__ __forceinline__ void rms_to_bf16(const float* x, const float* g, bf16* out, int gw, int NGW, int lane) {
    f32x4 gg[4];
#pragma unroll
    for (int j = 0; j < 4; ++j) gg[j] = ((const f32x4*)g)[lane + 64 * j];
    for (int m = 2 * gw; m < M; m += 2 * NGW) {
        const f32x4* xr = (const f32x4*)(x + (size_t)m * D) + lane; f32x4 v[8]; float s0 = 0.f, s1 = 0.f;
#pragma unroll
        for (int j = 0; j < 8; ++j) v[j] = xr[64 * j];
#pragma unroll
        for (int j = 0; j < 4; ++j) { s0 += (v[j].x * v[j].x + v[j].y * v[j].y) + (v[j].z * v[j].z + v[j].w * v[j].w); s1 += (v[4 + j].x * v[4 + j].x + v[4 + j].y * v[4 + j].y) + (v[4 + j].z * v[4 + j].z + v[4 + j].w * v[4 + j].w); }
        const float r0 = rsqrtf(wave_sum(s0) * (1.f / D) + 1e-6f), r1 = rsqrtf(wave_sum(s1) * (1.f / D) + 1e-6f);
        u32x2* o = (u32x2*)(out + (size_t)m * D) + lane;
#pragma unroll
        for (int j = 0; j < 8; ++j) { const float r = j < 4 ? r0 : r1; const f32x4 g4 = gg[j & 3]; u32x2 w; w.x = pk2(v[j].x * r * g4.x, v[j].y * r * g4.y); w.y = pk2(v[j].z * r * g4.z, v[j].w * r * g4.w); o[64 * j] = w; }
    }
}
__device__ __forceinline__ void rms_final(float* x, const float* g, int gw, int NGW, int lane) {
    for (int m = gw; m < M; m += NGW) {
        f32x4* xr = (f32x4*)(x + (size_t)m * D) + lane; f32x4 v[4]; float s = 0.f;
#pragma unroll
        for (int j = 0; j < 4; ++j) { v[j] = xr[64 * j]; s += (v[j].x * v[j].x + v[j].y * v[j].y) + (v[j].z * v[j].z + v[j].w * v[j].w); }
        const float r = rsqrtf(wave_sum(s) * (1.f / D) + 1e-6f);
#pragma unroll
        for (int j = 0; j < 4; ++j) { const f32x4 gg = ((const f32x4*)g)[lane + 64 * j]; xr[64 * j] = v[j] * r * gg; }
    }
}

__device__ __forceinline__ float inv_freq(int i) {
    switch (i) { case 0: return 1.0f; case 1: return 0.19392274474868576f; case 2: return 0.03760603093086393f; case 3: return 0.007292664737217109f;
                 case 4: return 0.001414213562373095f; case 5: return 0.0002742481756762073f; case 6: return 5.318295896944988e-05f; default: return 1.031338537721246e-05f; }
}
__device__ __forceinline__ void rope_cs(int t, int i, float& c, float& s) {
    const float ang = (float)t * inv_freq(i);
    const double rev = (double)ang * 0.15915494309189535; const float fr = (float)(rev - floor(rev));
    s = __builtin_amdgcn_sinf(fr); c = __builtin_amdgcn_cosf(fr);
}

__device__ __forceinline__ void rope_pass(const Params& p, int gw, int NGW, int lane) {
    bf16* Z = (bf16*)(p.ws + WS_Z);
    bf16* q = Z + 9 * (SLAB / 2); bf16* s5 = Z + 5 * (SLAB / 2); bf16* s6 = Z + 6 * (SLAB / 2);
    for (int m = gw; m < M; m += NGW) {
        const int t = m & (T - 1);
        float cl, sl; rope_cs(t, lane & 7, cl, sl);
        float cs[8], sn[8];
#pragma unroll
        for (int i = 0; i < 8; ++i) { cs[i] = __shfl(cl, i); sn[i] = __shfl(sl, i); }
        const int ch = lane & 7;
        {
            u32x4* ptr = (u32x4*)(q + (size_t)m * 512 + 8 * lane); const u32x4 w = *ptr; float v[8], o[8];
#pragma unroll
            for (int e = 0; e < 4; ++e) { v[2 * e] = lo16(w[e]); v[2 * e + 1] = hi16(w[e]); }
#pragma unroll
            for (int e = 0; e < 8; ++e) { const float pv = __shfl_xor(v[e], 1); o[e] = ch == 0 ? v[e] * cs[e] - pv * sn[e] : (ch == 1 ? v[e] * cs[e] + pv * sn[e] : v[e]); o[e] *= C2; }
            u32x4 r; r.x = pk2(o[0], o[1]); r.y = pk2(o[2], o[3]); r.z = pk2(o[4], o[5]); r.w = pk2(o[6], o[7]); *ptr = r;
        }
        {
            bf16* base = lane < 16 ? s5 + (size_t)m * 512 + 256 + 8 * lane : s6 + (size_t)m * 512 + 8 * (lane - 16);
            u32x4* ptr = (u32x4*)base; u32x4 w = (u32x4){0u, 0u, 0u, 0u}; if (lane < 32) w = *ptr; float v[8], o[8];
#pragma unroll
            for (int e = 0; e < 4; ++e) { v[2 * e] = lo16(w[e]); v[2 * e + 1] = hi16(w[e]); }
#pragma unroll
            for (int e = 0; e < 8; ++e) { const float pv = __shfl_xor(v[e], 1); o[e] = ch == 0 ? v[e] * cs[e] - pv * sn[e] : (ch == 1 ? v[e] * cs[e] + pv * sn[e] : v[e]); }
            u32x4 r; r.x = pk2(o[0], o[1]); r.y = pk2(o[2], o[3]); r.z = pk2(o[4], o[5]); r.w = pk2(o[6], o[7]); if (lane < 32) *ptr = r;
        }
    }
}

__device__ __forceinline__ float gelu_tanh(float x) { const float u = 0.7978845608028654f * (x + 0.044715f * x * x * x); const float e = __expf(2.f * u); const float th = 1.f - 2.f / (e + 1.f); return 0.5f * x * (1.f + th); }
__device__ __forceinline__ void compress_task(const Params& p, int layer, int task, char* lds) {
    const int tid = fresh_tid(), lane = tid & 63, w = __builtin_amdgcn_readfirstlane(tid >> 6), r32 = lane & 31, hi = lane >> 5;
    const int kind = task >> 7, rg = task & 127;
    const bf16* s5 = (const bf16*)(p.ws + WS_Z) + 5 * (SLAB / 2);
    const unsigned char* wb = p.ws + WS_W + (size_t)layer * W_LAYER;
    const bf16* w1T = (const bf16*)(wb + (kind ? OW_C1V : OW_C1K)); const bf16* w2T = (const bf16*)(wb + (kind ? OW_C2V : OW_C2K));
    const float* pos = p.in[kind ? 9 : 8] + (size_t)layer * 32 * 64;
    bf16* dst = (bf16*)(p.ws + (kind ? WS_VC : WS_KC));
    float* red = (float*)lds;
    bf16* hid = (bf16*)(lds + 131072);
    const int id = 32 * rg + r32; const bool valid = id < 4080; const int bg = valid ? id / 255 : 0, n = valid ? id % 255 : 0;
    const int b = bg >> 1, g = bg & 1;
    f32x16 acc[4];
#pragma unroll
    for (int i = 0; i < 4; ++i) acc[i] = (f32x16){};
    for (int s = 16 * w; s < 16 * w + 16; ++s) {
        const int j = s >> 2, d0 = 16 * (s & 3) + 8 * hi, tpos = 16 * n + j;
        const u32x4 wz = *(const u32x4*)(s5 + (size_t)(b * T + tpos) * 512 + kind * 128 + g * 64 + d0);
        float v[8];
#pragma unroll
        for (int e = 0; e < 4; ++e) { v[2 * e] = lo16(wz[e]); v[2 * e + 1] = hi16(wz[e]); }
        if (kind == 0 && (s & 3) == 0) {
#pragma unroll
            for (int e = 0; e < 8; ++e) { float c, sn; rope_cs(tpos, e, c, sn); const float pv = __shfl_xor(v[e], 32); v[e] = hi == 0 ? v[e] * c - pv * sn : v[e] * c + pv * sn; }
        }
        const f32x4 p0 = *(const f32x4*)(pos + j * 64 + d0), p1 = *(const f32x4*)(pos + j * 64 + d0 + 4);
        v[0] += p0.x; v[1] += p0.y; v[2] += p0.z; v[3] += p0.w; v[4] += p1.x; v[5] += p1.y; v[6] += p1.z; v[7] += p1.w;
        u32x4 aw; aw.x = pk2(v[0], v[1]); aw.y = pk2(v[2], v[3]); aw.z = pk2(v[4], v[5]); aw.w = pk2(v[6], v[7]);
        if (!valid) aw = (u32x4){0u, 0u, 0u, 0u};
        const bf16x8 a = __builtin_bit_cast(bf16x8, aw);
#pragma unroll
        for (int nb = 0; nb < 4; ++nb) { const bf16x8 bb = *(const bf16x8*)(w1T + (size_t)(32 * nb + r32) * 2048 + 16 * s + 8 * hi); acc[nb] = mfma32(a, bb, acc[nb]); }
    }
#pragma unroll
    for (int nb = 0; nb < 4; ++nb)
#pragma unroll
        for (int r = 0; r < 16; ++r) red[(w * 32 + crow(r, hi)) * 128 + 32 * nb + r32] = acc[nb][r];
    __syncthreads();
    for (int e = tid; e < 4096; e += 512) { float s = 0.f;
#pragma unroll
        for (int ww = 0; ww < 8; ++ww) s += red[ww * 4096 + e];
        hid[(e >> 7) * 136 + (e & 127)] = (bf16)f2bf(gelu_tanh(s)); }
    __syncthreads();
    if (w < 2) {
        f32x16 o = (f32x16){};
#pragma unroll
        for (int s = 0; s < 8; ++s) { const bf16x8 a = *(const bf16x8*)(hid + r32 * 136 + 16 * s + 8 * hi); const bf16x8 bb = *(const bf16x8*)(w2T + (size_t)(32 * w + r32) * 128 + 16 * s + 8 * hi); o = mfma32(a, bb, o); }
#pragma unroll
        for (int r = 0; r < 16; ++r) { const int id2 = 32 * rg + crow(r, hi); if (id2 < 4080) { const int bg2 = id2 / 255, n2 = id2 % 255; dst[((size_t)bg2 * 256 + n2) * 64 + 32 * w + r32] = (bf16)f2bf(o[r]); } }
    }
    __syncthreads();
}

constexpr size_t WS_PB = WS_END, WS_DEC = WS_END + 32 * MiB, WS_NEED = WS_END + 34 * MiB;
template <int DK, bool HG>
__device__ __forceinline__ void scan_prep(const Params& p, int layer, int b, int h, int c, char* lds) {
    constexpr int PARTS = 512 / DK, TP = 64 / PARTS, QS = DK + 8;
    const int tid = fresh_tid(), lane = tid & 63, w = __builtin_amdgcn_readfirstlane(tid >> 6), r32 = lane & 31, hi = lane >> 5;
    bf16* qe = (bf16*)lds; bf16* ke = qe + 64 * QS; bf16* keT = ke + 64 * QS; bf16* P = keT + DK * 72; float* tot = (float*)(P + 64 * 72);
    bf16* Z = (bf16*)(p.ws + WS_Z);
    const int d = tid % DK, part = tid / DK;
    bf16 *qsrc, *ksrc; const bf16* glr = Z + 6 * (SLAB / 2) + 256;
    float lb = 0.f, bias = 0.f, w2c[16];
    if (HG) {
        qsrc = Z + 0 * (SLAB / 2) + h * 128; ksrc = Z + 1 * (SLAB / 2) + h * 128;
        if (layer == 1) { const float l0 = p.in[3][h * 128 + d], l1 = p.in[3][512 + h * 128 + d]; lb = 1.f / (1.f + __expf(l0 - l1)); }
#pragma unroll
        for (int j = 0; j < 16; ++j) w2c[j] = 0.f;
    } else {
        qsrc = Z + 3 * (SLAB / 2) + h * 64; ksrc = Z + 3 * (SLAB / 2) + 256 + h * 64;
        bias = p.in[6][layer * 256 + h * 64 + d];
#pragma unroll
        for (int j = 0; j < 16; ++j) w2c[j] = p.in[5][(size_t)layer * 16 * 256 + j * 256 + h * 64 + d];
    }
    const size_t m0 = (size_t)b * T + 64 * c;
    float gl[TP], qv[TP], kv[TP]; float run = 0.f;
#pragma unroll
    for (int ii = 0; ii < TP; ++ii) {
        const size_t row = m0 + part * TP + ii;
        const float xq = bf2f(qsrc[row * 512 + d]), xk = bf2f(ksrc[row * 512 + d]);
        float g;
        if (HG) { const float ex = __expf(-xk); const float sg = 1.f / (1.f + ex); const float f = lb + (1.f - lb) * sg; g = __logf(f); kv[ii] = (1.f - lb) * ex * sg; qv[ii] = siluf_(xq); }
        else { float u = bias; const u32x4 g0 = *(const u32x4*)(glr + row * 512), g1 = *(const u32x4*)(glr + row * 512 + 8);
#pragma unroll
            for (int e = 0; e < 4; ++e) { u += lo16(g0[e]) * w2c[2 * e] + hi16(g0[e]) * w2c[2 * e + 1]; u += lo16(g1[e]) * w2c[8 + 2 * e] + hi16(g1[e]) * w2c[8 + 2 * e + 1]; }
            g = (fminf(u, 0.f) - __logf(1.f + __expf(-fabsf(u)))) * (1.f / 16.f); kv[ii] = xk; qv[ii] = xq * 0.125f; }
        run += g; gl[ii] = run;
    }
    tot[part * DK + d] = run;
    __syncthreads();
    float off = 0.f, total = 0.f;
#pragma unroll
    for (int pp = 0; pp < PARTS; ++pp) { const float tv = tot[pp * DK + d]; total += tv; if (pp < part) off += tv; }
    if (part == 0) ((float*)(p.ws + WS_DEC + (HG ? 0 : MiB)))[(size_t)((b * 4 + h) * 64 + c) * DK + d] = __expf(total);
#pragma unroll
    for (int ii = 0; ii < TP; ++ii) {
        const int i = part * TP + ii; const float bb = off + gl[ii];
        const float eq = __expf(fminf(bb - total, 80.f)), ek = __expf(total - bb);
        const bf16 qb16 = (bf16)f2bf(qv[ii] * eq), kb16 = (bf16)f2bf(kv[ii] * ek);
        qe[i * QS + d] = qb16; ke[i * QS + d] = kb16; keT[d * 72 + i] = kb16;
    }
    __syncthreads();
    if (w >= 4 && w < 7) {
        const int ti = w == 4 ? 0 : 1, si = w == 6 ? 1 : 0;
        f32x16 sc = (f32x16){};
#pragma unroll
        for (int ks = 0; ks < DK / 16; ++ks) { const bf16x8 a = *(const bf16x8*)(qe + (32 * ti + r32) * QS + 16 * ks + 8 * hi); const bf16x8 bb = *(const bf16x8*)(ke + (32 * si + r32) * QS + 16 * ks + 8 * hi); sc = mfma32(a, bb, sc); }
#pragma unroll
        for (int r = 0; r < 16; ++r) { const int tt = 32 * ti + crow(r, hi), ss = 32 * si + r32; P[tt * 72 + ss] = (ss <= tt) ? (bf16)f2bf(sc[r]) : (bf16)0; }
    } else if (w == 7) {
#pragma unroll
        for (int r = 0; r < 16; ++r) P[crow(r, hi) * 72 + 32 + r32] = (bf16)0;
    } else {
        const int t4 = tid;
        for (int q = t4; q < 64 * (DK / 8); q += 256) { const int row = q / (DK / 8), ch = q % (DK / 8); *(u32x4*)(qsrc + (m0 + row) * 512 + 8 * ch) = *(const u32x4*)(qe + row * QS + 8 * ch); }
        for (int q = t4; q < DK * 8; q += 256) { const int dd = q >> 3, ch = q & 7;
            bf16* dst = HG ? ksrc + (m0 + (dd >> 1)) * 512 + (dd & 1) * 64 + 8 * ch : ksrc + (m0 + dd) * 512 + 8 * ch;
            *(u32x4*)dst = *(const u32x4*)(keT + dd * 72 + 8 * ch); }
    }
    __syncthreads();
    { bf16* PB = (bf16*)(p.ws + WS_PB) + (HG ? 0 : (size_t)M * 256); const int t = tid >> 3, ch = tid & 7; *(u32x4*)(PB + (m0 + t) * 256 + h * 64 + 8 * ch) = *(const u32x4*)(P + t * 72 + 8 * ch); }
    __syncthreads();
}

template <int DK, bool HG>
__device__ __forceinline__ void scan_unit(const Params& p, int layer, int b, int h, int slice, char* lds, size_t dst_off) {
    constexpr int QS = DK + 8, NTS = DK / 32, NQ = (64 * DK / 8) / 512;
    constexpr int BUF = 64 * QS * 2 + DK * 72 * 2 + 64 * 72 * 2 + 32 * 72 * 2 + DK * 4;
    const int tid = fresh_tid(), lane = tid & 63, w = __builtin_amdgcn_readfirstlane(tid >> 6), r32 = lane & 31, hi = lane >> 5;
    bf16* ST = (bf16*)(lds + 2 * BUF);
    bf16* Z = (bf16*)(p.ws + WS_Z);
    const bf16* qsrc = HG ? Z + 0 * (SLAB / 2) + h * 128 : Z + 3 * (SLAB / 2) + h * 64;
    const bf16* ksrc = HG ? Z + 1 * (SLAB / 2) + h * 128 : Z + 3 * (SLAB / 2) + 256 + h * 64;
    bf16* vsrc = HG ? Z + 7 * (SLAB / 2) + h * 128 + 32 * slice : Z + 8 * (SLAB / 2) + h * 128 + 32 * slice;
    const bf16* PB = (const bf16*)(p.ws + WS_PB) + (HG ? 0 : (size_t)M * 256) + h * 64;
    const float* decg = (const float*)(p.ws + WS_DEC + (HG ? 0 : MiB)) + (size_t)((b * 4 + h) * 64) * DK;
    u32x4 rq[NQ], rk[NQ], rp; u32x2 rv; float rd = 0.f;
    auto gload = [&](int c) {
        const size_t m0 = (size_t)b * T + 64 * c;
#pragma unroll
        for (int k = 0; k < NQ; ++k) { const int q = tid + 512 * k; const int row = q / (DK / 8), ch = q % (DK / 8); rq[k] = *(const u32x4*)(qsrc + (m0 + row) * 512 + 8 * ch);
            const int dd = q >> 3, c8 = q & 7; rk[k] = *(const u32x4*)(HG ? ksrc + (m0 + (dd >> 1)) * 512 + (dd & 1) * 64 + 8 * c8 : ksrc + (m0 + dd) * 512 + 8 * c8); }
        rp = *(const u32x4*)(PB + (m0 + (tid >> 3)) * 256 + 8 * (tid & 7));
        rv = *(const u32x2*)(vsrc + (m0 + (tid >> 3)) * 512 + (tid & 7) * 4);
        if (tid < DK) rd = decg[c * DK + tid];
    };
    auto stage = [&](int x) {
        bf16* qe = (bf16*)(lds + x * BUF); bf16* keT = qe + 64 * QS; bf16* P = keT + DK * 72; bf16* VT = P + 64 * 72; float* dec = (float*)(VT + 32 * 72);
#pragma unroll
        for (int k = 0; k < NQ; ++k) { const int q = tid + 512 * k; const int row = q / (DK / 8), ch = q % (DK / 8); *(u32x4*)(qe + row * QS + 8 * ch) = rq[k]; *(u32x4*)(keT + (q >> 3) * 72 + 8 * (q & 7)) = rk[k]; }
        *(u32x4*)(P + (tid >> 3) * 72 + 8 * (tid & 7)) = rp;
        { const int s = tid >> 3, v4 = (tid & 7) * 4; VT[(v4 + 0) * 72 + s] = (bf16)(rv.x & 0xffffu); VT[(v4 + 1) * 72 + s] = (bf16)(rv.x >> 16); VT[(v4 + 2) * 72 + s] = (bf16)(rv.y & 0xffffu); VT[(v4 + 3) * 72 + s] = (bf16)(rv.y >> 16); }
        if (tid < DK) dec[tid] = rd;
    };
    f32x16 S = (f32x16){};
    gload(0); stage(0); gload(1);
    __syncthreads();
    for (int c = 0; c < T / 64; ++c) {
        const int x = c & 1; const size_t m0 = (size_t)b * T + 64 * c;
        const bf16* qe = (const bf16*)(lds + x * BUF); const bf16* keT = qe + 64 * QS; const bf16* P = keT + DK * 72; const bf16* VT = P + 64 * 72; const float* dec = (const float*)(VT + 32 * 72);
        if (c + 1 < T / 64) { stage(x ^ 1); if (c + 2 < T / 64) gload(c + 2); }
        f32x16 o = (f32x16){};
        if (w < NTS) {
            const float dc = dec[32 * w + r32];
#pragma unroll
            for (int r = 0; r < 16; ++r) { S[r] *= dc; ST[crow(r, hi) * QS + 32 * w + r32] = (bf16)f2bf(S[r]); }
#pragma unroll
            for (int ks = 0; ks < 4; ++ks) { const bf16x8 a = *(const bf16x8*)(VT + r32 * 72 + 16 * ks + 8 * hi); const bf16x8 bb = *(const bf16x8*)(keT + (32 * w + r32) * 72 + 16 * ks + 8 * hi); S = mfma32(a, bb, S); }
        } else if (w < 6) {
#pragma unroll
            for (int ks = 0; ks < 4; ++ks) { const bf16x8 a = *(const bf16x8*)(P + (32 * (w - 4) + r32) * 72 + 16 * ks + 8 * hi); const bf16x8 bb = *(const bf16x8*)(VT + r32 * 72 + 16 * ks + 8 * hi); o = mfma32(a, bb, o); }
        }
        __syncthreads();
        if (w >= 4 && w < 6) {
#pragma unroll
            for (int ks = 0; ks < DK / 16; ++ks) { const bf16x8 a = *(const bf16x8*)(qe + (32 * (w - 4) + r32) * QS + 16 * ks + 8 * hi); const bf16x8 bb = *(const bf16x8*)(ST + r32 * QS + 16 * ks + 8 * hi); o = mfma32(a, bb, o); }
#pragma unroll
            for (int r = 0; r < 16; ++r) vsrc[dst_off + (m0 + 32 * (w - 4) + crow(r, hi)) * 512 + r32] = (bf16)f2bf(o[r]);
        }
        __syncthreads();
    }
}

__device__ __forceinline__ void finish_pass(const Params& p, int layer, int gw, int NGW, int lane) {
    bf16* Z = (bf16*)(p.ws + WS_Z);
    for (int m = gw; m < M; m += NGW) {
        u32x4 wo[2], wg[2]; f32x4 g0[2], g1[2];
#pragma unroll
        for (int mix = 0; mix < 2; ++mix) {
            const bf16* o = Z + (mix ? 8 : 7) * (SLAB / 2) + (size_t)m * 512 + 8 * lane; const bf16* og = Z + (mix ? 4 : 2) * (SLAB / 2) + (size_t)m * 512 + 8 * lane;
            const float* g = p.in[mix ? 7 : 4] + layer * 512 + 8 * lane;
            wo[mix] = *(const u32x4*)o; wg[mix] = *(const u32x4*)og; g0[mix] = *(const f32x4*)g; g1[mix] = *(const f32x4*)(g + 4);
        }
#pragma unroll
        for (int mix = 0; mix < 2; ++mix) {
            float v[8], gt[8]; float s = 0.f;
#pragma unroll
            for (int e = 0; e < 4; ++e) { v[2 * e] = lo16(wo[mix][e]); v[2 * e + 1] = hi16(wo[mix][e]); gt[2 * e] = lo16(wg[mix][e]); gt[2 * e + 1] = hi16(wg[mix][e]); }
#pragma unroll
            for (int e = 0; e < 8; ++e) s += v[e] * v[e];
            s += __shfl_xor(s, 1); s += __shfl_xor(s, 2); s += __shfl_xor(s, 4); s += __shfl_xor(s, 8);
            const float r = rsqrtf(s * (1.f / 128.f) + 1e-6f);
            const float gg[8] = {g0[mix].x, g0[mix].y, g0[mix].z, g0[mix].w, g1[mix].x, g1[mix].y, g1[mix].z, g1[mix].w};
            float y[8];
#pragma unroll
            for (int e = 0; e < 8; ++e) y[e] = v[e] * r * gg[e] * siluf_(gt[e]);
            u32x4 w; w.x = pk2(y[0], y[1]); w.y = pk2(y[2], y[3]); w.z = pk2(y[4], y[5]); w.w = pk2(y[6], y[7]);
            *(u32x4*)(Z + (mix ? 8 : 7) * (SLAB / 2) + (size_t)m * 512 + 8 * lane) = w;
        }
    }
}

__device__ __forceinline__ void qk_tile(const bf16* Kt, const bf16x8* qr, f32x16& p0, f32x16& p1, int r32, int hi) {
    p0 = (f32x16){}; p1 = (f32x16){};
#pragma unroll
    for (int s = 0; s < 4; ++s) { const bf16x8 a0 = *(const bf16x8*)(Kt + r32 * 72 + 16 * s + 8 * hi), a1 = *(const bf16x8*)(Kt + (32 + r32) * 72 + 16 * s + 8 * hi); p0 = mfma32(a0, qr[s], p0); p1 = mfma32(a1, qr[s], p1); }
}
__device__ __forceinline__ unsigned cvtpk(float lo, float hi) { typedef float f2_t __attribute__((ext_vector_type(2))); typedef __bf16 b2_t __attribute__((ext_vector_type(2))); f2_t v = {lo, hi}; b2_t r = __builtin_convertvector(v, b2_t); return __builtin_bit_cast(unsigned, r); }
__device__ __forceinline__ void pv_tile(const bf16* Vt, const f32x16& p0, const f32x16& p1, f32x16* o, int r32, int hi) {
#pragma unroll
    for (int s = 0; s < 4; ++s) {
        u32x4 pw;
#pragma unroll
        for (int i = 0; i < 4; ++i) { const float a = (s < 2) ? p0[8 * (s & 1) + 2 * i] : p1[8 * (s & 1) + 2 * i], bq = (s < 2) ? p0[8 * (s & 1) + 2 * i + 1] : p1[8 * (s & 1) + 2 * i + 1]; pw[i] = cvtpk(a, bq); }
        const bf16x8 pb = __builtin_bit_cast(bf16x8, pw);
#pragma unroll
        for (int db = 0; db < 2; ++db) { const bf16* vp = Vt + (32 * db + r32) * 72 + 16 * s + 4 * hi; const u32x2 lo = *(const u32x2*)vp, hi8 = *(const u32x2*)(vp + 8);
            u32x4 aw; aw.x = lo.x; aw.y = lo.y; aw.z = hi8.x; aw.w = hi8.y; o[db] = mfma32(__builtin_bit_cast(bf16x8, aw), pb, o[db]); }
    }
}
struct TileRegs { u32x4 k; u32x2 va, vb; };
template <bool WITHV> __device__ __forceinline__ void tile_load(TileRegs& R, const bf16* Kb, const bf16* Vb, int pitch, int j, int tid) {
    R.k = *(const u32x4*)(Kb + (size_t)(64 * j + (tid >> 3)) * pitch + 8 * (tid & 7));
    if (WITHV) { const int pair = tid & 31, dq = tid >> 5; const bf16* vp = Vb + (size_t)(64 * j + 2 * pair) * pitch + 4 * dq; R.va = *(const u32x2*)vp; R.vb = *(const u32x2*)(vp + pitch); }
}
template <bool WITHV> __device__ __forceinline__ void tile_stage(const TileRegs& R, bf16* Kt, bf16* Vt, int tid) {
    *(u32x4*)(Kt + (tid >> 3) * 72 + 8 * (tid & 7)) = R.k;
    if (WITHV) { const int pair = tid & 31, dq = tid >> 5; unsigned* v32 = (unsigned*)Vt + (4 * dq) * 36 + pair;
        v32[0] = (R.va.x & 0xffffu) | (R.vb.x << 16); v32[36] = (R.va.x >> 16) | (R.vb.x & 0xffff0000u); v32[72] = (R.va.y & 0xffffu) | (R.vb.y << 16); v32[108] = (R.va.y >> 16) | (R.vb.y & 0xffff0000u); }
}
template <int MODE>
__device__ __forceinline__ void run_tiles(const bf16* Kb, const bf16* Vb, int pitch, int j0, int j1, bf16* Kt, bf16* Vt, const bf16x8* qr, int t,
                                          float& m, float& l, f32x16* o, float mc, float invlc, float* impme, int tid, int r32, int hi) {
    TileRegs R; tile_load<MODE != 0>(R, Kb, Vb, pitch, j0, tid);
    for (int j = j0; j <= j1; ++j) {
        __syncthreads();
        tile_stage<MODE != 0>(R, Kt, Vt, tid);
        if (j < j1) tile_load<MODE != 0>(R, Kb, Vb, pitch, j + 1, tid);
        __syncthreads();
        f32x16 p0, p1; qk_tile(Kt, qr, p0, p1, r32, hi);
        const float NEG = -INFINITY;
#pragma unroll
        for (int r = 0; r < 16; ++r) { const int k0 = 64 * j + crow(r, hi), k1 = k0 + 32; p0[r] = (16 * k0 + 31 <= t) ? p0[r] : NEG; p1[r] = (16 * k1 + 31 <= t) ? p1[r] : NEG; }
        if (MODE == 1) {
#pragma unroll
            for (int r = 0; r < 16; ++r) { p0[r] = __builtin_amdgcn_exp2f(p0[r] - mc) * invlc; p1[r] = __builtin_amdgcn_exp2f(p1[r] - mc) * invlc; }
#pragma unroll
            for (int half = 0; half < 2; ++half)
#pragma unroll
                for (int g4 = 0; g4 < 4; ++g4) {
                    const float c3 = half ? p1[4 * g4 + 3] : p0[4 * g4 + 3];
                    const float a = half ? (p1[4 * g4] + p1[4 * g4 + 1]) + (p1[4 * g4 + 2] + c3) : (p0[4 * g4] + p0[4 * g4 + 1]) + (p0[4 * g4 + 2] + c3);
                    const float cp = __shfl_xor(c3, 32); const int jj = 16 * j + 8 * half + 2 * g4 + hi;
                    if (hi) impme[jj] += a + cp; else { impme[jj] += a; impme[jj + 2] += cp; }
                }
            pv_tile(Vt, p0, p1, o, r32, hi);
        } else {
            float mx = p0[0];
#pragma unroll
            for (int r = 0; r < 16; ++r) { mx = fmaxf(mx, p0[r]); mx = fmaxf(mx, p1[r]); }
            mx = fmaxf(mx, __shfl_xor(mx, 32));
            const float mn = fmaxf(m, mx), alpha = __builtin_amdgcn_exp2f(m - mn); m = mn;
            float ls = 0.f;
#pragma unroll
            for (int r = 0; r < 16; ++r) { ls += __builtin_amdgcn_exp2f(p0[r] - mn) + __builtin_amdgcn_exp2f(p1[r] - mn); }
            l = l * alpha + ls;
        }
    }
}
template <int MODE>
__device__ __forceinline__ void run_tiles_fast(const bf16* Kb, const bf16* Vb, int pitch, int j0, int j1, int qb, bf16* Kt, bf16* Vt, const bf16x8* qr, int t, unsigned long long sel,
                                               float& mref, float& l, f32x16* o, int tid, int r32, int hi) {
    TileRegs R; tile_load<true>(R, Kb, Vb, pitch, j0, tid);
    const float NEG = -INFINITY;
    mref = 0.f;
    for (int j = j0; j <= j1; ++j) {
        __syncthreads();
        tile_stage<true>(R, Kt, Vt, tid);
        if (j < j1) tile_load<true>(R, Kb, Vb, pitch, j + 1, tid);
        __syncthreads();
        const float init = ((MODE == 2 && !((sel >> j) & 1ull)) ? NEG : 0.f) - mref;
        f32x16 p0, p1;
#pragma unroll
        for (int r = 0; r < 16; ++r) { p0[r] = init; p1[r] = init; }
#pragma unroll
        for (int s = 0; s < 4; ++s) { const bf16x8 a0 = *(const bf16x8*)(Kt + r32 * 72 + 16 * s + 8 * hi), a1 = *(const bf16x8*)(Kt + (32 + r32) * 72 + 16 * s + 8 * hi); p0 = mfma32(a0, qr[s], p0); p1 = mfma32(a1, qr[s], p1); }
        if (j == qb || (MODE == 3 && j == qb - 8)) {
#pragma unroll
            for (int r = 0; r < 16; ++r) { const int k0 = 64 * j + crow(r, hi), k1 = k0 + 32;
                const bool ok0 = k0 <= t && (MODE == 2 || k0 > t - 512), ok1 = k1 <= t && (MODE == 2 || k1 > t - 512);
                p0[r] = ok0 ? p0[r] : NEG; p1[r] = ok1 ? p1[r] : NEG; }
        }
        float mx = fmaxf(p0[0], p1[0]);
#pragma unroll
        for (int r = 1; r < 16; ++r) mx = fmaxf(fmaxf(mx, p0[r]), p1[r]);
        mx = fmaxf(mx, __shfl_xor(mx, 32));
        if (j == j0) { const float mr = (mx == NEG) ? 0.f : mx; mref = mr;
#pragma unroll
            for (int r = 0; r < 16; ++r) { p0[r] -= mr; p1[r] -= mr; } }
        else if (__any(mx > 8.f)) { const float dl = fmaxf(mx, 0.f), f = __builtin_amdgcn_exp2f(-dl); mref += dl; l *= f; o[0] *= f; o[1] *= f;
#pragma unroll
            for (int r = 0; r < 16; ++r) { p0[r] -= dl; p1[r] -= dl; } }
        float ls = 0.f;
#pragma unroll
        for (int r = 0; r < 16; ++r) { p0[r] = __builtin_amdgcn_exp2f(p0[r]); p1[r] = __builtin_amdgcn_exp2f(p1[r]); ls += p0[r] + p1[r]; }
        l += ls;
        pv_tile(Vt, p0, p1, o, r32, hi);
    }
}

__device__ __forceinline__ void nsa_unit(const Params& p, int bg, int qb, char* lds, size_t dst_off) {
    const int tid = fresh_tid(), lane = tid & 63, w = __builtin_amdgcn_readfirstlane(tid >> 6), r32 = lane & 31, hi = lane >> 5;
    const int b = bg >> 1, g = bg & 1;
    bf16* Kt = (bf16*)lds; bf16* Vt = Kt + 64 * 72; float* impw = (float*)(Vt + 64 * 72); unsigned long long* selm = (unsigned long long*)(impw + 8 * 32 * 65);
    bf16* Z = (bf16*)(p.ws + WS_Z);
    bf16* s5 = Z + 5 * (SLAB / 2); bf16* s6 = Z + 6 * (SLAB / 2); bf16* s9 = Z + 9 * (SLAB / 2);
    const bf16* KC = (const bf16*)(p.ws + WS_KC) + (size_t)bg * 256 * 64; const bf16* VC = (const bf16*)(p.ws + WS_VC) + (size_t)bg * 256 * 64;
    const size_t rowb = (size_t)b * T;
    const int hh = g * 4 + (w >> 1), tokl = 32 * (w & 1) + r32, t = 64 * qb + tokl; const size_t mrow = rowb + t;
    bf16x8 qr[4];
#pragma unroll
    for (int s = 0; s < 4; ++s) qr[s] = *(const bf16x8*)(s9 + mrow * 512 + hh * 64 + 16 * s + 8 * hi);
    for (int e = tid; e < 8 * 32 * 65; e += 512) impw[e] = 0.f;
    const bf16* gp = s6 + mrow * 512 + 272 + hh * 3;
    const float gc = sigmoidf_(bf2f(gp[0])), gs = sigmoidf_(bf2f(gp[1])), gwn = sigmoidf_(bf2f(gp[2]));
    f32x16 oacc[2]; oacc[0] = (f32x16){}; oacc[1] = (f32x16){};
    f32x16 o[2];
    float* impme = impw + (w * 32 + r32) * 65;
    const int ntc = (qb >> 4) + 1;
    float mc = -1e30f, lc = 0.f;
    run_tiles<0>(KC, VC, 64, 0, ntc - 1, Kt, Vt, qr, t, mc, lc, o, 0.f, 0.f, impme, tid, r32, hi);
    lc += __shfl_xor(lc, 32);
    const float invlc = lc > 0.f ? 1.f / lc : 0.f;
    o[0] = (f32x16){}; o[1] = (f32x16){};
    { float dm = 0.f, dl = 0.f; run_tiles<1>(KC, VC, 64, 0, ntc - 1, Kt, Vt, qr, t, dm, dl, o, mc, invlc, impme, tid, r32, hi); }
    oacc[0] += o[0] * gc; oacc[1] += o[1] * gc;
    __syncthreads();
    for (int tk = w; tk < 64; tk += 8) {
        float v = 0.f;
#pragma unroll
        for (int r = 0; r < 4; ++r) v += impw[((2 * r + (tk >> 5)) * 32 + (tk & 31)) * 65 + lane];
        const int cur = qb; const bool valid = lane <= cur, forced = lane == 0 || lane == cur || lane == cur - 1;
        const float sc = valid ? (forced ? 1e9f : v) : -1e9f;
        int rank = 0;
#pragma unroll 4
        for (int i = 0; i < 64; ++i) { const float si = __shfl(sc, i); rank += (si > sc || (si == sc && i < lane)) ? 1 : 0; }
        const unsigned long long mk = __ballot(rank < 16 && sc > -1e8f);
        if (lane == 0) selm[tk] = mk;
    }
    __syncthreads();
    const unsigned long long sel = selm[tokl];
    {
        float ms = -1e30f, ls = 0.f; o[0] = (f32x16){}; o[1] = (f32x16){};
        run_tiles_fast<2>(s5 + rowb * 512 + 256 + g * 64, s5 + rowb * 512 + 384 + g * 64, 512, 0, qb, qb, Kt, Vt, qr, t, sel, ms, ls, o, tid, r32, hi);
        ls += __shfl_xor(ls, 32); const float sc = gs / ls; oacc[0] += o[0] * sc; oacc[1] += o[1] * sc;
    }
    {
        float ms = -1e30f, ls = 0.f; o[0] = (f32x16){}; o[1] = (f32x16){};
        run_tiles_fast<3>(s6 + rowb * 512 + g * 64, s6 + rowb * 512 + 128 + g * 64, 512, qb > 8 ? qb - 8 : 0, qb, qb, Kt, Vt, qr, t, 0ull, ms, ls, o, tid, r32, hi);
        ls += __shfl_xor(ls, 32); const float sc = gwn / ls; oacc[0] += o[0] * sc; oacc[1] += o[1] * sc;
    }
#pragma unroll
    for (int db = 0; db < 2; ++db)
#pragma unroll
        for (int rg = 0; rg < 4; ++rg) { u32x2 wv; wv.x = pk2(oacc[db][4 * rg], oacc[db][4 * rg + 1]); wv.y = pk2(oacc[db][4 * rg + 2], oacc[db][4 * rg + 3]);
            *(u32x2*)(s9 + dst_off + mrow * 512 + hh * 64 + 32 * db + 8 * rg + 4 * hi) = wv; }
    __syncthreads();
}
}

namespace pg8 {
template <int ACT  > struct EpiStore {
    static constexpr bool PERM = true, AFTER_DRAIN = false;
    bf16_t* O; int ldc; int split_cols; size_t split_stride;
    __device__ __forceinline__ void operator()(const f32x4 (&acc)[2][2][4][2], const Unit& u, int wr, int wc, int fr, int fq) const {
        const int row0 = u.pm * BM + wr * 64 + fr; int colt = u.pn * BM; bf16_t* base = O;
        { const int t = colt / split_cols; base += (size_t)t * split_stride; colt -= t * split_cols; }
        const int col0 = colt + wc * 32 + 8 * fq;
#pragma unroll
        for (int ai = 0; ai < 2; ++ai)
#pragma unroll
            for (int m = 0; m < 4; ++m) { bf16_t* rowp = base + (size_t)(row0 + ai * HALF + m * 16) * ldc + col0;
#pragma unroll
                for (int bj = 0; bj < 2; ++bj) { f32x4 v0 = acc[ai][bj][m][0], v1 = acc[ai][bj][m][1];
                    if (ACT == 2) {
#pragma unroll
                        for (int e = 0; e < 4; ++e) { v0[e] = 1.f / (1.f + __expf(-v0[e])); v1[e] = 1.f / (1.f + __expf(-v1[e])); } }
                    u32x4 w; w.x = cvt_pk_bf16(v0[0], v0[1]); w.y = cvt_pk_bf16(v0[2], v0[3]); w.z = cvt_pk_bf16(v1[0], v1[1]); w.w = cvt_pk_bf16(v1[2], v1[3]);
                    *(u32x4*)(rowp + bj * HALF) = w; } }
    }
};
__device__ __forceinline__ float bflo(unsigned w) { return __uint_as_float(w << 16); }
__device__ __forceinline__ float bfhi(unsigned w) { return __uint_as_float(w & 0xffff0000u); }
template <bool FIRST> struct EpiBranch {
    static constexpr bool PERM = true, AFTER_DRAIN = false;
    bf16_t* Mo; const bf16_t* G;
    __device__ __forceinline__ void operator()(const f32x4 (&acc)[2][2][4][2], const Unit& u, int wr, int wc, int fr, int fq) const {
        const int row0 = u.pm * BM + wr * 64 + fr, col0 = u.pn * BM + wc * 32 + 8 * fq;
#pragma unroll
        for (int ai = 0; ai < 2; ++ai)
#pragma unroll
            for (int m = 0; m < 4; ++m) { const size_t off = (size_t)(row0 + ai * HALF + m * 16) * 1024 + col0;
#pragma unroll
                for (int bj = 0; bj < 2; ++bj) { const f32x4 v0 = acc[ai][bj][m][0], v1 = acc[ai][bj][m][1];
                    const u32x4 g = *(const u32x4*)(G + off + bj * HALF);
                    float r[8] = {bflo(g.x) * v0[0], bfhi(g.x) * v0[1], bflo(g.y) * v0[2], bfhi(g.y) * v0[3], bflo(g.z) * v1[0], bfhi(g.z) * v1[1], bflo(g.w) * v1[2], bfhi(g.w) * v1[3]};
                    if (!FIRST) { const u32x4 o = *(const u32x4*)(Mo + off + bj * HALF);
                        r[0] += bflo(o.x); r[1] += bfhi(o.x); r[2] += bflo(o.y); r[3] += bfhi(o.y); r[4] += bflo(o.z); r[5] += bfhi(o.z); r[6] += bflo(o.w); r[7] += bfhi(o.w); }
                    u32x4 w; w.x = cvt_pk_bf16(r[0], r[1]); w.y = cvt_pk_bf16(r[2], r[3]); w.z = cvt_pk_bf16(r[4], r[5]); w.w = cvt_pk_bf16(r[6], r[7]);
                    *(u32x4*)(Mo + off + bj * HALF) = w; } }
    }
};
struct EpiResid {
    static constexpr bool PERM = false, AFTER_DRAIN = false;
    const float* base; float* out;
    __device__ __forceinline__ void operator()(const f32x4 (&acc)[2][2][4][2], const Unit& u, int wr, int wc, int fr, int fq) const {
        const int row0 = u.pm * BM + wr * 64 + fr, col0 = u.pn * BM + wc * 32 + 4 * fq;
#pragma unroll
        for (int ai = 0; ai < 2; ++ai)
#pragma unroll
            for (int m = 0; m < 4; ++m) { const size_t off = (size_t)(row0 + ai * HALF + m * 16) * 1024 + col0;
#pragma unroll
                for (int bj = 0; bj < 2; ++bj)
#pragma unroll
                    for (int n = 0; n < 2; ++n) { const f32x4 bs = *(const f32x4*)(base + off + bj * HALF + n * 16); *(f32x4*)(out + off + bj * HALF + n * 16) = bs + acc[ai][bj][m][n]; } }
    }
};
struct EpiSwiGLU {
    static constexpr bool PERM = true, AFTER_DRAIN = false;
    bf16_t* Hd;
    __device__ __forceinline__ void operator()(const f32x4 (&acc)[2][2][4][2], const Unit& u, int wr, int wc, int fr, int fq) const {
        const int row0 = u.pm * BM + wr * 64 + fr, col0 = u.pn * 128 + wc * 32 + 8 * fq;
#pragma unroll
        for (int ai = 0; ai < 2; ++ai)
#pragma unroll
            for (int m = 0; m < 4; ++m) { float r[8];
#pragma unroll
                for (int n = 0; n < 2; ++n)
#pragma unroll
                    for (int e = 0; e < 4; ++e) { const float gt = acc[ai][0][m][n][e], up = acc[ai][1][m][n][e]; r[4 * n + e] = gt / (1.f + __expf(-gt)) * up; }
                u32x4 w; w.x = cvt_pk_bf16(r[0], r[1]); w.y = cvt_pk_bf16(r[2], r[3]); w.z = cvt_pk_bf16(r[4], r[5]); w.w = cvt_pk_bf16(r[6], r[7]);
                *(u32x4*)(Hd + (size_t)(row0 + ai * HALF + m * 16) * 2816 + col0) = w; }
    }
};
}

#define LAS __attribute__((address_space(3)))
#define XB_TMO      128
#define XB_XCNT(j)  (256  + 64 * (j))
#define XB_XSUB(j)  (1280 + 64 * (j))
#define XB_XGEN(j)  (2304 + 64 * (j))
#define XB_TOP      3328
#define XB_TOPGEN   3392
#define XCD_BAR_WORDS 3456
#define XB_SPIN_CAP (1u << 18)

__device__ __forceinline__ unsigned xb_ld(unsigned* p)              { return __hip_atomic_load(p, __ATOMIC_RELAXED, __HIP_MEMORY_SCOPE_AGENT); }
__device__ __forceinline__ unsigned xb_add(unsigned* p, unsigned v) { return __hip_atomic_fetch_add(p, v, __ATOMIC_RELAXED, __HIP_MEMORY_SCOPE_AGENT); }
__device__ __forceinline__ unsigned xb_xcc_id() { return (unsigned)__builtin_amdgcn_s_getreg((3 << 11) | 20) & 0xFu; }
#define XB_SPIN(cond, bar) do { unsigned _sp = 0; while (cond) { __builtin_amdgcn_s_sleep(1); \
    if ((++_sp & 255u) == 0u) { if (xb_ld(&(bar)[XB_TMO])) break; if (_sp > XB_SPIN_CAP) { atomicAdd(&(bar)[XB_TMO], 1u); break; } } } } while (0)

struct XcdBarrier {
    unsigned* bar; unsigned x;
    volatile LAS unsigned* st;
};

__device__ __forceinline__ XcdBarrier xcd_barrier_post(unsigned* bar, volatile LAS unsigned* st) {
    XcdBarrier b; b.bar = bar; b.x = xb_xcc_id(); b.st = st;
    if (threadIdx.x == 0) (void)xb_add(&bar[XB_XCNT(b.x)], 1u);
    return b;
}
__device__ __forceinline__ void xcd_barrier_complete(unsigned* bar, unsigned x, unsigned& nloc, unsigned& nx) {
    const unsigned G = gridDim.x * gridDim.y * gridDim.z;
    unsigned sum, cnt, mine, sp = 0u;
    for (;;) {
        sum = 0u; cnt = 0u; mine = 0u;
#pragma unroll
        for (unsigned j = 0; j < 16; ++j) { const unsigned c = xb_ld(&bar[XB_XCNT(j)]); sum += c; cnt += (c > 0u) ? 1u : 0u; mine = (j == x) ? c : mine; }
        if (sum == G) break;
        __builtin_amdgcn_s_sleep(1);
        if ((++sp & 255u) == 0u) { if (xb_ld(&bar[XB_TMO])) break; if (sp > XB_SPIN_CAP) { atomicAdd(&bar[XB_TMO], 1u); break; } }
    }
    nloc = mine > 0u ? mine : 1u; nx = cnt > 0u ? cnt : 1u;
}

__device__ __forceinline__ void xcd_barrier(const XcdBarrier& b) {
    asm volatile("s_waitcnt vmcnt(0)" ::: "memory");
    __syncthreads();
    if (threadIdx.x == 0) {
        unsigned* bar = b.bar;
        __builtin_amdgcn_s_waitcnt(0);
        unsigned nloc = b.st[0], nx = b.st[1];
        if (nloc == 0u) { xcd_barrier_complete(bar, b.x, nloc, nx); b.st[0] = nloc; b.st[1] = nx; }
        const unsigned old = xb_add(&bar[XB_XSUB(b.x)], 1u);
        const unsigned gen = old / nloc;
        if (old + 1u == (gen + 1u) * nloc) {
            __builtin_amdgcn_fence(__ATOMIC_RELEASE, "agent");
            asm volatile("s_waitcnt vmcnt(0)" ::: "memory");
            const unsigned og = xb_add(&bar[XB_TOP], 1u);
            const unsigned tg = og / nx;
            if (og + 1u == (tg + 1u) * nx) xb_add(&bar[XB_TOPGEN], 1u);
            else XB_SPIN(xb_ld(&bar[XB_TOPGEN]) == tg, bar);
            __builtin_amdgcn_fence(__ATOMIC_ACQUIRE, "agent");
            xb_add(&bar[XB_XGEN(b.x)], 1u);
            asm volatile("s_waitcnt vmcnt(0)" ::: "memory");
        } else {
            XB_SPIN(xb_ld(&bar[XB_XGEN(b.x)]) == gen, bar);
            __builtin_amdgcn_fence(__ATOMIC_ACQUIRE, "agent");
            asm volatile("s_waitcnt vmcnt(0)" ::: "memory");
        }
    }
    __syncthreads();
}

#ifndef PROBE_SCAN
#define PROBE_SCAN 0
#endif
#ifndef PROBE_NSA
#define PROBE_NSA 0
#endif
#ifndef PROBE_GEMM
#define PROBE_GEMM 0
#endif
#ifndef PROBE_SYNC
#define PROBE_SYNC 0
#endif
#ifndef PROBE_EW
#define PROBE_EW 0
#endif
#ifndef MK_ONE_LAUNCH
#define MK_ONE_LAUNCH 1
#endif
constexpr int N_PHASES = 1 + 11 * 2;

using namespace mk;
__global__ void __launch_bounds__(512, 2) mk_fwd(Params p, int ph_lo, int ph_hi) {
    extern __shared__ __attribute__((aligned(16))) unsigned char lds_raw[];
    char* lds = (char*)lds_raw;
    PG8_LAS unsigned char* lds3 = (PG8_LAS unsigned char*)lds_raw;
    const int G = gridDim.x, NGW = G * 8;
#define FRESH() const int tid = fresh_tid(), lane = tid & 63, wave = __builtin_amdgcn_readfirstlane(tid >> 6), bid = fresh_bid(), gw = bid * 8 + wave; (void)lane; (void)gw; (void)bid
    unsigned char* ws = p.ws;
    bf16* H = (bf16*)(ws + WS_H); bf16* Z = (bf16*)(ws + WS_Z);
    int ph = 0;
#if MK_ONE_LAUNCH
    cg::grid_group grid = cg::this_grid();
    { volatile LAS unsigned* st0 = (volatile LAS unsigned*)(lds3 + LDS_BYTES - 64); if (threadIdx.x < 2) st0[threadIdx.x] = 0u; __syncthreads(); }
    XcdBarrier xbar = xcd_barrier_post((unsigned*)ws, (volatile LAS unsigned*)(lds3 + LDS_BYTES - 64));
#define SEAM() do { if (ph == 0) grid.sync(); else xcd_barrier(xbar); for (int q_ = 0; q_ < PROBE_SYNC; ++q_) xcd_barrier(xbar); ++ph; } while (0)
#else
#define SEAM() do { ++ph; } while (0)
#endif
#define RUN (ph >= ph_lo && ph < ph_hi)
    if (RUN) { FRESH();
_Pragma("nounroll") for (int rep = 0; rep < 1 + PROBE_EW; ++rep) {
#ifndef NO_CONV
 convert_weights(p, lds, gw, NGW, wave, lane);
#endif
 rms_to_bf16(p.in[0], p.in[1], H, gw, NGW, lane); } }
    SEAM();
    for (int l = 0; l < DEPTH; ++l) {
        const unsigned char* wb = ws + WS_W + (size_t)l * W_LAYER;
        const float* xin = l == 0 ? p.in[0] : p.out;
        if (RUN) { FRESH(); pg8::Gemm g{H, (const bf16*)(wb + OW_IN), M, NZ, D}; pg8::StaticOrder S; S.init(M, NZ, G, bid);
            pg8::EpiStore<0> E{Z, 512, 512, (size_t)M * 512};
_Pragma("nounroll") for (int rep = 0; rep < 1 + PROBE_GEMM; ++rep)
#ifndef NO_G1
pg8::gemm_phase<pg8::EpiStore<0>, pg8::StaticOrder, true, true>(lds3, g, S, E);
#endif
 }
        SEAM();
        if (RUN) { FRESH();
#ifndef NO_CMP
 for (int task = bid; task < 256; task += G) compress_task(p, l, task, lds);
#endif
#ifndef NO_ROPE
 rope_pass(p, gw, NGW, lane);
#endif
#ifndef NO_SCAN
 __syncthreads();
 for (int u = bid; u < 4096; u += G) { const int cc = u & 63, hh = (u >> 6) & 3, bb = (u >> 8) & 7; if (u < 2048) scan_prep<128, true>(p, l, bb, hh, cc, lds); else scan_prep<64, false>(p, l, bb, hh, cc, lds); }
#endif
 }
        SEAM();
        if (RUN) { FRESH();
_Pragma("nounroll")          for (int rep = 0; rep < 1 + PROBE_SCAN; ++rep) { const size_t sc_off7 = 0, sc_off8 = 0;
#ifndef NO_SCAN
            for (int u = bid; u < 256; u += G) { const int bb = (u & 127) >> 4, hh = (u & 15) >> 2, sl = u & 3; if (u < 128) scan_unit<128, true>(p, l, bb, hh, sl, lds, sc_off7); else scan_unit<64, false>(p, l, bb, hh, sl, lds, sc_off8); }
#endif
          }
_Pragma("nounroll")          for (int rep = 0; rep < 1 + PROBE_NSA; ++rep) { const size_t ns_off = 0;
#ifndef NO_NSA
            for (int vc = bid; vc < 256; vc += G) { const int bg = vc >> 4, s = vc & 15;
                for (int i = 0; i < 4; ++i) { const int qb = i == 0 ? 63 - s : (i == 1 ? 32 + s : (i == 2 ? 31 - s : s)); nsa_unit(p, bg, qb, lds, ns_off); } }
#endif
          }
        }
        SEAM();
        if (RUN) { FRESH(); finish_pass(p, l, gw, NGW, lane); }
        SEAM();
        if (RUN) { FRESH(); pg8::Gemm g{H, (const bf16*)(wb + OW_G), M, 3072, D}; pg8::StaticOrder S; S.init(M, 3072, G, bid);
            pg8::EpiStore<2> E{Z, 1024, 1024, (size_t)M * 1024};
_Pragma("nounroll") for (int rep = 0; rep < 1 + PROBE_GEMM; ++rep)
#ifndef NO_G2
pg8::gemm_phase<pg8::EpiStore<2>, pg8::StaticOrder, true, true>(lds3, g, S, E);
#endif
 }
        SEAM();
        if (RUN) { FRESH();
            pg8::StaticOrder S; S.init(M, D, G, bid);
_Pragma("nounroll") for (int rep = 0; rep < 1 + PROBE_GEMM; ++rep) {
            { pg8::Gemm g{Z + 7 * (SLAB / 2), (const bf16*)(wb + OW_BR), M, D, 512}; pg8::EpiBranch<true> E{H, Z};
#ifndef NO_G3
pg8::gemm_phase<pg8::EpiBranch<true>, pg8::StaticOrder, true, true>(lds3, g, S, E);
#endif
 }
            asm volatile("s_waitcnt vmcnt(0)" ::: "memory"); __syncthreads();
            { pg8::Gemm g{Z + 8 * (SLAB / 2), (const bf16*)(wb + OW_BR) + (size_t)D * 512, M, D, 512}; pg8::EpiBranch<false> E{H, Z + (size_t)M * 1024};
#ifndef NO_G4
pg8::gemm_phase<pg8::EpiBranch<false>, pg8::StaticOrder, true, true>(lds3, g, S, E);
#endif
 }
            asm volatile("s_waitcnt vmcnt(0)" ::: "memory"); __syncthreads();
            { pg8::Gemm g{Z + 9 * (SLAB / 2), (const bf16*)(wb + OW_BR) + (size_t)2 * D * 512, M, D, 512}; pg8::EpiBranch<false> E{H, Z + (size_t)2 * M * 1024};
#ifndef NO_G5
pg8::gemm_phase<pg8::EpiBranch<false>, pg8::StaticOrder, true, true>(lds3, g, S, E);
#endif
 }
            if (rep < PROBE_GEMM) { asm volatile("s_waitcnt vmcnt(0)" ::: "memory"); __syncthreads(); } }
        }
        SEAM();
        if (RUN) { FRESH(); pg8::Gemm g{H, (const bf16*)(wb + OW_OUT), M, D, D}; pg8::StaticOrder S; S.init(M, D, G, bid);
            pg8::EpiResid E{xin, p.out};
#ifndef NO_G6
pg8::gemm_phase<pg8::EpiResid, pg8::StaticOrder, true, true>(lds3, g, S, E);
#endif
 }
        SEAM();
        if (RUN) { FRESH(); _Pragma("nounroll") for (int rep = 0; rep < 1 + PROBE_EW; ++rep) rms_to_bf16(p.out, p.in[18] + l * D, H, gw, NGW, lane); }
        SEAM();
        if (RUN) { FRESH(); pg8::Gemm g{H, (const bf16*)(wb + OW_GU), M, 2 * FF, D}; pg8::StaticOrder S; S.init(M, 2 * FF, G, bid);
            pg8::EpiSwiGLU E{Z};
_Pragma("nounroll") for (int rep = 0; rep < 1 + PROBE_GEMM; ++rep)
#ifndef NO_G7
pg8::gemm_phase<pg8::EpiSwiGLU, pg8::StaticOrder, true, true>(lds3, g, S, E);
#endif
 }
        SEAM();
        if (RUN) { FRESH(); pg8::Gemm g{Z, (const bf16*)(wb + OW_D), M, D, FF}; pg8::StaticOrder S; S.init(M, D, G, bid);
            pg8::EpiResid E{p.out, p.out};
#ifndef NO_G8
pg8::gemm_phase<pg8::EpiResid, pg8::StaticOrder, true, true>(lds3, g, S, E);
#endif
 }
        SEAM();
        if (RUN) { FRESH(); if (l + 1 < DEPTH) rms_to_bf16(p.out, p.in[1] + (l + 1) * D, H, gw, NGW, lane); else rms_final(p.out, p.in[22], gw, NGW, lane); }
        if (l + 1 < DEPTH) SEAM();
    }
}

extern "C" void kernel_launch(void* const* d_in, const int* in_sizes, int n_in, void* d_out, int out_size, void* d_ws, size_t ws_size, hipStream_t stream) {
    static int grid = 0;
    if (grid == 0) {
        if (n_in != 23 || in_sizes[0] != M * D || out_size != M * D || ws_size < WS_NEED) { fprintf(stderr, "kernel_launch: unexpected shapes (n_in %d, in0 %d, out %d, ws %zu)\n", n_in, n_in > 0 ? in_sizes[0] : -1, out_size, ws_size); grid = -1; return; }
        int dev = 0, cus = 0, per_cu = 0;
        hipGetDevice(&dev); hipDeviceGetAttribute(&cus, hipDeviceAttributeMultiprocessorCount, dev);
        hipFuncSetAttribute((const void*)mk_fwd, hipFuncAttributeMaxDynamicSharedMemorySize, LDS_BYTES);
        hipOccupancyMaxActiveBlocksPerMultiprocessor(&per_cu, (const void*)mk_fwd, 512, LDS_BYTES);
        (void)hipGetLastError();
        if (per_cu < 1) per_cu = 1;
        grid = cus;
    }
    if (grid < 0) return;
    Params p{};
    for (int i = 0; i < 23; ++i) p.in[i] = (const float*)d_in[i];
    p.out = (float*)d_out; p.ws = (unsigned char*)d_ws;
#if MK_ONE_LAUNCH
    int lo = 0, hi = 1000;
    void* args[] = {&p, &lo, &hi};
    if (hipMemsetAsync(d_ws, 0, 65536, stream) != hipSuccess) { fprintf(stderr, "memset failed\n"); return; }
    hipError_t e = hipLaunchCooperativeKernel((const void*)mk_fwd, dim3(grid), dim3(512), args, LDS_BYTES, stream);
    if (e != hipSuccess) fprintf(stderr, "cooperative launch failed: %s (grid %d)\n", hipGetErrorString(e), grid);
#else
    for (int ph = 0; ph < N_PHASES; ++ph) hipLaunchKernelGGL(mk_fwd, dim3(grid), dim3(512), LDS_BYTES, stream, p, ph, ph + 1);
#endif
}
```

```cpp
#include <hip/hip_runtime.h>
#include <hip/hip_cooperative_groups.h>
#include <cstdio>
#include <cstdint>
namespace cg = cooperative_groups;
namespace pg8 {
#define PG8_LAS __attribute__((address_space(3)))
typedef unsigned short bf16_t;
typedef short bf16x8 __attribute__((ext_vector_type(8)));
typedef float f32x4 __attribute__((ext_vector_type(4)));
typedef unsigned u32x4 __attribute__((ext_vector_type(4)));
constexpr int BM = 256, BK = 64, HALF = 128, HTB = HALF * BK * 2  , STAGE_BYTES = 8 * HTB, NXCD = 8, WGM = 8;

__host__ __device__ __forceinline__ int lds_byte(int r, int c) { const int st = (r >> 4) * 2 + (c >> 5), rr = r & 15, cc = c & 31, ob = rr * 64 + cc * 2; return st * 1024 + (ob ^ (((ob >> 9) & 1) << 5)); }
__host__ __device__ __forceinline__ void stage_rc(int b, int& R, int& C) { const int st = b / 1024, sb = b % 1024, swz = sb ^ (((sb >> 9) & 1) << 5); R = (st >> 1) * 16 + swz / 64; C = (st & 1) * 32 + (swz % 64) / 2; }
__host__ __device__ __forceinline__ int perm32(int rho) { const int n = rho >> 4, i = rho & 15; return 8 * (i >> 2) + 4 * n + (i & 3); }

struct Unit { int pm, pn; };
struct Gemm { const bf16_t* A; const bf16_t* Bt; int M, N, K; };

struct StaticOrder {
    int nM, nN, nwg, G, c;
    __host__ __device__ void init(int M, int N, int G_, int c_) { nM = M / BM; nN = N / BM; nwg = nM * nN; G = G_; c = c_; }
    __host__ __device__ bool next(int i, Unit& u) const {
        const long L = (long)i * G + c; if (L >= nwg) return false;
        int wgid = (int)L; { const int q = nwg / NXCD, r = nwg % NXCD, xcd = wgid % NXCD, off = wgid / NXCD; wgid = (xcd < r ? xcd * (q + 1) : r * (q + 1) + (xcd - r) * q) + off; }
        const int nig = WGM * nN, gid = wgid / nig, fm = gid * WGM, gsz = (nM - fm) < WGM ? (nM - fm) : WGM;
        u.pm = fm + ((wgid % nig) % gsz); u.pn = (wgid % nig) / gsz; return true;
    }
    __device__ __forceinline__ void a_ready(const Unit&) const {}
    __device__ __forceinline__ void done(const Unit&) const {}
};

__device__ __forceinline__ unsigned cvt_pk_bf16(float lo, float hi) { unsigned r; asm volatile("v_cvt_pk_bf16_f32 %0, %1, %2" : "=v"(r) : "v"(lo), "v"(hi)); return r; }
typedef float f32x2 __attribute__((ext_vector_type(2)));
__device__ __forceinline__ f32x2 gelu_pk(f32x2 v) {
    const f32x2 av = __builtin_elementwise_abs(v), d = av * 0.2316418882f + 1.0f;
    f32x2 t; t.x = __builtin_amdgcn_rcpf(d.x); t.y = __builtin_amdgcn_rcpf(d.y);
    f32x2 q = t * 0.5307027145f + (-0.7265760135f); q = q * t + 0.7107068705f; q = q * t + (-0.142248368f); q = q * t + 0.127414796f; q = q * t;
    const f32x2 s = (v * v) * (-0.72134752044f);
    f32x2 e; e.x = __builtin_amdgcn_exp2f(s.x); e.y = __builtin_amdgcn_exp2f(s.y);
    const f32x2 m = v * (q * e), r = v - m;
    f32x2 o; o.x = v.x < 0.f ? m.x : r.x; o.y = v.y < 0.f ? m.y : r.y; return o;
}

template <int ACT  > struct EpiBf16 {
    static constexpr bool PERM = true, AFTER_DRAIN = false; static_assert(ACT == 0 || ACT == 1, "EpiBf16: ACT is 0 (none) or 1 (gelu_pk)");
    bf16_t* O; int ldc; const float* bias; int split_cols; size_t split_stride; float scale0;
    __device__ __forceinline__ void operator()(const f32x4 (&acc)[2][2][4][2], const Unit& u, int wr, int wc, int fr, int fq) const {
        const int row0 = u.pm * BM + wr * 64 + fr; int colt = u.pn * BM; bf16_t* base = O;
        float sc = 1.f; if (split_cols) { const int t = colt / split_cols; base += (size_t)t * split_stride; colt -= t * split_cols; if (t == 0) sc = scale0; }
        const int col0 = colt + wc * 32 + 8 * fq, bcol0 = u.pn * BM + wc * 32 + 8 * fq;
        f32x4 bv[2][2];
#pragma unroll
        for (int bj = 0; bj < 2; ++bj)
#pragma unroll
            for (int n = 0; n < 2; ++n) bv[bj][n] = bias ? *(const f32x4*)(bias + bcol0 + bj * HALF + 4 * n) : (f32x4){0.f, 0.f, 0.f, 0.f};
#pragma unroll
        for (int ai = 0; ai < 2; ++ai)
#pragma unroll
            for (int m = 0; m < 4; ++m) { bf16_t* rowp = base + (size_t)(row0 + ai * HALF + m * 16) * ldc + col0;
#pragma unroll
                for (int bj = 0; bj < 2; ++bj) { f32x4 v0 = acc[ai][bj][m][0] + bv[bj][0], v1 = acc[ai][bj][m][1] + bv[bj][1];
                    if (ACT == 1) { f32x2 a = gelu_pk((f32x2){v0[0], v0[1]}), b = gelu_pk((f32x2){v0[2], v0[3]}), c = gelu_pk((f32x2){v1[0], v1[1]}), d = gelu_pk((f32x2){v1[2], v1[3]});
                        v0 = (f32x4){a.x, a.y, b.x, b.y}; v1 = (f32x4){c.x, c.y, d.x, d.y}; }
                    v0 = v0 * sc; v1 = v1 * sc; u32x4 w; w.x = cvt_pk_bf16(v0[0], v0[1]); w.y = cvt_pk_bf16(v0[2], v0[3]); w.z = cvt_pk_bf16(v1[0], v1[1]); w.w = cvt_pk_bf16(v1[2], v1[3]);
                    *(u32x4*)(rowp + bj * HALF) = w; } }
    }
};
template <class Epi, class Sched, bool ALIGN_EPI = false, bool SP2 = false>
__device__ __forceinline__ void gemm_phase(PG8_LAS unsigned char* lds, const Gemm g, const Sched& S, const Epi& E) {
    int tid = threadIdx.x; asm volatile("" : "+v"(tid));
    const int wid = __builtin_amdgcn_readfirstlane(tid >> 6), lane = tid & 63, wr = wid >> 2, wc = wid & 3, fr = lane & 15, fq = lane >> 4;
    const int K = g.K, nt = K / BK;
    unsigned voffA[2], voffB[2];
#pragma unroll
    for (int i = 0; i < 2; ++i) { int R, C; stage_rc(tid * 16 + i * 8192, R, C); const int Rb = Epi::PERM ? ((R & ~31) + perm32(R & 31)) : R;
        voffA[i] = (unsigned)(R * K + C) * 2u; voffB[i] = (unsigned)(Rb * K + C) * 2u; }
    const size_t kstep = (size_t)(BK * 2);
    const size_t hstep = (size_t)HALF * K * 2;
    const size_t tstep = 2 * hstep;
    const unsigned ldsw = (unsigned)wid * 1024u;
    const int aoff = lds_byte(wr * 64 + fr, fq * 8), boff = lds_byte(wc * 32 + fr, fq * 8);
#define PG8_SA(b, h) (((b) * 2 + (h)) * HTB)
#define PG8_SB(b, h) ((4 + (b) * 2 + (h)) * HTB)
#define PG8_STAGE(bufoff, gbase, voff) do { _Pragma("unroll") for (int _i = 0; _i < 2; ++_i) \
        __builtin_amdgcn_global_load_lds((const unsigned*)((const char*)(gbase) + (voff)[_i]), (PG8_LAS unsigned*)(lds + (bufoff) + ldsw + _i * 8192), 16, 0, 0); } while (0)
#define PG8_LDA(dst, b, h) do { _Pragma("unroll") for (int m = 0; m < 4; ++m) _Pragma("unroll") for (int k = 0; k < 2; ++k) dst[m][k] = *(const PG8_LAS bf16x8*)(lds + PG8_SA(b, h) + aoff + m * 2048 + k * 1024); } while (0)
#define PG8_LDB(dst, b, h) do { _Pragma("unroll") for (int n = 0; n < 2; ++n) _Pragma("unroll") for (int k = 0; k < 2; ++k) dst[n][k] = *(const PG8_LAS bf16x8*)(lds + PG8_SB(b, h) + boff + n * 2048 + k * 1024); } while (0)
#define PG8_MMA(ai, bj, At, Bt) do { __builtin_amdgcn_s_setprio(1); _Pragma("unroll") for (int m = 0; m < 4; ++m) _Pragma("unroll") for (int n = 0; n < 2; ++n) _Pragma("unroll") for (int k = 0; k < 2; ++k) \
        acc[ai][bj][m][n] = __builtin_amdgcn_mfma_f32_16x16x32_bf16(Bt[n][k], At[m][k], acc[ai][bj][m][n], 0, 0, 0); __builtin_amdgcn_s_setprio(0); } while (0)
#define PG8_WAIT_V(n) asm volatile("s_waitcnt vmcnt(" #n ")" ::: "memory")
#define PG8_WAIT_L(n) asm volatile("s_waitcnt lgkmcnt(" #n ")" ::: "memory")
#define PG8_BAR __builtin_amdgcn_s_barrier()
#define PG8_SCHED __builtin_amdgcn_sched_barrier(0)
    Unit cur, nxt; int ui = 0;
    if (!S.next(0, cur)) return;
    f32x4 acc[2][2][4][2];
#pragma unroll
    for (int a = 0; a < 2; ++a)
#pragma unroll
        for (int b = 0; b < 2; ++b)
#pragma unroll
            for (int m = 0; m < 4; ++m)
#pragma unroll
                for (int n = 0; n < 2; ++n) acc[a][b][m][n] = (f32x4){0.f, 0.f, 0.f, 0.f};
    bf16x8 At[4][2], B0[2][2], B1[2][2];
    const char* cA = (const char*)g.A + (size_t)cur.pm * tstep; const char* cB = (const char*)g.Bt + (size_t)cur.pn * tstep;
    S.a_ready(cur);
    if constexpr (SP2) {
        PG8_STAGE(PG8_SB(0, 0), cB, voffB); PG8_STAGE(PG8_SB(0, 1), cB + hstep, voffB); PG8_STAGE(PG8_SA(0, 0), cA, voffA); PG8_STAGE(PG8_SA(0, 1), cA + hstep, voffA);
        if (wr == 1) PG8_BAR;
        PG8_WAIT_V(2); PG8_BAR;
        PG8_STAGE(PG8_SB(1, 0), cB + kstep, voffB); PG8_STAGE(PG8_SA(1, 0), cA + kstep, voffA); PG8_STAGE(PG8_SB(1, 1), cB + hstep + kstep, voffB);
        PG8_WAIT_V(6); PG8_BAR;
    } else {
        PG8_STAGE(PG8_SB(0, 0), cB, voffB); PG8_STAGE(PG8_SA(0, 0), cA, voffA); PG8_STAGE(PG8_SB(0, 1), cB + hstep, voffB); PG8_STAGE(PG8_SA(0, 1), cA + hstep, voffA);
        if (wr == 1) PG8_BAR;
        PG8_WAIT_V(4); PG8_BAR;
        PG8_STAGE(PG8_SB(1, 0), cB + kstep, voffB); PG8_STAGE(PG8_SA(1, 0), cA + kstep, voffA); PG8_STAGE(PG8_SB(1, 1), cB + hstep + kstep, voffB);
        PG8_WAIT_V(6); PG8_BAR;
    }
    for (;;) {
        const bool has_next = S.next(ui + 1, nxt);
        const char* nA = has_next ? (const char*)g.A + (size_t)nxt.pm * tstep : cA; const char* nB = has_next ? (const char*)g.Bt + (size_t)nxt.pn * tstep : cB;
        for (int t = 0; t < nt; t += 2) {
            const bool last = (t == nt - 2);
            const char* a1 = cA + (size_t)(t + 1) * kstep;
            const char* a2 = last ? nA : cA + (size_t)(t + 2) * kstep; const char* b2 = last ? nB : cB + (size_t)(t + 2) * kstep;
            const char* a3 = a2 + kstep; const char* b3 = b2 + kstep;
            if (last && has_next) S.a_ready(nxt);
            if constexpr (SP2) {
            PG8_LDB(B0, 0, 0); PG8_LDB(B1, 0, 1); PG8_SCHED; PG8_LDA(At, 0, 0); PG8_STAGE(PG8_SA(1, 1), a1 + hstep, voffA);
            PG8_WAIT_V(8); PG8_WAIT_L(0); PG8_BAR; PG8_MMA(0, 0, At, B0); PG8_MMA(0, 1, At, B1); PG8_BAR; PG8_SCHED;
            PG8_LDA(At, 0, 1); PG8_STAGE(PG8_SB(0, 0), b2, voffB); PG8_STAGE(PG8_SB(0, 1), b2 + hstep, voffB); PG8_STAGE(PG8_SA(0, 0), a2, voffA);
            PG8_WAIT_V(8); PG8_WAIT_L(0); PG8_BAR; PG8_MMA(1, 0, At, B0); PG8_MMA(1, 1, At, B1); PG8_BAR; PG8_SCHED;
            PG8_LDB(B0, 1, 0); PG8_LDB(B1, 1, 1); PG8_SCHED; PG8_LDA(At, 1, 0); PG8_STAGE(PG8_SA(0, 1), a2 + hstep, voffA);
            PG8_WAIT_V(8); PG8_WAIT_L(0); PG8_BAR; PG8_MMA(0, 0, At, B0); PG8_MMA(0, 1, At, B1); PG8_BAR; PG8_SCHED;
            PG8_LDA(At, 1, 1); PG8_STAGE(PG8_SB(1, 0), b3, voffB); PG8_STAGE(PG8_SB(1, 1), b3 + hstep, voffB); PG8_STAGE(PG8_SA(1, 0), a3, voffA);
            PG8_WAIT_V(8); PG8_WAIT_L(0); PG8_BAR; PG8_MMA(1, 0, At, B0); PG8_MMA(1, 1, At, B1); PG8_BAR; PG8_SCHED;
            } else {
            PG8_LDB(B0, 0, 0); PG8_SCHED; PG8_LDA(At, 0, 0); PG8_STAGE(PG8_SA(1, 1), a1 + hstep, voffA);
            PG8_WAIT_L(8); PG8_BAR; PG8_WAIT_L(0); PG8_MMA(0, 0, At, B0); PG8_BAR; PG8_SCHED;
            PG8_LDB(B1, 0, 1); PG8_STAGE(PG8_SB(0, 0), b2, voffB);
            PG8_BAR; PG8_WAIT_L(0); PG8_MMA(0, 1, At, B1); PG8_BAR;
            PG8_LDA(At, 0, 1); PG8_STAGE(PG8_SA(0, 0), a2, voffA);
            PG8_BAR; PG8_WAIT_L(0); PG8_MMA(1, 0, At, B0); PG8_BAR; PG8_SCHED;
            PG8_STAGE(PG8_SB(0, 1), b2 + hstep, voffB);
            PG8_WAIT_V(6); PG8_BAR; PG8_MMA(1, 1, At, B1); PG8_BAR;
            PG8_LDB(B0, 1, 0); PG8_SCHED; PG8_LDA(At, 1, 0); PG8_STAGE(PG8_SA(0, 1), a2 + hstep, voffA);
            PG8_WAIT_L(8); PG8_BAR; PG8_WAIT_L(0); PG8_MMA(0, 0, At, B0); PG8_BAR; PG8_SCHED;
            PG8_LDB(B1, 1, 1); PG8_STAGE(PG8_SB(1, 0), b3, voffB);
            PG8_BAR; PG8_WAIT_L(0); PG8_MMA(0, 1, At, B1); PG8_BAR;
            PG8_LDA(At, 1, 1); PG8_STAGE(PG8_SA(1, 0), a3, voffA);
            PG8_BAR; PG8_WAIT_L(0); PG8_MMA(1, 0, At, B0); PG8_BAR; PG8_SCHED;
            PG8_STAGE(PG8_SB(1, 1), b3 + hstep, voffB);
            PG8_WAIT_V(6); PG8_BAR; PG8_MMA(1, 1, At, B1); PG8_BAR;
            }
        }
        if constexpr (ALIGN_EPI) { if (wr == 0) PG8_BAR; }
        if constexpr (!Epi::AFTER_DRAIN) { E(acc, cur, wr, wc, fr, fq); S.done(cur); }
        if (!has_next) break;
#pragma unroll
        for (int a = 0; a < 2; ++a)
#pragma unroll
            for (int b = 0; b < 2; ++b)
#pragma unroll
                for (int m = 0; m < 4; ++m)
#pragma unroll
                    for (int n = 0; n < 2; ++n) acc[a][b][m][n] = (f32x4){0.f, 0.f, 0.f, 0.f};
        cur = nxt; cA = nA; cB = nB; ++ui;
        if constexpr (ALIGN_EPI) { if (wr == 1) PG8_BAR; }
    }
    PG8_WAIT_V(0);
    if constexpr (!ALIGN_EPI) { if (wr == 0) PG8_BAR; }
    PG8_BAR;
    if constexpr (Epi::AFTER_DRAIN) { E.fused(acc, cur, wr, wc, fr, fq, lds, wid, lane); S.done(cur); }
#undef PG8_SA
#undef PG8_SB
#undef PG8_STAGE
#undef PG8_LDA
#undef PG8_LDB
#undef PG8_MMA
#undef PG8_WAIT_V
#undef PG8_WAIT_L
#undef PG8_BAR
#undef PG8_SCHED
}
}

namespace mk {
typedef unsigned short bf16;
typedef short bf16x8 __attribute__((ext_vector_type(8)));
typedef float f32x16 __attribute__((ext_vector_type(16)));
typedef float f32x4 __attribute__((ext_vector_type(4)));
typedef unsigned u32x4 __attribute__((ext_vector_type(4)));
typedef unsigned u32x2 __attribute__((ext_vector_type(2)));

constexpr int BATCH = 8, T = 4096, D = 1024, M = BATCH * T, DEPTH = 2, INC = 7976, FF = 2816, NZ = 5120;
constexpr size_t MiB = 1u << 20;
constexpr size_t WS_W = 1 * MiB, W_LAYER = 40 * MiB;
constexpr size_t OW_IN = 0, OW_G = 10 * MiB, OW_BR = 16 * MiB, OW_OUT = 19 * MiB, OW_GU = 21 * MiB, OW_D = 32 * MiB,
                 OW_C1K = 38 * MiB, OW_C1V = 38 * MiB + 512 * 1024, OW_C2K = 39 * MiB, OW_C2V = 39 * MiB + 256 * 1024;
constexpr size_t WS_KC = 81 * MiB, WS_VC = WS_KC + 512 * 1024;
constexpr size_t WS_H = 82 * MiB, WS_Z = 146 * MiB, SLAB = 32 * MiB, WS_END = WS_Z + 10 * SLAB;
constexpr int LDS_BYTES = 147456;
constexpr float C2 = 0.18033688011112042f;

struct Params { const float* in[23]; float* out; unsigned char* ws; };

__device__ __forceinline__ float bf2f(bf16 v) { return __uint_as_float(((unsigned)v) << 16); }
__device__ __forceinline__ unsigned f2bf(float f) { unsigned u = __float_as_uint(f); return (u + 0x7fffu + ((u >> 16) & 1u)) >> 16; }
__device__ __forceinline__ unsigned pk2(float lo, float hi) { return f2bf(lo) | (f2bf(hi) << 16); }
__device__ __forceinline__ float lo16(unsigned w) { return __uint_as_float(w << 16); }
__device__ __forceinline__ float hi16(unsigned w) { return __uint_as_float(w & 0xffff0000u); }
__device__ __forceinline__ f32x16 mfma32(bf16x8 a, bf16x8 b, f32x16 c) { return __builtin_amdgcn_mfma_f32_32x32x16_bf16(a, b, c, 0, 0, 0); }
__device__ __forceinline__ int crow(int r, int hi) { return (r & 3) + 8 * (r >> 2) + 4 * hi; }
__device__ __forceinline__ float wave_sum(float v) {
#pragma unroll
    for (int o = 1; o < 64; o <<= 1) v += __shfl_xor(v, o);
    return v;
}
__device__ __forceinline__ float sigmoidf_(float x) { return 1.f / (1.f + __expf(-x)); }
__device__ __forceinline__ float siluf_(float x) { return x / (1.f + __expf(-x)); }
#define LDS_WAIT() asm volatile("s_waitcnt lgkmcnt(0)" ::: "memory")
__device__ __forceinline__ int fresh_tid() { int t = threadIdx.x; asm volatile("" : "+v"(t)); return t; }
__device__ __forceinline__ int fresh_bid() { int t = blockIdx.x; asm volatile("" : "+s"(t)); return t; }

template <class F>
__device__ __forceinline__ void wt_convert(F colptr, int ld, int K, int N, bf16* WT, float* scr, int gw, int NGW, int lane) {
    const int nblk = N / 32, nitems = (K / 64) * nblk;
    for (int it = gw; it < nitems; it += NGW) {
        const int kb = it / nblk, nb = it % nblk, k0 = 64 * kb, n0 = 32 * nb;
        const float* cp = colptr(n0 + 4 * (lane & 7));
        f32x4 v[8];
#pragma unroll
        for (int i = 0; i < 8; ++i) { const int kk = (lane >> 3) + 8 * i; v[i] = cp ? *(const f32x4*)(cp + (size_t)(k0 + kk) * ld) : (f32x4){0.f, 0.f, 0.f, 0.f}; }
#pragma unroll
        for (int i = 0; i < 8; ++i) { const int kk = (lane >> 3) + 8 * i; float* s = scr + kk * 33 + 4 * (lane & 7); s[0] = v[i].x; s[1] = v[i].y; s[2] = v[i].z; s[3] = v[i].w; }
        LDS_WAIT();
        const int c = lane & 7;
#pragma unroll
        for (int j = 0; j < 4; ++j) {
            const int n = (lane >> 3) + 8 * j; const float* s = scr + (8 * c) * 33 + n;
            u32x4 o; o.x = pk2(s[0 * 33], s[1 * 33]); o.y = pk2(s[2 * 33], s[3 * 33]); o.z = pk2(s[4 * 33], s[5 * 33]); o.w = pk2(s[6 * 33], s[7 * 33]);
            *(u32x4*)(WT + (size_t)(n0 + n) * K + k0 + 8 * c) = o;
        }
        LDS_WAIT();
    }
}

__device__ __forceinline__ void convert_weights(const Params& p, char* lds, int gw, int NGW, int wave, int lane) {
    float* scr = (float*)(lds + wave * 8448);
    for (int l = 0; l < DEPTH; ++l) {
        unsigned char* wb = p.ws + WS_W + (size_t)l * W_LAYER;
        const float* win = p.in[2] + (size_t)l * D * INC;
        wt_convert([=](int n) -> const float* {
            const int s = n >> 9, c = n & 511; int src;
            switch (s) { case 0: src = c; break; case 1: src = 512 + c; break; case 2: src = 1536 + c; break; case 3: src = 2048 + c; break; case 4: src = 3088 + c; break;
                         case 5: src = 4112 + c; break; case 6: src = c < 256 ? 4624 + c : (c < 272 ? 3072 + (c - 256) : (c < 296 ? 4880 + (c - 272) : -1)); break;
                         case 7: src = 1024 + c; break; case 8: src = 2560 + c; break; default: src = 3600 + c; break; }
            return src < 0 ? nullptr : win + src; }, INC, D, NZ, (bf16*)(wb + OW_IN), scr, gw, NGW, lane);
        wt_convert([=](int n) -> const float* { return win + 4904 + n; }, INC, D, 3072, (bf16*)(wb + OW_G), scr, gw, NGW, lane);
        for (int b = 0; b < 3; ++b) { const float* w = p.in[14 + b] + (size_t)l * 512 * D;
            wt_convert([=](int n) -> const float* { return w + n; }, D, 512, D, (bf16*)(wb + OW_BR) + (size_t)b * D * 512, scr, gw, NGW, lane); }
        { const float* w = p.in[17] + (size_t)l * D * D; wt_convert([=](int n) -> const float* { return w + n; }, D, D, D, (bf16*)(wb + OW_OUT), scr, gw, NGW, lane); }
        { const float* wg = p.in[19] + (size_t)l * D * FF; const float* wu = p.in[20] + (size_t)l * D * FF;
          wt_convert([=](int n) -> const float* { const int j = n >> 8, i = n & 255; return i < 128 ? wg + 128 * j + i : wu + 128 * j + (i - 128); }, FF, D, 2 * FF, (bf16*)(wb + OW_GU), scr, gw, NGW, lane); }
        { const float* w = p.in[21] + (size_t)l * FF * D; wt_convert([=](int n) -> const float* { return w + n; }, D, FF, D, (bf16*)(wb + OW_D), scr, gw, NGW, lane); }
        { const float* w = p.in[10] + (size_t)l * 2048 * 128; wt_convert([=](int n) -> const float* { return w + n; }, 128, 2048, 128, (bf16*)(wb + OW_C1K), scr, gw, NGW, lane); }
        { const float* w = p.in[12] + (size_t)l * 2048 * 128; wt_convert([=](int n) -> const float* { return w + n; }, 128, 2048, 128, (bf16*)(wb + OW_C1V), scr, gw, NGW, lane); }
        { const float* w = p.in[11] + (size_t)l * 128 * 64; wt_convert([=](int n) -> const float* { return w + n; }, 64, 128, 64, (bf16*)(wb + OW_C2K), scr, gw, NGW, lane); }
        { const float* w = p.in[13] + (size_t)l * 128 * 64; wt_convert([=](int n) -> const float* { return w + n; }, 64, 128, 64, (bf16*)(wb + OW_C2V), scr, gw, NGW, lane); }
    }
}

__device__ __forceinline__ void rms_to_bf16(const float* x, const float* g, bf16* out, int gw, int NGW, int lane) {
    f32x4 gg[4];
#pragma unroll
    for (int j = 0; j < 4; ++j) gg[j] = ((const f32x4*)g)[lane + 64 * j];
    for (int m = 2 * gw; m < M; m += 2 * NGW) {
        const f32x4* xr = (const f32x4*)(x + (size_t)m * D) + lane; f32x4 v[8]; float s0 = 0.f, s1 = 0.f;
#pragma unroll
        for (int j = 0; j < 8; ++j) v[j] = xr[64 * j];
#pragma unroll
        for (int j = 0; j < 4; ++j) { s0 += (v[j].x * v[j].x + v[j].y * v[j].y) + (v[j].z * v[j].z + v[j].w * v[j].w); s1 += (v[4 + j].x * v[4 + j].x + v[4 + j].y * v[4 + j].y) + (v[4 + j].z * v[4 + j].z + v[4 + j].w * v[4 + j].w); }
        const float r0 = rsqrtf(wave_sum(s0) * (1.f / D) + 1e-6f), r1 = rsqrtf(wave_sum(s1) * (1.f / D) + 1e-6f);
        u32x2* o = (u32x2*)(out + (size_t)m * D) + lane;
#pragma unroll
        for (int j = 0; j < 8; ++j) { const float r = j < 4 ? r0 : r1; const f32x4 g4 = gg[j & 3]; u32x2 w; w.x = pk2(v[j].x * r * g4.x, v[j].y * r * g4.y); w.y = pk2(v[j].z * r * g4.z, v[j].w * r * g4.w); o[64 * j] = w; }
    }
}
__device__ __forceinline__ void rms_final(float* x, const float* g, int gw, int NGW, int lane) {
    for (int m = gw; m < M; m += NGW) {
        f32x4* xr = (f32x4*)(x + (size_t)m * D) + lane; f32x4 v[4]; float s = 0.f;
#pragma unroll
        for (int j = 0; j < 4; ++j) { v[j] = xr[64 * j]; s += (v[j].x * v[j].x + v[j].y * v[j].y) + (v[j].z * v[j].z + v[j].w * v[j].w); }
        const float r = rsqrtf(wave_sum(s) * (1.f / D) + 1e-6f);
#pragma unroll
        for (int j = 0; j < 4; ++j) { const f32x4 gg = ((const f32x4*)g)[lane + 64 * j]; xr[64 * j] = v[j] * r * gg; }
    }
}

__device__ __forceinline__ float inv_freq(int i) {
    switch (i) { case 0: return 1.0f; case 1: return 0.19392274474868576f; case 2: return 0.03760603093086393f; case 3: return 0.007292664737217109f;
                 case 4: return 0.001414213562373095f; case 5: return 0.0002742481756762073f; case 6: return 5.318295896944988e-05f; default: return 1.031338537721246e-05f; }
}
__device__ __forceinline__ void rope_cs(int t, int i, float& c, float& s) {
    const float ang = (float)t * inv_freq(i);
    const double rev = (double)ang * 0.15915494309189535; const float fr = (float)(rev - floor(rev));
    s = __builtin_amdgcn_sinf(fr); c = __builtin_amdgcn_cosf(fr);
}

__device__ __forceinline__ void rope_pass(const Params& p, int gw, int NGW, int lane) {
    bf16* Z = (bf16*)(p.ws + WS_Z);
    bf16* q = Z + 9 * (SLAB / 2); bf16* s5 = Z + 5 * (SLAB / 2); bf16* s6 = Z + 6 * (SLAB / 2);
    for (int m = gw; m < M; m += NGW) {
        const int t = m & (T - 1);
        float cl, sl; rope_cs(t, lane & 7, cl, sl);
        float cs[8], sn[8];
#pragma unroll
        for (int i = 0; i < 8; ++i) { cs[i] = __shfl(cl, i); sn[i] = __shfl(sl, i); }
        const int ch = lane & 7;
        {
            u32x4* ptr = (u32x4*)(q + (size_t)m * 512 + 8 * lane); const u32x4 w = *ptr; float v[8], o[8];
#pragma unroll
            for (int e = 0; e < 4; ++e) { v[2 * e] = lo16(w[e]); v[2 * e + 1] = hi16(w[e]); }
#pragma unroll
            for (int e = 0; e < 8; ++e) { const float pv = __shfl_xor(v[e], 1); o[e] = ch == 0 ? v[e] * cs[e] - pv * sn[e] : (ch == 1 ? v[e] * cs[e] + pv * sn[e] : v[e]); o[e] *= C2; }
            u32x4 r; r.x = pk2(o[0], o[1]); r.y = pk2(o[2], o[3]); r.z = pk2(o[4], o[5]); r.w = pk2(o[6], o[7]); *ptr = r;
        }
        {
            bf16* base = lane < 16 ? s5 + (size_t)m * 512 + 256 + 8 * lane : s6 + (size_t)m * 512 + 8 * (lane - 16);
            u32x4* ptr = (u32x4*)base; u32x4 w = (u32x4){0u, 0u, 0u, 0u}; if (lane < 32) w = *ptr; float v[8], o[8];
#pragma unroll
            for (int e = 0; e < 4; ++e) { v[2 * e] = lo16(w[e]); v[2 * e + 1] = hi16(w[e]); }
#pragma unroll
            for (int e = 0; e < 8; ++e) { const float pv = __shfl_xor(v[e], 1); o[e] = ch == 0 ? v[e] * cs[e] - pv * sn[e] : (ch == 1 ? v[e] * cs[e] + pv * sn[e] : v[e]); }
            u32x4 r; r.x = pk2(o[0], o[1]); r.y = pk2(o[2], o[3]); r.z = pk2(o[4], o[5]); r.w = pk2(o[6], o[7]); if (lane < 32) *ptr = r;
        }
    }
}

__device__ __forceinline__ float gelu_tanh(float x) { const float u = 0.7978845608028654f * (x + 0.044715f * x * x * x); const float e = __expf(2.f * u); const float th = 1.f - 2.f / (e + 1.f); return 0.5f * x * (1.f + th); }
__device__ __forceinline__ void compress_task(const Params& p, int layer, int task, char* lds) {
    const int tid = fresh_tid(), lane = tid & 63, w = __builtin_amdgcn_readfirstlane(tid >> 6), r32 = lane & 31, hi = lane >> 5;
    const int kind = task >> 7, rg = task & 127;
    const bf16* s5 = (const bf16*)(p.ws + WS_Z) + 5 * (SLAB / 2);
    const unsigned char* wb = p.ws + WS_W + (size_t)layer * W_LAYER;
    const bf16* w1T = (const bf16*)(wb + (kind ? OW_C1V : OW_C1K)); const bf16* w2T = (const bf16*)(wb + (kind ? OW_C2V : OW_C2K));
    const float* pos = p.in[kind ? 9 : 8] + (size_t)layer * 32 * 64;
    bf16* dst = (bf16*)(p.ws + (kind ? WS_VC : WS_KC));
    float* red = (float*)lds;
    bf16* hid = (bf16*)(lds + 131072);
    const int id = 32 * rg + r32; const bool valid = id < 4080; const int bg = valid ? id / 255 : 0, n = valid ? id % 255 : 0;
    const int b = bg >> 1, g = bg & 1;
    f32x16 acc[4];
#pragma unroll
    for (int i = 0; i < 4; ++i) acc[i] = (f32x16){};
    for (int s = 16 * w; s < 16 * w + 16; ++s) {
        const int j = s >> 2, d0 = 16 * (s & 3) + 8 * hi, tpos = 16 * n + j;
        const u32x4 wz = *(const u32x4*)(s5 + (size_t)(b * T + tpos) * 512 + kind * 128 + g * 64 + d0);
        float v[8];
#pragma unroll
        for (int e = 0; e < 4; ++e) { v[2 * e] = lo16(wz[e]); v[2 * e + 1] = hi16(wz[e]); }
        if (kind == 0 && (s & 3) == 0) {
#pragma unroll
            for (int e = 0; e < 8; ++e) { float c, sn; rope_cs(tpos, e, c, sn); const float pv = __shfl_xor(v[e], 32); v[e] = hi == 0 ? v[e] * c - pv * sn : v[e] * c + pv * sn; }
        }
        const f32x4 p0 = *(const f32x4*)(pos + j * 64 + d0), p1 = *(const f32x4*)(pos + j * 64 + d0 + 4);
        v[0] += p0.x; v[1] += p0.y; v[2] += p0.z; v[3] += p0.w; v[4] += p1.x; v[5] += p1.y; v[6] += p1.z; v[7] += p1.w;
        u32x4 aw; aw.x = pk2(v[0], v[1]); aw.y = pk2(v[2], v[3]); aw.z = pk2(v[4], v[5]); aw.w = pk2(v[6], v[7]);
        if (!valid) aw = (u32x4){0u, 0u, 0u, 0u};
        const bf16x8 a = __builtin_bit_cast(bf16x8, aw);
#pragma unroll
        for (int nb = 0; nb < 4; ++nb) { const bf16x8 bb = *(const bf16x8*)(w1T + (size_t)(32 * nb + r32) * 2048 + 16 * s + 8 * hi); acc[nb] = mfma32(a, bb, acc[nb]); }
    }
#pragma unroll
    for (int nb = 0; nb < 4; ++nb)
#pragma unroll
        for (int r = 0; r < 16; ++r) red[(w * 32 + crow(r, hi)) * 128 + 32 * nb + r32] = acc[nb][r];
    __syncthreads();
    for (int e = tid; e < 4096; e += 512) { float s = 0.f;
#pragma unroll
        for (int ww = 0; ww < 8; ++ww) s += red[ww * 4096 + e];
        hid[(e >> 7) * 136 + (e & 127)] = (bf16)f2bf(gelu_tanh(s)); }
    __syncthreads();
    if (w < 2) {
        f32x16 o = (f32x16){};
#pragma unroll
        for (int s = 0; s < 8; ++s) { const bf16x8 a = *(const bf16x8*)(hid + r32 * 136 + 16 * s + 8 * hi); const bf16x8 bb = *(const bf16x8*)(w2T + (size_t)(32 * w + r32) * 128 + 16 * s + 8 * hi); o = mfma32(a, bb, o); }
#pragma unroll
        for (int r = 0; r < 16; ++r) { const int id2 = 32 * rg + crow(r, hi); if (id2 < 4080) { const int bg2 = id2 / 255, n2 = id2 % 255; dst[((size_t)bg2 * 256 + n2) * 64 + 32 * w + r32] = (bf16)f2bf(o[r]); } }
    }
    __syncthreads();
}

constexpr size_t WS_PB = WS_END, WS_DEC = WS_END + 32 * MiB, WS_NEED = WS_END + 34 * MiB;
template <int DK, bool HG>
__device__ __forceinline__ void scan_prep(const Params& p, int layer, int b, int h, int c, char* lds) {
    constexpr int PARTS = 512 / DK, TP = 64 / PARTS, QS = DK + 8;
    const int tid = fresh_tid(), lane = tid & 63, w = __builtin_amdgcn_readfirstlane(tid >> 6), r32 = lane & 31, hi = lane >> 5;
    bf16* qe = (bf16*)lds; bf16* ke = qe + 64 * QS; bf16* keT = ke + 64 * QS; bf16* P = keT + DK * 72; float* tot = (float*)(P + 64 * 72);
    bf16* Z = (bf16*)(p.ws + WS_Z);
    const int d = tid % DK, part = tid / DK;
    bf16 *qsrc, *ksrc; const bf16* glr = Z + 6 * (SLAB / 2) + 256;
    float lb = 0.f, bias = 0.f, w2c[16];
    if (HG) {
        qsrc = Z + 0 * (SLAB / 2) + h * 128; ksrc = Z + 1 * (SLAB / 2) + h * 128;
        if (layer == 1) { const float l0 = p.in[3][h * 128 + d], l1 = p.in[3][512 + h * 128 + d]; lb = 1.f / (1.f + __expf(l0 - l1)); }
#pragma unroll
        for (int j = 0; j < 16; ++j) w2c[j] = 0.f;
    } else {
        qsrc = Z + 3 * (SLAB / 2) + h * 64; ksrc = Z + 3 * (SLAB / 2) + 256 + h * 64;
        bias = p.in[6][layer * 256 + h * 64 + d];
#pragma unroll
        for (int j = 0; j < 16; ++j) w2c[j] = p.in[5][(size_t)layer * 16 * 256 + j * 256 + h * 64 + d];
    }
    const size_t m0 = (size_t)b * T + 64 * c;
    float gl[TP], qv[TP], kv[TP]; float run = 0.f;
#pragma unroll
    for (int ii = 0; ii < TP; ++ii) {
        const size_t row = m0 + part * TP + ii;
        const float xq = bf2f(qsrc[row * 512 + d]), xk = bf2f(ksrc[row * 512 + d]);
        float g;
        if (HG) { const float ex = __expf(-xk); const float sg = 1.f / (1.f + ex); const float f = lb + (1.f - lb) * sg; g = __logf(f); kv[ii] = (1.f - lb) * ex * sg; qv[ii] = siluf_(xq); }
        else { float u = bias; const u32x4 g0 = *(const u32x4*)(glr + row * 512), g1 = *(const u32x4*)(glr + row * 512 + 8);
#pragma unroll
            for (int e = 0; e < 4; ++e) { u += lo16(g0[e]) * w2c[2 * e] + hi16(g0[e]) * w2c[2 * e + 1]; u += lo16(g1[e]) * w2c[8 + 2 * e] + hi16(g1[e]) * w2c[8 + 2 * e + 1]; }
            g = (fminf(u, 0.f) - __logf(1.f + __expf(-fabsf(u)))) * (1.f / 16.f); kv[ii] = xk; qv[ii] = xq * 0.125f; }
        run += g; gl[ii] = run;
    }
    tot[part * DK + d] = run;
    __syncthreads();
    float off = 0.f, total = 0.f;
#pragma unroll
    for (int pp = 0; pp < PARTS; ++pp) { const float tv = tot[pp * DK + d]; total += tv; if (pp < part) off += tv; }
    if (part == 0) ((float*)(p.ws + WS_DEC + (HG ? 0 : MiB)))[(size_t)((b * 4 + h) * 64 + c) * DK + d] = __expf(total);
#pragma unroll
    for (int ii = 0; ii < TP; ++ii) {
        const int i = part * TP + ii; const float bb = off + gl[ii];
        const float eq = __expf(fminf(bb - total, 80.f)), ek = __expf(total - bb);
        const bf16 qb16 = (bf16)f2bf(qv[ii] * eq), kb16 = (bf16)f2bf(kv[ii] * ek);
        qe[i * QS + d] = qb16; ke[i * QS + d] = kb16; keT[d * 72 + i] = kb16;
    }
    __syncthreads();
    if (w >= 4 && w < 7) {
        const int ti = w == 4 ? 0 : 1, si = w == 6 ? 1 : 0;
        f32x16 sc = (f32x16){};
#pragma unroll
        for (int ks = 0; ks < DK / 16; ++ks) { const bf16x8 a = *(const bf16x8*)(qe + (32 * ti + r32) * QS + 16 * ks + 8 * hi); const bf16x8 bb = *(const bf16x8*)(ke + (32 * si + r32) * QS + 16 * ks + 8 * hi); sc = mfma32(a, bb, sc); }
#pragma unroll
        for (int r = 0; r < 16; ++r) { const int tt = 32 * ti + crow(r, hi), ss = 32 * si + r32; P[tt * 72 + ss] = (ss <= tt) ? (bf16)f2bf(sc[r]) : (bf16)0; }
    } else if (w == 7) {
#pragma unroll
        for (int r = 0; r < 16; ++r) P[crow(r, hi) * 72 + 32 + r32] = (bf16)0;
    } else {
        const int t4 = tid;
        for (int q = t4; q < 64 * (DK / 8); q += 256) { const int row = q / (DK / 8), ch = q % (DK / 8); *(u32x4*)(qsrc + (m0 + row) * 512 + 8 * ch) = *(const u32x4*)(qe + row * QS + 8 * ch); }
        for (int q = t4; q < DK * 8; q += 256) { const int dd = q >> 3, ch = q & 7;
            bf16* dst = HG ? ksrc + (m0 + (dd >> 1)) * 512 + (dd & 1) * 64 + 8 * ch : ksrc + (m0 + dd) * 512 + 8 * ch;
            *(u32x4*)dst = *(const u32x4*)(keT + dd * 72 + 8 * ch); }
    }
    __syncthreads();
    { bf16* PB = (bf16*)(p.ws + WS_PB) + (HG ? 0 : (size_t)M * 256); const int t = tid >> 3, ch = tid & 7; *(u32x4*)(PB + (m0 + t) * 256 + h * 64 + 8 * ch) = *(const u32x4*)(P + t * 72 + 8 * ch); }
    __syncthreads();
}

template <int DK, bool HG>
__device__ __forceinline__ void scan_unit(const Params& p, int layer, int b, int h, int slice, char* lds, size_t dst_off) {
    constexpr int QS = DK + 8, NTS = DK / 32, NQ = (64 * DK / 8) / 512;
    constexpr int BUF = 64 * QS * 2 + DK * 72 * 2 + 64 * 72 * 2 + 32 * 72 * 2 + DK * 4;
    const int tid = fresh_tid(), lane = tid & 63, w = __builtin_amdgcn_readfirstlane(tid >> 6), r32 = lane & 31, hi = lane >> 5;
    bf16* ST = (bf16*)(lds + 2 * BUF);
    bf16* Z = (bf16*)(p.ws + WS_Z);
    const bf16* qsrc = HG ? Z + 0 * (SLAB / 2) + h * 128 : Z + 3 * (SLAB / 2) + h * 64;
    const bf16* ksrc = HG ? Z + 1 * (SLAB / 2) + h * 128 : Z + 3 * (SLAB / 2) + 256 + h * 64;
    bf16* vsrc = HG ? Z + 7 * (SLAB / 2) + h * 128 + 32 * slice : Z + 8 * (SLAB / 2) + h * 128 + 32 * slice;
    const bf16* PB = (const bf16*)(p.ws + WS_PB) + (HG ? 0 : (size_t)M * 256) + h * 64;
    const float* decg = (const float*)(p.ws + WS_DEC + (HG ? 0 : MiB)) + (size_t)((b * 4 + h) * 64) * DK;
    u32x4 rq[NQ], rk[NQ], rp; u32x2 rv; float rd = 0.f;
    auto gload = [&](int c) {
        const size_t m0 = (size_t)b * T + 64 * c;
#pragma unroll
        for (int k = 0; k < NQ; ++k) { const int q = tid + 512 * k; const int row = q / (DK / 8), ch = q % (DK / 8); rq[k] = *(const u32x4*)(qsrc + (m0 + row) * 512 + 8 * ch);
            const int dd = q >> 3, c8 = q & 7; rk[k] = *(const u32x4*)(HG ? ksrc + (m0 + (dd >> 1)) * 512 + (dd & 1) * 64 + 8 * c8 : ksrc + (m0 + dd) * 512 + 8 * c8); }
        rp = *(const u32x4*)(PB + (m0 + (tid >> 3)) * 256 + 8 * (tid & 7));
        rv = *(const u32x2*)(vsrc + (m0 + (tid >> 3)) * 512 + (tid & 7) * 4);
        if (tid < DK) rd = decg[c * DK + tid];
    };
    auto stage = [&](int x) {
        bf16* qe = (bf16*)(lds + x * BUF); bf16* keT = qe + 64 * QS; bf16* P = keT + DK * 72; bf16* VT = P + 64 * 72; float* dec = (float*)(VT + 32 * 72);
#pragma unroll
        for (int k = 0; k < NQ; ++k) { const int q = tid + 512 * k; const int row = q / (DK / 8), ch = q % (DK / 8); *(u32x4*)(qe + row * QS + 8 * ch) = rq[k]; *(u32x4*)(keT + (q >> 3) * 72 + 8 * (q & 7)) = rk[k]; }
        *(u32x4*)(P + (tid >> 3) * 72 + 8 * (tid & 7)) = rp;
        { const int s = tid >> 3, v4 = (tid & 7) * 4; VT[(v4 + 0) * 72 + s] = (bf16)(rv.x & 0xffffu); VT[(v4 + 1) * 72 + s] = (bf16)(rv.x >> 16); VT[(v4 + 2) * 72 + s] = (bf16)(rv.y & 0xffffu); VT[(v4 + 3) * 72 + s] = (bf16)(rv.y >> 16); }
        if (tid < DK) dec[tid] = rd;
    };
    f32x16 S = (f32x16){};
    gload(0); stage(0); gload(1);
    __syncthreads();
    for (int c = 0; c < T / 64; ++c) {
        const int x = c & 1; const size_t m0 = (size_t)b * T + 64 * c;
        const bf16* qe = (const bf16*)(lds + x * BUF); const bf16* keT = qe + 64 * QS; const bf16* P = keT + DK * 72; const bf16* VT = P + 64 * 72; const float* dec = (const float*)(VT + 32 * 72);
        if (c + 1 < T / 64) { stage(x ^ 1); if (c + 2 < T / 64) gload(c + 2); }
        f32x16 o = (f32x16){};
        if (w < NTS) {
            const float dc = dec[32 * w + r32];
#pragma unroll
            for (int r = 0; r < 16; ++r) { S[r] *= dc; ST[crow(r, hi) * QS + 32 * w + r32] = (bf16)f2bf(S[r]); }
#pragma unroll
            for (int ks = 0; ks < 4; ++ks) { const bf16x8 a = *(const bf16x8*)(VT + r32 * 72 + 16 * ks + 8 * hi); const bf16x8 bb = *(const bf16x8*)(keT + (32 * w + r32) * 72 + 16 * ks + 8 * hi); S = mfma32(a, bb, S); }
        } else if (w < 6) {
#pragma unroll
            for (int ks = 0; ks < 4; ++ks) { const bf16x8 a = *(const bf16x8*)(P + (32 * (w - 4) + r32) * 72 + 16 * ks + 8 * hi); const bf16x8 bb = *(const bf16x8*)(VT + r32 * 72 + 16 * ks + 8 * hi); o = mfma32(a, bb, o); }
        }
        __syncthreads();
        if (w >= 4 && w < 6) {
#pragma unroll
            for (int ks = 0; ks < DK / 16; ++ks) { const bf16x8 a = *(const bf16x8*)(qe + (32 * (w - 4) + r32) * QS + 16 * ks + 8 * hi); const bf16x8 bb = *(const bf16x8*)(ST + r32 * QS + 16 * ks + 8 * hi); o = mfma32(a, bb, o); }
#pragma unroll
            for (int r = 0; r < 16; ++r) vsrc[dst_off + (m0 + 32 * (w - 4) + crow(r, hi)) * 512 + r32] = (bf16)f2bf(o[r]);
        }
        __syncthreads();
    }
}

__device__ __forceinline__ void finish_pass(const Params& p, int layer, int gw, int NGW, int lane) {
    bf16* Z = (bf16*)(p.ws + WS_Z);
    for (int m = gw; m < M; m += NGW) {
        u32x4 wo[2], wg[2]; f32x4 g0[2], g1[2];
#pragma unroll
        for (int mix = 0; mix < 2; ++mix) {
            const bf16* o = Z + (mix ? 8 : 7) * (SLAB / 2) + (size_t)m * 512 + 8 * lane; const bf16* og = Z + (mix ? 4 : 2) * (SLAB / 2) + (size_t)m * 512 + 8 * lane;
            const float* g = p.in[mix ? 7 : 4] + layer * 512 + 8 * lane;
            wo[mix] = *(const u32x4*)o; wg[mix] = *(const u32x4*)og; g0[mix] = *(const f32x4*)g; g1[mix] = *(const f32x4*)(g + 4);
        }
#pragma unroll
        for (int mix = 0; mix < 2; ++mix) {
            float v[8], gt[8]; float s = 0.f;
#pragma unroll
            for (int e = 0; e < 4; ++e) { v[2 * e] = lo16(wo[mix][e]); v[2 * e + 1] = hi16(wo[mix][e]); gt[2 * e] = lo16(wg[mix][e]); gt[2 * e + 1] = hi16(wg[mix][e]); }
#pragma unroll
            for (int e = 0; e < 8; ++e) s += v[e] * v[e];
            s += __shfl_xor(s, 1); s += __shfl_xor(s, 2); s += __shfl_xor(s, 4); s += __shfl_xor(s, 8);
            const float r = rsqrtf(s * (1.f / 128.f) + 1e-6f);
            const float gg[8] = {g0[mix].x, g0[mix].y, g0[mix].z, g0[mix].w, g1[mix].x, g1[mix].y, g1[mix].z, g1[mix].w};
            float y[8];
#pragma unroll
            for (int e = 0; e < 8; ++e) y[e] = v[e] * r * gg[e] * siluf_(gt[e]);
            u32x4 w; w.x = pk2(y[0], y[1]); w.y = pk2(y[2], y[3]); w.z = pk2(y[4], y[5]); w.w = pk2(y[6], y[7]);
            *(u32x4*)(Z + (mix ? 8 : 7) * (SLAB / 2) + (size_t)m * 512 + 8 * lane) = w;
        }
    }
}

__device__ __forceinline__ void qk_tile(const bf16* Kt, const bf16x8* qr, f32x16& p0, f32x16& p1, int r32, int hi) {
    p0 = (f32x16){}; p1 = (f32x16){};
#pragma unroll
    for (int s = 0; s < 4; ++s) { const bf16x8 a0 = *(const bf16x8*)(Kt + r32 * 72 + 16 * s + 8 * hi), a1 = *(const bf16x8*)(Kt + (32 + r32) * 72 + 16 * s + 8 * hi); p0 = mfma32(a0, qr[s], p0); p1 = mfma32(a1, qr[s], p1); }
}
__device__ __forceinline__ unsigned cvtpk(float lo, float hi) { typedef float f2_t __attribute__((ext_vector_type(2))); typedef __bf16 b2_t __attribute__((ext_vector_type(2))); f2_t v = {lo, hi}; b2_t r = __builtin_convertvector(v, b2_t); return __builtin_bit_cast(unsigned, r); }
__device__ __forceinline__ void pv_tile(const bf16* Vt, const f32x16& p0, const f32x16& p1, f32x16* o, int r32, int hi) {
    bf16x8 pb[4], vf[8];
#pragma unroll
    for (int s = 0; s < 4; ++s) {
        u32x4 pw;
#pragma unroll
        for (int i = 0; i < 4; ++i) { const float a = (s < 2) ? p0[8 * (s & 1) + 2 * i] : p1[8 * (s & 1) + 2 * i], bq = (s < 2) ? p0[8 * (s & 1) + 2 * i + 1] : p1[8 * (s & 1) + 2 * i + 1]; pw[i] = cvtpk(a, bq); }
        pb[s] = __builtin_bit_cast(bf16x8, pw);
    }
#pragma unroll
    for (int s = 0; s < 4; ++s)
#pragma unroll
        for (int db = 0; db < 2; ++db) { const bf16* vp = Vt + (32 * db + r32) * 72 + 16 * s + 4 * hi; const u32x2 lo = *(const u32x2*)vp, hi8 = *(const u32x2*)(vp + 8);
            u32x4 aw; aw.x = lo.x; aw.y = lo.y; aw.z = hi8.x; aw.w = hi8.y; vf[2 * s + db] = __builtin_bit_cast(bf16x8, aw); }
    __builtin_amdgcn_sched_barrier(0);
#pragma unroll
    for (int s = 0; s < 4; ++s) { o[0] = mfma32(vf[2 * s], pb[s], o[0]); o[1] = mfma32(vf[2 * s + 1], pb[s], o[1]); }
    __builtin_amdgcn_sched_barrier(0);
}
struct TileRegs { u32x4 k; u32x2 va, vb; };
template <bool WITHV> __device__ __forceinline__ void tile_load(TileRegs& R, const bf16* Kb, const bf16* Vb, int pitch, int j, int tid) {
    R.k = *(const u32x4*)(Kb + (size_t)(64 * j + (tid >> 3)) * pitch + 8 * (tid & 7));
    if (WITHV) { const int pair = tid & 31, dq = tid >> 5; const bf16* vp = Vb + (size_t)(64 * j + 2 * pair) * pitch + 4 * dq; R.va = *(const u32x2*)vp; R.vb = *(const u32x2*)(vp + pitch); }
}
template <bool WITHV> __device__ __forceinline__ void tile_stage(const TileRegs& R, bf16* Kt, bf16* Vt, int tid) {
    *(u32x4*)(Kt + (tid >> 3) * 72 + 8 * (tid & 7)) = R.k;
    if (WITHV) { const int pair = tid & 31, dq = tid >> 5; unsigned* v32 = (unsigned*)Vt + (4 * dq) * 36 + pair;
        v32[0] = (R.va.x & 0xffffu) | (R.vb.x << 16); v32[36] = (R.va.x >> 16) | (R.vb.x & 0xffff0000u); v32[72] = (R.va.y & 0xffffu) | (R.vb.y << 16); v32[108] = (R.va.y >> 16) | (R.vb.y & 0xffff0000u); }
}
template <int MODE>
__device__ __forceinline__ void run_tiles(const bf16* Kb, const bf16* Vb, int pitch, int j0, int j1, bf16* Kt0, bf16* Vt0, const bf16x8* qr, int t,
                                          float& m, float& l, f32x16* o, float mc, float invlc, float* impme, int tid, int r32, int hi) {
    TileRegs R; tile_load<MODE != 0>(R, Kb, Vb, pitch, j0, tid);
    __syncthreads();
    tile_stage<MODE != 0>(R, Kt0, Vt0, tid);
    if (j0 < j1) tile_load<MODE != 0>(R, Kb, Vb, pitch, j0 + 1, tid);
    __syncthreads();
    for (int j = j0; j <= j1; ++j) {
        const int xb = (j - j0) & 1; bf16* Kt = Kt0 + xb * (2 * 64 * 72); bf16* Vt = Vt0 + xb * (2 * 64 * 72);
        if (j < j1) { tile_stage<MODE != 0>(R, Kt0 + (xb ^ 1) * (2 * 64 * 72), Vt0 + (xb ^ 1) * (2 * 64 * 72), tid); if (j + 1 < j1) tile_load<MODE != 0>(R, Kb, Vb, pitch, j + 2, tid); }
        f32x16 p0, p1; qk_tile(Kt, qr, p0, p1, r32, hi);
        const float NEG = -INFINITY;
#pragma unroll
        for (int r = 0; r < 16; ++r) { const int k0 = 64 * j + crow(r, hi), k1 = k0 + 32; p0[r] = (16 * k0 + 31 <= t) ? p0[r] : NEG; p1[r] = (16 * k1 + 31 <= t) ? p1[r] : NEG; }
        if (MODE == 1) {
#pragma unroll
            for (int r = 0; r < 16; ++r) { p0[r] = __builtin_amdgcn_exp2f(p0[r] - mc) * invlc; p1[r] = __builtin_amdgcn_exp2f(p1[r] - mc) * invlc; }
#pragma unroll
            for (int half = 0; half < 2; ++half)
#pragma unroll
                for (int g4 = 0; g4 < 4; ++g4) {
                    const float c3 = half ? p1[4 * g4 + 3] : p0[4 * g4 + 3];
                    const float a = half ? (p1[4 * g4] + p1[4 * g4 + 1]) + (p1[4 * g4 + 2] + c3) : (p0[4 * g4] + p0[4 * g4 + 1]) + (p0[4 * g4 + 2] + c3);
                    const float cp = __shfl_xor(c3, 32); const int jj = 16 * j + 8 * half + 2 * g4 + hi;
                    if (hi) impme[jj] += a + cp; else { impme[jj] += a; impme[jj + 2] += cp; }
                }
            pv_tile(Vt, p0, p1, o, r32, hi);
        } else {
            float mx = p0[0];
#pragma unroll
            for (int r = 0; r < 16; ++r) { mx = fmaxf(mx, p0[r]); mx = fmaxf(mx, p1[r]); }
            mx = fmaxf(mx, __shfl_xor(mx, 32));
            const float mn = fmaxf(m, mx), alpha = __builtin_amdgcn_exp2f(m - mn); m = mn;
            float ls = 0.f;
#pragma unroll
            for (int r = 0; r < 16; ++r) { ls += __builtin_amdgcn_exp2f(p0[r] - mn) + __builtin_amdgcn_exp2f(p1[r] - mn); }
            l = l * alpha + ls;
        }
        __syncthreads();
    }
}
template <int MODE>
__device__ __forceinline__ void run_tiles_fast(const bf16* Kb, const bf16* Vb, int pitch, int j0, int j1, int qb, bf16* Kt0, bf16* Vt0, const bf16x8* qr, int t, unsigned long long sel,
                                               float& mref, float& l, f32x16* o, int tid, int r32, int hi) {
    TileRegs R; tile_load<true>(R, Kb, Vb, pitch, j0, tid);
    const float NEG = -INFINITY;
    mref = 0.f;
    __syncthreads();
    tile_stage<true>(R, Kt0, Vt0, tid);
    if (j0 < j1) tile_load<true>(R, Kb, Vb, pitch, j0 + 1, tid);
    __syncthreads();
    for (int j = j0; j <= j1; ++j) {
        const int xb = (j - j0) & 1; bf16* Kt = Kt0 + xb * (2 * 64 * 72); bf16* Vt = Vt0 + xb * (2 * 64 * 72);
        if (j < j1) { tile_stage<true>(R, Kt0 + (xb ^ 1) * (2 * 64 * 72), Vt0 + (xb ^ 1) * (2 * 64 * 72), tid); if (j + 1 < j1) tile_load<true>(R, Kb, Vb, pitch, j + 2, tid); }
        const float init = ((MODE == 2 && !((sel >> j) & 1ull)) ? NEG : 0.f) - mref;
        f32x16 p0, p1;
#pragma unroll
        for (int r = 0; r < 16; ++r) { p0[r] = init; p1[r] = init; }
        { bf16x8 kf[8];
#pragma unroll
          for (int s = 0; s < 4; ++s) { kf[2 * s] = *(const bf16x8*)(Kt + r32 * 72 + 16 * s + 8 * hi); kf[2 * s + 1] = *(const bf16x8*)(Kt + (32 + r32) * 72 + 16 * s + 8 * hi); }
          __builtin_amdgcn_sched_barrier(0);
#pragma unroll
          for (int s = 0; s < 4; ++s) { p0 = mfma32(kf[2 * s], qr[s], p0); p1 = mfma32(kf[2 * s + 1], qr[s], p1); }
          __builtin_amdgcn_sched_barrier(0); }
        if (j == qb || (MODE == 3 && j == qb - 8)) {
#pragma unroll
            for (int r = 0; r < 16; ++r) { const int k0 = 64 * j + crow(r, hi), k1 = k0 + 32;
                const bool ok0 = k0 <= t && (MODE == 2 || k0 > t - 512), ok1 = k1 <= t && (MODE == 2 || k1 > t - 512);
                p0[r] = ok0 ? p0[r] : NEG; p1[r] = ok1 ? p1[r] : NEG; }
        }
        float mx = fmaxf(p0[0], p1[0]);
#pragma unroll
        for (int r = 1; r < 16; ++r) mx = fmaxf(fmaxf(mx, p0[r]), p1[r]);
        mx = fmaxf(mx, __shfl_xor(mx, 32));
        if (j == j0) { const float mr = (mx == NEG) ? 0.f : mx; mref = mr;
#pragma unroll
            for (int r = 0; r < 16; ++r) { p0[r] -= mr; p1[r] -= mr; } }
        else if (__any(mx > 8.f)) { const float dl = fmaxf(mx, 0.f), f = __builtin_amdgcn_exp2f(-dl); mref += dl; l *= f; o[0] *= f; o[1] *= f;
#pragma unroll
            for (int r = 0; r < 16; ++r) { p0[r] -= dl; p1[r] -= dl; } }
        float ls = 0.f;
#pragma unroll
        for (int r = 0; r < 16; ++r) { p0[r] = __builtin_amdgcn_exp2f(p0[r]); p1[r] = __builtin_amdgcn_exp2f(p1[r]); ls += p0[r] + p1[r]; }
        l += ls;
        pv_tile(Vt, p0, p1, o, r32, hi);
        __syncthreads();
    }
}

__device__ __forceinline__ void nsa_unit(const Params& p, int bg, int qb, char* lds, size_t dst_off) {
    const int tid = fresh_tid(), lane = tid & 63, w = __builtin_amdgcn_readfirstlane(tid >> 6), r32 = lane & 31, hi = lane >> 5;
    const int b = bg >> 1, g = bg & 1;
    bf16* Kt = (bf16*)lds; bf16* Vt = Kt + 64 * 72; float* impw = (float*)(Kt + 4 * 64 * 72); unsigned long long* selm = (unsigned long long*)(impw + 8 * 32 * 65);
    bf16* Z = (bf16*)(p.ws + WS_Z);
    bf16* s5 = Z + 5 * (SLAB / 2); bf16* s6 = Z + 6 * (SLAB / 2); bf16* s9 = Z + 9 * (SLAB / 2);
    const bf16* KC = (const bf16*)(p.ws + WS_KC) + (size_t)bg * 256 * 64; const bf16* VC = (const bf16*)(p.ws + WS_VC) + (size_t)bg * 256 * 64;
    const size_t rowb = (size_t)b * T;
    const int hh = g * 4 + (w >> 1), tokl = 32 * (w & 1) + r32, t = 64 * qb + tokl; const size_t mrow = rowb + t;
    bf16x8 qr[4];
#pragma unroll
    for (int s = 0; s < 4; ++s) qr[s] = *(const bf16x8*)(s9 + mrow * 512 + hh * 64 + 16 * s + 8 * hi);
    for (int e = tid; e < 8 * 32 * 65; e += 512) impw[e] = 0.f;
    const bf16* gp = s6 + mrow * 512 + 272 + hh * 3;
    const float gc = sigmoidf_(bf2f(gp[0])), gs = sigmoidf_(bf2f(gp[1])), gwn = sigmoidf_(bf2f(gp[2]));
    f32x16 oacc[2]; oacc[0] = (f32x16){}; oacc[1] = (f32x16){};
    f32x16 o[2];
    float* impme = impw + (w * 32 + r32) * 65;
    const int ntc = (qb >> 4) + 1;
    float mc = -1e30f, lc = 0.f;
    run_tiles<0>(KC, VC, 64, 0, ntc - 1, Kt, Vt, qr, t, mc, lc, o, 0.f, 0.f, impme, tid, r32, hi);
    lc += __shfl_xor(lc, 32);
    const float invlc = lc > 0.f ? 1.f / lc : 0.f;
    o[0] = (f32x16){}; o[1] = (f32x16){};
    { float dm = 0.f, dl = 0.f; run_tiles<1>(KC, VC, 64, 0, ntc - 1, Kt, Vt, qr, t, dm, dl, o, mc, invlc, impme, tid, r32, hi); }
    oacc[0] += o[0] * gc; oacc[1] += o[1] * gc;
    __syncthreads();
    if (qb < 16) { if (tid < 64) selm[tid] = (2ull << qb) - 1ull; }
    else for (int tk = w; tk < 64; tk += 8) {
        float v = 0.f;
#pragma unroll
        for (int r = 0; r < 4; ++r) v += impw[((2 * r + (tk >> 5)) * 32 + (tk & 31)) * 65 + lane];
        const int cur = qb; const bool valid = lane <= cur, forced = lane == 0 || lane == cur || lane == cur - 1;
        const float sc = valid ? (forced ? 1e9f : v) : -1e9f;
        const unsigned bits = __float_as_uint(sc), key = (bits & 0x80000000u) ? ~bits : (bits | 0x80000000u);
        unsigned thr = 0u;
#pragma unroll 1
        for (int bit = 31; bit >= 0; --bit) { const unsigned cand = thr | (1u << bit); if (__popcll(__ballot(key >= cand)) >= 16) thr = cand; }
        const unsigned long long gt = __ballot(key > thr), eq = __ballot(key == thr);
        const int need = 16 - __popcll(gt);
        const int before = __popcll(eq & ((1ull << lane) - 1ull));
        const bool pick = (key > thr) || (key == thr && before < need);
        const unsigned long long mk = __ballot(pick && sc > -1e8f);
        if (lane == 0) selm[tk] = mk;
    }
    __syncthreads();
    const unsigned long long sel = selm[tokl];
    {
        float ms = -1e30f, ls = 0.f; o[0] = (f32x16){}; o[1] = (f32x16){};
        run_tiles_fast<2>(s5 + rowb * 512 + 256 + g * 64, s5 + rowb * 512 + 384 + g * 64, 512, 0, qb, qb, Kt, Vt, qr, t, sel, ms, ls, o, tid, r32, hi);
        ls += __shfl_xor(ls, 32); const float sc = gs / ls; oacc[0] += o[0] * sc; oacc[1] += o[1] * sc;
    }
    {
        float ms = -1e30f, ls = 0.f; o[0] = (f32x16){}; o[1] = (f32x16){};
        run_tiles_fast<3>(s6 + rowb * 512 + g * 64, s6 + rowb * 512 + 128 + g * 64, 512, qb > 8 ? qb - 8 : 0, qb, qb, Kt, Vt, qr, t, 0ull, ms, ls, o, tid, r32, hi);
        ls += __shfl_xor(ls, 32); const float sc = gwn / ls; oacc[0] += o[0] * sc; oacc[1] += o[1] * sc;
    }
#pragma unroll
    for (int db = 0; db < 2; ++db)
#pragma unroll
        for (int rg = 0; rg < 4; ++rg) { u32x2 wv; wv.x = pk2(oacc[db][4 * rg], oacc[db][4 * rg + 1]); wv.y = pk2(oacc[db][4 * rg + 2], oacc[db][4 * rg + 3]);
            *(u32x2*)(s9 + dst_off + mrow * 512 + hh * 64 + 32 * db + 8 * rg + 4 * hi) = wv; }
    __syncthreads();
}
}

namespace pg8 {
template <int ACT  > struct EpiStore {
    static constexpr bool PERM = true, AFTER_DRAIN = false;
    bf16_t* O; int ldc; int split_cols; size_t split_stride;
    __device__ __forceinline__ void operator()(const f32x4 (&acc)[2][2][4][2], const Unit& u, int wr, int wc, int fr, int fq) const {
        const int row0 = u.pm * BM + wr * 64 + fr; int colt = u.pn * BM; bf16_t* base = O;
        { const int t = colt / split_cols; base += (size_t)t * split_stride; colt -= t * split_cols; }
        const int col0 = colt + wc * 32 + 8 * fq;
#pragma unroll
        for (int ai = 0; ai < 2; ++ai)
#pragma unroll
            for (int m = 0; m < 4; ++m) { bf16_t* rowp = base + (size_t)(row0 + ai * HALF + m * 16) * ldc + col0;
#pragma unroll
                for (int bj = 0; bj < 2; ++bj) { f32x4 v0 = acc[ai][bj][m][0], v1 = acc[ai][bj][m][1];
                    if (ACT == 2) {
#pragma unroll
                        for (int e = 0; e < 4; ++e) { v0[e] = 1.f / (1.f + __expf(-v0[e])); v1[e] = 1.f / (1.f + __expf(-v1[e])); } }
                    u32x4 w; w.x = cvt_pk_bf16(v0[0], v0[1]); w.y = cvt_pk_bf16(v0[2], v0[3]); w.z = cvt_pk_bf16(v1[0], v1[1]); w.w = cvt_pk_bf16(v1[2], v1[3]);
                    *(u32x4*)(rowp + bj * HALF) = w; } }
    }
};
__device__ __forceinline__ float bflo(unsigned w) { return __uint_as_float(w << 16); }
__device__ __forceinline__ float bfhi(unsigned w) { return __uint_as_float(w & 0xffff0000u); }
template <bool FIRST> struct EpiBranch {
    static constexpr bool PERM = true, AFTER_DRAIN = false;
    bf16_t* Mo; const bf16_t* G;
    __device__ __forceinline__ void operator()(const f32x4 (&acc)[2][2][4][2], const Unit& u, int wr, int wc, int fr, int fq) const {
        const int row0 = u.pm * BM + wr * 64 + fr, col0 = u.pn * BM + wc * 32 + 8 * fq;
#pragma unroll
        for (int ai = 0; ai < 2; ++ai)
#pragma unroll
            for (int m = 0; m < 4; ++m) { const size_t off = (size_t)(row0 + ai * HALF + m * 16) * 1024 + col0;
#pragma unroll
                for (int bj = 0; bj < 2; ++bj) { const f32x4 v0 = acc[ai][bj][m][0], v1 = acc[ai][bj][m][1];
                    const u32x4 g = *(const u32x4*)(G + off + bj * HALF);
                    float r[8] = {bflo(g.x) * v0[0], bfhi(g.x) * v0[1], bflo(g.y) * v0[2], bfhi(g.y) * v0[3], bflo(g.z) * v1[0], bfhi(g.z) * v1[1], bflo(g.w) * v1[2], bfhi(g.w) * v1[3]};
                    if (!FIRST) { const u32x4 o = *(const u32x4*)(Mo + off + bj * HALF);
                        r[0] += bflo(o.x); r[1] += bfhi(o.x); r[2] += bflo(o.y); r[3] += bfhi(o.y); r[4] += bflo(o.z); r[5] += bfhi(o.z); r[6] += bflo(o.w); r[7] += bfhi(o.w); }
                    u32x4 w; w.x = cvt_pk_bf16(r[0], r[1]); w.y = cvt_pk_bf16(r[2], r[3]); w.z = cvt_pk_bf16(r[4], r[5]); w.w = cvt_pk_bf16(r[6], r[7]);
                    *(u32x4*)(Mo + off + bj * HALF) = w; } }
    }
};
struct EpiResid {
    static constexpr bool PERM = false, AFTER_DRAIN = false;
    const float* base; float* out;
    __device__ __forceinline__ void operator()(const f32x4 (&acc)[2][2][4][2], const Unit& u, int wr, int wc, int fr, int fq) const {
        const int row0 = u.pm * BM + wr * 64 + fr, col0 = u.pn * BM + wc * 32 + 4 * fq;
#pragma unroll
        for (int ai = 0; ai < 2; ++ai)
#pragma unroll
            for (int m = 0; m < 4; ++m) { const size_t off = (size_t)(row0 + ai * HALF + m * 16) * 1024 + col0;
#pragma unroll
                for (int bj = 0; bj < 2; ++bj)
#pragma unroll
                    for (int n = 0; n < 2; ++n) { const f32x4 bs = *(const f32x4*)(base + off + bj * HALF + n * 16); *(f32x4*)(out + off + bj * HALF + n * 16) = bs + acc[ai][bj][m][n]; } }
    }
};
struct EpiSwiGLU {
    static constexpr bool PERM = true, AFTER_DRAIN = false;
    bf16_t* Hd;
    __device__ __forceinline__ void operator()(const f32x4 (&acc)[2][2][4][2], const Unit& u, int wr, int wc, int fr, int fq) const {
        const int row0 = u.pm * BM + wr * 64 + fr, col0 = u.pn * 128 + wc * 32 + 8 * fq;
#pragma unroll
        for (int ai = 0; ai < 2; ++ai)
#pragma unroll
            for (int m = 0; m < 4; ++m) { float r[8];
#pragma unroll
                for (int n = 0; n < 2; ++n)
#pragma unroll
                    for (int e = 0; e < 4; ++e) { const float gt = acc[ai][0][m][n][e], up = acc[ai][1][m][n][e]; r[4 * n + e] = gt / (1.f + __expf(-gt)) * up; }
                u32x4 w; w.x = cvt_pk_bf16(r[0], r[1]); w.y = cvt_pk_bf16(r[2], r[3]); w.z = cvt_pk_bf16(r[4], r[5]); w.w = cvt_pk_bf16(r[6], r[7]);
                *(u32x4*)(Hd + (size_t)(row0 + ai * HALF + m * 16) * 2816 + col0) = w; }
    }
};
}

#define LAS __attribute__((address_space(3)))
#define XB_TMO      128
#define XB_XCNT(j)  (256  + 64 * (j))
#define XB_XSUB(j)  (1280 + 64 * (j))
#define XB_XGEN(j)  (2304 + 64 * (j))
#define XB_TOP      3328
#define XB_TOPGEN   3392
#define XCD_BAR_WORDS 3456
#define XB_SPIN_CAP (1u << 18)

__device__ __forceinline__ unsigned xb_ld(unsigned* p)              { return __hip_atomic_load(p, __ATOMIC_RELAXED, __HIP_MEMORY_SCOPE_AGENT); }
__device__ __forceinline__ unsigned xb_add(unsigned* p, unsigned v) { return __hip_atomic_fetch_add(p, v, __ATOMIC_RELAXED, __HIP_MEMORY_SCOPE_AGENT); }
__device__ __forceinline__ unsigned xb_xcc_id() { return (unsigned)__builtin_amdgcn_s_getreg((3 << 11) | 20) & 0xFu; }
#define XB_SPIN(cond, bar) do { unsigned _sp = 0; while (cond) { __builtin_amdgcn_s_sleep(1); \
    if ((++_sp & 255u) == 0u) { if (xb_ld(&(bar)[XB_TMO])) break; if (_sp > XB_SPIN_CAP) { atomicAdd(&(bar)[XB_TMO], 1u); break; } } } } while (0)

struct XcdBarrier {
    unsigned* bar; unsigned x;
    volatile LAS unsigned* st;
};

__device__ __forceinline__ XcdBarrier xcd_barrier_post(unsigned* bar, volatile LAS unsigned* st) {
    XcdBarrier b; b.bar = bar; b.x = xb_xcc_id(); b.st = st;
    if (threadIdx.x == 0) (void)xb_add(&bar[XB_XCNT(b.x)], 1u);
    return b;
}
__device__ __forceinline__ void xcd_barrier_complete(unsigned* bar, unsigned x, unsigned& nloc, unsigned& nx) {
    const unsigned G = gridDim.x * gridDim.y * gridDim.z;
    unsigned sum, cnt, mine, sp = 0u;
    for (;;) {
        sum = 0u; cnt = 0u; mine = 0u;
#pragma unroll
        for (unsigned j = 0; j < 16; ++j) { const unsigned c = xb_ld(&bar[XB_XCNT(j)]); sum += c; cnt += (c > 0u) ? 1u : 0u; mine = (j == x) ? c : mine; }
        if (sum == G) break;
        __builtin_amdgcn_s_sleep(1);
        if ((++sp & 255u) == 0u) { if (xb_ld(&bar[XB_TMO])) break; if (sp > XB_SPIN_CAP) { atomicAdd(&bar[XB_TMO], 1u); break; } }
    }
    nloc = mine > 0u ? mine : 1u; nx = cnt > 0u ? cnt : 1u;
}

__device__ __forceinline__ void xcd_barrier(const XcdBarrier& b) {
    asm volatile("s_waitcnt vmcnt(0)" ::: "memory");
    __syncthreads();
    if (threadIdx.x == 0) {
        unsigned* bar = b.bar;
        __builtin_amdgcn_s_waitcnt(0);
        unsigned nloc = b.st[0], nx = b.st[1];
        if (nloc == 0u) { xcd_barrier_complete(bar, b.x, nloc, nx); b.st[0] = nloc; b.st[1] = nx; }
        const unsigned old = xb_add(&bar[XB_XSUB(b.x)], 1u);
        const unsigned gen = old / nloc;
        if (old + 1u == (gen + 1u) * nloc) {
            __builtin_amdgcn_fence(__ATOMIC_RELEASE, "agent");
            asm volatile("s_waitcnt vmcnt(0)" ::: "memory");
            const unsigned og = xb_add(&bar[XB_TOP], 1u);
            const unsigned tg = og / nx;
            if (og + 1u == (tg + 1u) * nx) xb_add(&bar[XB_TOPGEN], 1u);
            else XB_SPIN(xb_ld(&bar[XB_TOPGEN]) == tg, bar);
            __builtin_amdgcn_fence(__ATOMIC_ACQUIRE, "agent");
            xb_add(&bar[XB_XGEN(b.x)], 1u);
            asm volatile("s_waitcnt vmcnt(0)" ::: "memory");
        } else {
            XB_SPIN(xb_ld(&bar[XB_XGEN(b.x)]) == gen, bar);
            __builtin_amdgcn_fence(__ATOMIC_ACQUIRE, "agent");
            asm volatile("s_waitcnt vmcnt(0)" ::: "memory");
        }
    }
    __syncthreads();
}

#ifndef PROBE_SCAN
#define PROBE_SCAN 0
#endif
#ifndef PROBE_NSA
#define PROBE_NSA 0
#endif
#ifndef PROBE_GEMM
#define PROBE_GEMM 0
#endif
#ifndef PROBE_SYNC
#define PROBE_SYNC 0
#endif
#ifndef PROBE_EW
#define PROBE_EW 0
#endif
#ifndef MK_ONE_LAUNCH
#define MK_ONE_LAUNCH 1
#endif
constexpr int N_PHASES = 1 + 11 * 2;

using namespace mk;
__global__ void __launch_bounds__(512, 2) mk_fwd(Params p, int ph_lo, int ph_hi) {
    extern __shared__ __attribute__((aligned(16))) unsigned char lds_raw[];
    char* lds = (char*)lds_raw;
    PG8_LAS unsigned char* lds3 = (PG8_LAS unsigned char*)lds_raw;
    const int G = gridDim.x, NGW = G * 8;
#define FRESH() const int tid = fresh_tid(), lane = tid & 63, wave = __builtin_amdgcn_readfirstlane(tid >> 6), bid = fresh_bid(), gw = bid * 8 + wave; (void)lane; (void)gw; (void)bid
    unsigned char* ws = p.ws;
    bf16* H = (bf16*)(ws + WS_H); bf16* Z = (bf16*)(ws + WS_Z);
    int ph = 0;
#if MK_ONE_LAUNCH
    cg::grid_group grid = cg::this_grid();
    { volatile LAS unsigned* st0 = (volatile LAS unsigned*)(lds3 + LDS_BYTES - 64); if (threadIdx.x < 2) st0[threadIdx.x] = 0u; __syncthreads(); }
    XcdBarrier xbar = xcd_barrier_post((unsigned*)ws, (volatile LAS unsigned*)(lds3 + LDS_BYTES - 64));
#define SEAM() do { if (ph == 0) grid.sync(); else xcd_barrier(xbar); for (int q_ = 0; q_ < PROBE_SYNC; ++q_) xcd_barrier(xbar); ++ph; } while (0)
#else
#define SEAM() do { ++ph; } while (0)
#endif
#define RUN (ph >= ph_lo && ph < ph_hi)
    if (RUN) { FRESH();
_Pragma("nounroll") for (int rep = 0; rep < 1 + PROBE_EW; ++rep) {
#ifndef NO_CONV
 convert_weights(p, lds, gw, NGW, wave, lane);
#endif
 rms_to_bf16(p.in[0], p.in[1], H, gw, NGW, lane); } }
    SEAM();
    for (int l = 0; l < DEPTH; ++l) {
        const unsigned char* wb = ws + WS_W + (size_t)l * W_LAYER;
        const float* xin = l == 0 ? p.in[0] : p.out;
        if (RUN) { FRESH(); pg8::Gemm g{H, (const bf16*)(wb + OW_IN), M, NZ, D}; pg8::StaticOrder S; S.init(M, NZ, G, bid);
            pg8::EpiStore<0> E{Z, 512, 512, (size_t)M * 512};
_Pragma("nounroll") for (int rep = 0; rep < 1 + PROBE_GEMM; ++rep)
#ifndef NO_G1
pg8::gemm_phase<pg8::EpiStore<0>, pg8::StaticOrder, true, true>(lds3, g, S, E);
#endif
 }
        SEAM();
        if (RUN) { FRESH();
#ifndef NO_CMP
 for (int task = bid; task < 256; task += G) compress_task(p, l, task, lds);
#endif
#ifndef NO_ROPE
 rope_pass(p, gw, NGW, lane);
#endif
#ifndef NO_SCAN
 __syncthreads();
 for (int u = bid; u < 4096; u += G) { const int cc = u & 63, hh = (u >> 6) & 3, bb = (u >> 8) & 7; if (u < 2048) scan_prep<128, true>(p, l, bb, hh, cc, lds); else scan_prep<64, false>(p, l, bb, hh, cc, lds); }
#endif
 }
        SEAM();
        if (RUN) { FRESH();
_Pragma("nounroll")          for (int rep = 0; rep < 1 + PROBE_SCAN; ++rep) { const size_t sc_off7 = 0, sc_off8 = 0;
#ifndef NO_SCAN
            for (int u = bid; u < 256; u += G) { const int bb = (u & 127) >> 4, hh = (u & 15) >> 2, sl = u & 3; if (u < 128) scan_unit<128, true>(p, l, bb, hh, sl, lds, sc_off7); else scan_unit<64, false>(p, l, bb, hh, sl, lds, sc_off8); }
#endif
          }
_Pragma("nounroll")          for (int rep = 0; rep < 1 + PROBE_NSA; ++rep) { const size_t ns_off = 0;
#ifndef NO_NSA
            for (int vc = bid; vc < 256; vc += G) { const int bg = vc >> 4, s = vc & 15;
                for (int i = 0; i < 4; ++i) { const int qb = i == 0 ? 63 - s : (i == 1 ? 32 + s : (i == 2 ? 31 - s : s)); nsa_unit(p, bg, qb, lds, ns_off); } }
#endif
          }
        }
        SEAM();
        if (RUN) { FRESH(); finish_pass(p, l, gw, NGW, lane); }
        SEAM();
        if (RUN) { FRESH(); pg8::Gemm g{H, (const bf16*)(wb + OW_G), M, 3072, D}; pg8::StaticOrder S; S.init(M, 3072, G, bid);
            pg8::EpiStore<2> E{Z, 1024, 1024, (size_t)M * 1024};
_Pragma("nounroll") for (int rep = 0; rep < 1 + PROBE_GEMM; ++rep)
#ifndef NO_G2
pg8::gemm_phase<pg8::EpiStore<2>, pg8::StaticOrder, true, true>(lds3, g, S, E);
#endif
 }
        SEAM();
        if (RUN) { FRESH();
            pg8::StaticOrder S; S.init(M, D, G, bid);
_Pragma("nounroll") for (int rep = 0; rep < 1 + PROBE_GEMM; ++rep) {
            { pg8::Gemm g{Z + 7 * (SLAB / 2), (const bf16*)(wb + OW_BR), M, D, 512}; pg8::EpiBranch<true> E{H, Z};
#ifndef NO_G3
pg8::gemm_phase<pg8::EpiBranch<true>, pg8::StaticOrder, true, true>(lds3, g, S, E);
#endif
 }
            asm volatile("s_waitcnt vmcnt(0)" ::: "memory"); __syncthreads();
            { pg8::Gemm g{Z + 8 * (SLAB / 2), (const bf16*)(wb + OW_BR) + (size_t)D * 512, M, D, 512}; pg8::EpiBranch<false> E{H, Z + (size_t)M * 1024};
#ifndef NO_G4
pg8::gemm_phase<pg8::EpiBranch<false>, pg8::StaticOrder, true, true>(lds3, g, S, E);
#endif
 }
            asm volatile("s_waitcnt vmcnt(0)" ::: "memory"); __syncthreads();
            { pg8::Gemm g{Z + 9 * (SLAB / 2), (const bf16*)(wb + OW_BR) + (size_t)2 * D * 512, M, D, 512}; pg8::EpiBranch<false> E{H, Z + (size_t)2 * M * 1024};
#ifndef NO_G5
pg8::gemm_phase<pg8::EpiBranch<false>, pg8::StaticOrder, true, true>(lds3, g, S, E);
#endif
 }
            if (rep < PROBE_GEMM) { asm volatile("s_waitcnt vmcnt(0)" ::: "memory"); __syncthreads(); } }
        }
        SEAM();
        if (RUN) { FRESH(); pg8::Gemm g{H, (const bf16*)(wb + OW_OUT), M, D, D}; pg8::StaticOrder S; S.init(M, D, G, bid);
            pg8::EpiResid E{xin, p.out};
#ifndef NO_G6
pg8::gemm_phase<pg8::EpiResid, pg8::StaticOrder, true, true>(lds3, g, S, E);
#endif
 }
        SEAM();
        if (RUN) { FRESH(); _Pragma("nounroll") for (int rep = 0; rep < 1 + PROBE_EW; ++rep) rms_to_bf16(p.out, p.in[18] + l * D, H, gw, NGW, lane); }
        SEAM();
        if (RUN) { FRESH(); pg8::Gemm g{H, (const bf16*)(wb + OW_GU), M, 2 * FF, D}; pg8::StaticOrder S; S.init(M, 2 * FF, G, bid);
            pg8::EpiSwiGLU E{Z};
_Pragma("nounroll") for (int rep = 0; rep < 1 + PROBE_GEMM; ++rep)
#ifndef NO_G7
pg8::gemm_phase<pg8::EpiSwiGLU, pg8::StaticOrder, true, true>(lds3, g, S, E);
#endif
 }
        SEAM();
        if (RUN) { FRESH(); pg8::Gemm g{Z, (const bf16*)(wb + OW_D), M, D, FF}; pg8::StaticOrder S; S.init(M, D, G, bid);
            pg8::EpiResid E{p.out, p.out};
#ifndef NO_G8
pg8::gemm_phase<pg8::EpiResid, pg8::StaticOrder, true, true>(lds3, g, S, E);
#endif
 }
        SEAM();
        if (RUN) { FRESH(); if (l + 1 < DEPTH) rms_to_bf16(p.out, p.in[1] + (l + 1) * D, H, gw, NGW, lane); else rms_final(p.out, p.in[22], gw, NGW, lane); }
        if (l + 1 < DEPTH) SEAM();
    }
}

extern "C" void kernel_launch(void* const* d_in, const int* in_sizes, int n_in, void* d_out, int out_size, void* d_ws, size_t ws_size, hipStream_t stream) {
    static int grid = 0;
    if (grid == 0) {
        if (n_in != 23 || in_sizes[0] != M * D || out_size != M * D || ws_size < WS_NEED) { fprintf(stderr, "kernel_launch: unexpected shapes (n_in %d, in0 %d, out %d, ws %zu)\n", n_in, n_in > 0 ? in_sizes[0] : -1, out_size, ws_size); grid = -1; return; }
        int dev = 0, cus = 0, per_cu = 0;
        hipGetDevice(&dev); hipDeviceGetAttribute(&cus, hipDeviceAttributeMultiprocessorCount, dev);
        hipFuncSetAttribute((const void*)mk_fwd, hipFuncAttributeMaxDynamicSharedMemorySize, LDS_BYTES);
        hipOccupancyMaxActiveBlocksPerMultiprocessor(&per_cu, (const void*)mk_fwd, 512, LDS_BYTES);
        (void)hipGetLastError();
        if (per_cu < 1) per_cu = 1;
        grid = cus;
    }
    if (grid < 0) return;
    Params p{};
    for (int i = 0; i < 23; ++i) p.in[i] = (const float*)d_in[i];
    p.out = (float*)d_out; p.ws = (unsigned char*)d_ws;
#if MK_ONE_LAUNCH
    int lo = 0, hi = 1000;
    void* args[] = {&p, &lo, &hi};
    if (hipMemsetAsync(d_ws, 0, 65536, stream) != hipSuccess) { fprintf(stderr, "memset failed\n"); return; }
    hipError_t e = hipLaunchCooperativeKernel((const void*)mk_fwd, dim3(grid), dim3(512), args, LDS_BYTES, stream);
    if (e != hipSuccess) fprintf(stderr, "cooperative launch failed: %s (grid %d)\n", hipGetErrorString(e), grid);
#else
    for (int ph = 0; ph < N_PHASES; ++ph) hipLaunchKernelGGL(mk_fwd, dim3(grid), dim3(512), LDS_BYTES, stream, p, ph, ph + 1);
#endif
}
```
